# Optimizing an MI355X kernel written in HIP

```python
import math
import jax, jax.numpy as jnp
from jax import lax
import numpy as np

D_MODEL = 2048
BATCH = 2
SEQ = 4096
DEPTH = 4

ATTN_HEADS = 8
ATTN_KV_HEADS = 2
HEAD_DIM = 128
WINDOW = 128
ROPE_THETA = 10000.0
DN_HEADS = 4
DN_HEAD_DIM = 128
DN_CONV = 4
DN_CHUNK = 64
S5_GROUPS = 32
S5_GROUP_CH = 16
S5_STATE = 64
ATTN_WIDTH = ATTN_HEADS * HEAD_DIM
ATTN_KV_WIDTH = ATTN_KV_HEADS * HEAD_DIM
DN_WIDTH = DN_HEADS * DN_HEAD_DIM
S5_WIDTH = S5_GROUPS * S5_GROUP_CH
MIX_WIDTH = ATTN_WIDTH + DN_WIDTH + S5_WIDTH
IN_SPLITS = (ATTN_WIDTH, ATTN_KV_WIDTH, ATTN_KV_WIDTH, 3 * DN_WIDTH, DN_WIDTH, DN_HEADS, DN_HEADS, S5_WIDTH)
IN_WIDTH = sum(IN_SPLITS)
D_FF = 5632
FFN_RES_WEIGHT = 0.5
NORM_EPS = 1e-6

kernel_name = "hymba_style_swa_deltanet_s5_macaron"


def rms_norm(x, gain):
    xf = x.astype(jnp.float32)
    y = xf * lax.rsqrt(jnp.mean(xf * xf, axis=-1, keepdims=True) + NORM_EPS)
    return (y * gain.astype(jnp.float32)).astype(x.dtype)


def l2_norm(x):
    return x * lax.rsqrt(jnp.sum(x * x, axis=-1, keepdims=True) + NORM_EPS)


def swiglu(h, w_gate, w_up, w_down):
    return (jax.nn.silu(h @ w_gate) * (h @ w_up)) @ w_down


def rope_tables(seq):
    half = HEAD_DIM // 2
    inv_freq = ROPE_THETA ** (-jnp.arange(half, dtype=jnp.float32) / half)
    ang = jnp.arange(seq, dtype=jnp.float32)[:, None] * inv_freq[None, :]
    return jnp.cos(ang), jnp.sin(ang)


def apply_rope(x, cos, sin):
    half = HEAD_DIM // 2
    xf = x.astype(jnp.float32)
    x1, x2 = xf[..., :half], xf[..., half:]
    c = cos[None, :, None, :]
    s = sin[None, :, None, :]
    return jnp.concatenate([x1 * c - x2 * s, x2 * c + x1 * s], axis=-1).astype(x.dtype)


def sliding_window_attention(q, k, v, sinks):
    b, s, hq, d = q.shape
    hkv = k.shape[2]
    grp = hq // hkv
    nb = s // WINDOW
    qb = q.reshape(b, nb, WINDOW, hkv, grp, d)
    kb = k.reshape(b, nb, WINDOW, hkv, d)
    vb = v.reshape(b, nb, WINDOW, hkv, d)
    pad = ((0, 0), (1, 0), (0, 0), (0, 0), (0, 0))
    kk = jnp.concatenate([jnp.pad(kb, pad)[:, :-1], kb], axis=2)
    vv = jnp.concatenate([jnp.pad(vb, pad)[:, :-1], vb], axis=2)
    scores = jnp.einsum('bnqhgd,bnkhd->bnhgqk', qb, kk, preferred_element_type=jnp.float32) * (d ** -0.5)
    qi = jnp.arange(WINDOW)[:, None] + WINDOW
    kj = jnp.arange(2 * WINDOW)[None, :]
    rel = qi - kj
    band = (rel >= 0) & (rel < WINDOW)
    first = (jnp.arange(nb) == 0)[:, None, None] & (kj < WINDOW)[None]
    mask = band[None] & jnp.logical_not(first)
    scores = jnp.where(mask[None, :, None, None], scores, -jnp.inf)
    sink = sinks.astype(jnp.float32).reshape(hkv, grp)[None, None, :, :, None, None]
    m = jnp.maximum(jnp.max(scores, axis=-1, keepdims=True), sink)
    p = jnp.exp(scores - m)
    p = p / (jnp.sum(p, axis=-1, keepdims=True) + jnp.exp(sink - m))
    out = jnp.einsum('bnhgqk,bnkhd->bnqhgd', p.astype(vv.dtype), vv)
    return out.reshape(b, s, hq * d)


def causal_depthwise_conv(u, w):
    taps = w.shape[0]
    return lax.conv_general_dilated(u, w[:, None, :], window_strides=(1,), padding=[(taps - 1, 0)],
                                    dimension_numbers=('NWC', 'WIO', 'NWC'), feature_group_count=u.shape[-1])


def gated_delta_rule(q, k, v, g, beta):
    b, s, h, dk = q.shape
    dv = v.shape[-1]
    c = DN_CHUNK
    n = s // c

    def chunks(t):
        return t.reshape(b, n, c, h, -1).transpose(0, 1, 3, 2, 4)

    q = chunks(q) * (dk ** -0.5)
    k = chunks(k)
    v = chunks(v)
    beta = chunks(beta[..., None])[..., 0]
    g = jnp.cumsum(chunks(g[..., None])[..., 0], axis=-1)
    causal = jnp.tril(jnp.ones((c, c), bool))
    strict = jnp.tril(jnp.ones((c, c), bool), -1)
    decay = jnp.exp(jnp.where(causal, g[..., :, None] - g[..., None, :], -jnp.inf))
    k_beta = k * beta[..., None]
    lower = jnp.where(strict, jnp.einsum('bnhid,bnhjd->bnhij', k_beta, k) * decay, 0.0) + jnp.eye(c, dtype=jnp.float32)
    rhs = jnp.concatenate([v * beta[..., None], k_beta * jnp.exp(g)[..., None]], axis=-1)
    uw = lax.linalg.triangular_solve(lower, rhs, left_side=True, lower=True, unit_diagonal=True)
    u, w = uw[..., :dv], uw[..., dv:]
    attn = jnp.where(causal, jnp.einsum('bnhid,bnhjd->bnhij', q, k) * decay, 0.0)
    q_dec = q * jnp.exp(g)[..., None]
    g_last = g[..., -1]
    k_dec = k * jnp.exp(g_last[..., None] - g)[..., None]

    def step(state, inp):
        q_c, k_c, u_c, w_c, a_c, gl = inp
        v_new = u_c - jnp.einsum('bhck,bhkv->bhcv', w_c, state)
        o = jnp.einsum('bhck,bhkv->bhcv', q_c, state) + jnp.einsum('bhij,bhjv->bhiv', a_c, v_new)
        state = state * jnp.exp(gl)[..., None, None] + jnp.einsum('bhck,bhcv->bhkv', k_c, v_new)
        return state, o

    mv = lambda t: jnp.moveaxis(t, 1, 0)
    s0 = jnp.zeros((b, h, dk, dv), jnp.float32)
    _, o = lax.scan(step, s0, (mv(q_dec), mv(k_dec), mv(u), mv(w), mv(attn), mv(g_last)))
    return o.transpose(1, 0, 3, 2, 4).reshape(b, s, h, dv)


def gated_deltanet(qkv_raw, z_gate, b_raw, a_raw, conv_w, a_log, dt_bias, norm_w):
    b, s, _ = qkv_raw.shape
    qkv = jax.nn.silu(causal_depthwise_conv(qkv_raw, conv_w)).astype(jnp.float32)
    q, k, v = jnp.split(qkv, 3, axis=-1)
    shp = (b, s, DN_HEADS, DN_HEAD_DIM)
    q = l2_norm(q.reshape(shp))
    k = l2_norm(k.reshape(shp))
    v = v.reshape(shp)
    beta = jax.nn.sigmoid(b_raw.astype(jnp.float32))
    g = -jnp.exp(a_log.astype(jnp.float32)) * jax.nn.softplus(a_raw.astype(jnp.float32) + dt_bias.astype(jnp.float32))
    o = gated_delta_rule(q, k, v, g, beta)
    o = o * lax.rsqrt(jnp.mean(o * o, axis=-1, keepdims=True) + NORM_EPS) * norm_w.astype(jnp.float32)
    o = o * jax.nn.silu(z_gate.astype(jnp.float32).reshape(shp))
    return o.reshape(b, s, DN_WIDTH).astype(qkv_raw.dtype)


def s5_mixer(u, a_re, a_im, log_dt, b_re, b_im, c_re, c_im, d_skip, glu_w, glu_b):
    b, s, _ = u.shape
    uf = u.astype(jnp.float32).reshape(b, s, S5_GROUPS, S5_GROUP_CH)
    lam = lax.complex(a_re.astype(jnp.float32), a_im.astype(jnp.float32))
    dt = jnp.exp(log_dt.astype(jnp.float32))[:, None]
    a_bar = jnp.exp(lam * dt)
    b_c = lax.complex(b_re.astype(jnp.float32), b_im.astype(jnp.float32))
    b_bar = ((a_bar - 1.0) / lam)[..., None] * b_c
    bu = jnp.einsum('bsgh,gph->bsgp', uf.astype(jnp.complex64), b_bar)
    a_seq = jnp.broadcast_to(a_bar, bu.shape)

    def combine(e1, e2):
        a1, x1 = e1
        a2, x2 = e2
        return a1 * a2, a2 * x1 + x2

    _, states = lax.associative_scan(combine, (a_seq, bu), axis=1)
    c_c = lax.complex(c_re.astype(jnp.float32), c_im.astype(jnp.float32))
    y = jnp.real(jnp.einsum('bsgp,ghp->bsgh', states, c_c))
    y = y + d_skip.astype(jnp.float32).reshape(S5_GROUPS, S5_GROUP_CH) * uf
    y = jax.nn.gelu(y.reshape(b, s, S5_WIDTH)).astype(u.dtype)
    return y * jax.nn.sigmoid(y @ glu_w + glu_b)


def setup_inputs(seed: int = 0) -> dict:
    key = jax.random.key(seed)
    ks = iter(jax.random.split(key, 40))
    f32 = jnp.float32

    def nrm(shape, scale):
        return scale * jax.random.normal(next(ks), shape, f32)

    def gain(width=D_MODEL):
        return 1.0 + nrm((DEPTH, width), 0.02)

    x = nrm((BATCH, SEQ, D_MODEL), 1.0)
    ff1_norm_pre = gain()
    ff1_w_gate = nrm((DEPTH, D_MODEL, D_FF), D_MODEL ** -0.5)
    ff1_w_up = nrm((DEPTH, D_MODEL, D_FF), D_MODEL ** -0.5)
    ff1_w_down = nrm((DEPTH, D_FF, D_MODEL), D_FF ** -0.5)
    ff1_norm_post = gain()
    mix_norm_pre = gain()
    w_in = nrm((DEPTH, D_MODEL, IN_WIDTH), D_MODEL ** -0.5)
    attn_sinks = nrm((DEPTH, ATTN_HEADS), 0.5)
    dn_conv_w = nrm((DEPTH, DN_CONV, 3 * DN_WIDTH), DN_CONV ** -0.5)
    dn_a_log = jnp.log(jax.random.uniform(next(ks), (DEPTH, DN_HEADS), f32, 1.0, 16.0))
    dn_dt = jnp.exp(jax.random.uniform(next(ks), (DEPTH, DN_HEADS), f32, math.log(1e-3), math.log(1e-1)))
    dn_dt_bias = dn_dt + jnp.log(-jnp.expm1(-dn_dt))
    dn_norm_w = gain(DN_HEAD_DIM)
    s5_a_re = -0.5 + nrm((DEPTH, S5_GROUPS, S5_STATE), 0.01)
    s5_a_im = math.pi * jnp.arange(S5_STATE, dtype=f32)[None, None, :] + nrm((DEPTH, S5_GROUPS, S5_STATE), 0.01)
    s5_log_dt = jax.random.uniform(next(ks), (DEPTH, S5_GROUPS), f32, math.log(1e-3), math.log(1e-1))
    s5_b_re = nrm((DEPTH, S5_GROUPS, S5_STATE, S5_GROUP_CH), (2 * S5_GROUP_CH) ** -0.5)
    s5_b_im = nrm((DEPTH, S5_GROUPS, S5_STATE, S5_GROUP_CH), (2 * S5_GROUP_CH) ** -0.5)
    s5_c_re = nrm((DEPTH, S5_GROUPS, S5_GROUP_CH, S5_STATE), (2 * S5_STATE) ** -0.5)
    s5_c_im = nrm((DEPTH, S5_GROUPS, S5_GROUP_CH, S5_STATE), (2 * S5_STATE) ** -0.5)
    s5_d = nrm((DEPTH, S5_WIDTH), 1.0)
    s5_glu_w = nrm((DEPTH, S5_WIDTH, S5_WIDTH), S5_WIDTH ** -0.5)
    s5_glu_b = nrm((DEPTH, S5_WIDTH), 0.01)
    w_out = nrm((DEPTH, MIX_WIDTH, D_MODEL), MIX_WIDTH ** -0.5)
    mix_norm_post = gain()
    ff2_norm_pre = gain()
    ff2_w_gate = nrm((DEPTH, D_MODEL, D_FF), D_MODEL ** -0.5)
    ff2_w_up = nrm((DEPTH, D_MODEL, D_FF), D_MODEL ** -0.5)
    ff2_w_down = nrm((DEPTH, D_FF, D_MODEL), D_FF ** -0.5)
    ff2_norm_post = gain()
    return {"x": x, "ff1_norm_pre": ff1_norm_pre, "ff1_w_gate": ff1_w_gate, "ff1_w_up": ff1_w_up,
            "ff1_w_down": ff1_w_down, "ff1_norm_post": ff1_norm_post, "mix_norm_pre": mix_norm_pre,
            "w_in": w_in, "attn_sinks": attn_sinks, "dn_conv_w": dn_conv_w, "dn_a_log": dn_a_log,
            "dn_dt_bias": dn_dt_bias, "dn_norm_w": dn_norm_w, "s5_a_re": s5_a_re, "s5_a_im": s5_a_im,
            "s5_log_dt": s5_log_dt, "s5_b_re": s5_b_re, "s5_b_im": s5_b_im, "s5_c_re": s5_c_re,
            "s5_c_im": s5_c_im, "s5_d": s5_d, "s5_glu_w": s5_glu_w, "s5_glu_b": s5_glu_b, "w_out": w_out,
            "mix_norm_post": mix_norm_post, "ff2_norm_pre": ff2_norm_pre, "ff2_w_gate": ff2_w_gate,
            "ff2_w_up": ff2_w_up, "ff2_w_down": ff2_w_down, "ff2_norm_post": ff2_norm_post}


def reference(x, ff1_norm_pre, ff1_w_gate, ff1_w_up, ff1_w_down, ff1_norm_post, mix_norm_pre, w_in,
              attn_sinks, dn_conv_w, dn_a_log, dn_dt_bias, dn_norm_w, s5_a_re, s5_a_im, s5_log_dt,
              s5_b_re, s5_b_im, s5_c_re, s5_c_im, s5_d, s5_glu_w, s5_glu_b, w_out, mix_norm_post,
              ff2_norm_pre, ff2_w_gate, ff2_w_up, ff2_w_down, ff2_norm_post):
    b, s, _ = x.shape
    cos, sin = rope_tables(s)
    offsets = np.cumsum(IN_SPLITS)[:-1].tolist()
    for l in range(DEPTH):
        h = rms_norm(x, ff1_norm_pre[l])
        x = x + FFN_RES_WEIGHT * rms_norm(swiglu(h, ff1_w_gate[l], ff1_w_up[l], ff1_w_down[l]), ff1_norm_post[l])
        h = rms_norm(x, mix_norm_pre[l])
        z = h @ w_in[l]
        aq, ak, av, dn_qkv, dn_z, dn_b, dn_a, s5_u = jnp.split(z, offsets, axis=-1)
        aq = apply_rope(aq.reshape(b, s, ATTN_HEADS, HEAD_DIM), cos, sin)
        ak = apply_rope(ak.reshape(b, s, ATTN_KV_HEADS, HEAD_DIM), cos, sin)
        av = av.reshape(b, s, ATTN_KV_HEADS, HEAD_DIM)
        y_attn = sliding_window_attention(aq, ak, av, attn_sinks[l])
        y_dn = gated_deltanet(dn_qkv, dn_z, dn_b, dn_a, dn_conv_w[l], dn_a_log[l],
                              dn_dt_bias[l], dn_norm_w[l])
        y_s5 = s5_mixer(s5_u, s5_a_re[l], s5_a_im[l], s5_log_dt[l], s5_b_re[l], s5_b_im[l],
                        s5_c_re[l], s5_c_im[l], s5_d[l], s5_glu_w[l], s5_glu_b[l])
        mixed = jnp.concatenate([y_attn, y_dn, y_s5], axis=-1) @ w_out[l]
        x = x + rms_norm(mixed, mix_norm_post[l])
        h = rms_norm(x, ff2_norm_pre[l])
        x = x + FFN_RES_WEIGHT * rms_norm(swiglu(h, ff2_w_gate[l], ff2_w_up[l], ff2_w_down[l]), ff2_norm_post[l])
    return x
```

```cpp
#include <hip/hip_runtime.h>
#include <cstdio>
#include <cstdint>
#ifndef PROBE_DBL_MASK
#define PROBE_DBL_MASK 0
#endif
#ifndef FAST_DN
#define FAST_DN 1
#endif
#ifndef FAST_S5
#define FAST_S5 1
#endif
#ifndef FAST_ATTN
#define FAST_ATTN 1
#endif
namespace pg8 {
#define PG8_LAS __attribute__((address_space(3)))
typedef unsigned short bf16_t;
typedef short bf16x8 __attribute__((ext_vector_type(8)));
typedef float f32x4 __attribute__((ext_vector_type(4)));
typedef unsigned u32x4 __attribute__((ext_vector_type(4)));
constexpr int BM = 256, BK = 64, HALF = 128, HTB = HALF * BK * 2  , STAGE_BYTES = 8 * HTB, NXCD = 8, WGM = 8;

__host__ __device__ __forceinline__ int lds_byte(int r, int c) { const int st = (r >> 4) * 2 + (c >> 5), rr = r & 15, cc = c & 31, ob = rr * 64 + cc * 2; return st * 1024 + (ob ^ (((ob >> 9) & 1) << 5)); }
__host__ __device__ __forceinline__ void stage_rc(int b, int& R, int& C) { const int st = b / 1024, sb = b % 1024, swz = sb ^ (((sb >> 9) & 1) << 5); R = (st >> 1) * 16 + swz / 64; C = (st & 1) * 32 + (swz % 64) / 2; }
__host__ __device__ __forceinline__ int perm32(int rho) { const int n = rho >> 4, i = rho & 15; return 8 * (i >> 2) + 4 * n + (i & 3); }

struct Unit { int pm, pn; };
struct Gemm { const bf16_t* A; const bf16_t* Bt; int M, N, K; };

struct StaticOrder {
    int nM, nN, nwg, G, c;
    __host__ __device__ void init(int M, int N, int G_, int c_) { nM = M / BM; nN = N / BM; nwg = nM * nN; G = G_; c = c_; }
    __host__ __device__ bool next(int i, Unit& u) const {
        const long L = (long)i * G + c; if (L >= nwg) return false;
        int wgid = (int)L; { const int q = nwg / NXCD, r = nwg % NXCD, xcd = wgid % NXCD, off = wgid / NXCD; wgid = (xcd < r ? xcd * (q + 1) : r * (q + 1) + (xcd - r) * q) + off; }
        const int nig = WGM * nN, gid = wgid / nig, fm = gid * WGM, gsz = (nM - fm) < WGM ? (nM - fm) : WGM;
        u.pm = fm + ((wgid % nig) % gsz); u.pn = (wgid % nig) / gsz; return true;
    }
    __device__ __forceinline__ void a_ready(const Unit&) const {}
    __device__ __forceinline__ void done(const Unit&) const {}
};
__device__ __forceinline__ unsigned cvt_pk_bf16(float lo, float hi) { unsigned r; asm volatile("v_cvt_pk_bf16_f32 %0, %1, %2" : "=v"(r) : "v"(lo), "v"(hi)); return r; }
typedef float f32x2 __attribute__((ext_vector_type(2)));
__device__ __forceinline__ float fast_sigmoid(float x) { return __builtin_amdgcn_rcpf(1.0f + __expf(-x)); }
__device__ __forceinline__ float silu_f(float x) { return x * fast_sigmoid(x); }
struct EpiF32 {
    static constexpr bool PERM = false, AFTER_DRAIN = false;
    float* C; int ldc;
    __device__ __forceinline__ void operator()(const f32x4 (&acc)[2][2][4][2], const Unit& u, int wr, int wc, int fr, int fq) const {
        const int row0 = u.pm * BM + wr * 64 + fr, col0 = u.pn * BM + wc * 32 + 4 * fq;
#pragma unroll
        for (int ai = 0; ai < 2; ++ai)
#pragma unroll
            for (int m = 0; m < 4; ++m) { float* rowp = C + (size_t)(row0 + ai * HALF + m * 16) * ldc + col0;
#pragma unroll
                for (int bj = 0; bj < 2; ++bj)
#pragma unroll
                    for (int n = 0; n < 2; ++n) *(f32x4*)(rowp + bj * HALF + n * 16) = acc[ai][bj][m][n]; }
    }
};
struct EpiBf16P {
    static constexpr bool PERM = true, AFTER_DRAIN = false;
    bf16_t* O; int ldc;
    __device__ __forceinline__ void operator()(const f32x4 (&acc)[2][2][4][2], const Unit& u, int wr, int wc, int fr, int fq) const {
        const int row0 = u.pm * BM + wr * 64 + fr, col0 = u.pn * BM + wc * 32 + 8 * fq;
#pragma unroll
        for (int ai = 0; ai < 2; ++ai)
#pragma unroll
            for (int m = 0; m < 4; ++m) { bf16_t* rowp = O + (size_t)(row0 + ai * HALF + m * 16) * ldc + col0;
#pragma unroll
                for (int bj = 0; bj < 2; ++bj) { const f32x4 v0 = acc[ai][bj][m][0], v1 = acc[ai][bj][m][1];
                    u32x4 w; w.x = cvt_pk_bf16(v0[0], v0[1]); w.y = cvt_pk_bf16(v0[2], v0[3]); w.z = cvt_pk_bf16(v1[0], v1[1]); w.w = cvt_pk_bf16(v1[2], v1[3]);
                    *(u32x4*)(rowp + bj * HALF) = w; } }
    }
};
struct EpiSwiGLU {
    static constexpr bool PERM = true, AFTER_DRAIN = false;
    bf16_t* O; int ldc;
    __device__ __forceinline__ void operator()(const f32x4 (&acc)[2][2][4][2], const Unit& u, int wr, int wc, int fr, int fq) const {
        const int row0 = u.pm * BM + wr * 64 + fr, col0 = u.pn * HALF + wc * 32 + 8 * fq;
#pragma unroll
        for (int ai = 0; ai < 2; ++ai)
#pragma unroll
            for (int m = 0; m < 4; ++m) { bf16_t* rowp = O + (size_t)(row0 + ai * HALF + m * 16) * ldc + col0;
                const f32x4 g0 = acc[ai][0][m][0], g1 = acc[ai][0][m][1], u0 = acc[ai][1][m][0], u1 = acc[ai][1][m][1];
                f32x4 v0, v1;
#pragma unroll
                for (int j = 0; j < 4; ++j) { v0[j] = silu_f(g0[j]) * u0[j]; v1[j] = silu_f(g1[j]) * u1[j]; }
                u32x4 w; w.x = cvt_pk_bf16(v0[0], v0[1]); w.y = cvt_pk_bf16(v0[2], v0[3]); w.z = cvt_pk_bf16(v1[0], v1[1]); w.w = cvt_pk_bf16(v1[2], v1[3]);
                *(u32x4*)rowp = w; }
    }
};
struct EpiGlu {
    static constexpr bool PERM = true, AFTER_DRAIN = false;
    const float* Y; int ldy; const float* bias; bf16_t* O; int ldo; int ocol0;
    __device__ __forceinline__ void operator()(const f32x4 (&acc)[2][2][4][2], const Unit& u, int wr, int wc, int fr, int fq) const {
        const int row0 = u.pm * BM + wr * 64 + fr, col0 = u.pn * BM + wc * 32 + 8 * fq;
#pragma unroll
        for (int ai = 0; ai < 2; ++ai)
#pragma unroll
            for (int m = 0; m < 4; ++m) { const int row = row0 + ai * HALF + m * 16;
#pragma unroll
                for (int bj = 0; bj < 2; ++bj) { const int c = col0 + bj * HALF;
                    const f32x4 y0 = *(const f32x4*)(Y + (size_t)row * ldy + c), y1 = *(const f32x4*)(Y + (size_t)row * ldy + c + 4);
                    const f32x4 b0 = *(const f32x4*)(bias + c), b1 = *(const f32x4*)(bias + c + 4);
                    f32x4 v0, v1;
#pragma unroll
                    for (int j = 0; j < 4; ++j) { v0[j] = y0[j] * fast_sigmoid(acc[ai][bj][m][0][j] + b0[j]); v1[j] = y1[j] * fast_sigmoid(acc[ai][bj][m][1][j] + b1[j]); }
                    u32x4 w; w.x = cvt_pk_bf16(v0[0], v0[1]); w.y = cvt_pk_bf16(v0[2], v0[3]); w.z = cvt_pk_bf16(v1[0], v1[1]); w.w = cvt_pk_bf16(v1[2], v1[3]);
                    *(u32x4*)(O + (size_t)row * ldo + ocol0 + c) = w; } }
    }
};
template <class Epi, class Sched, bool ALIGN_EPI = false, bool SP2 = false>
__device__ __forceinline__ void gemm_phase(PG8_LAS unsigned char* lds, const Gemm g, const Sched& S, const Epi& E) {
    int tid_ = threadIdx.x; asm volatile("" : "+v"(tid_));
    const int tid = tid_, wid = __builtin_amdgcn_readfirstlane(tid >> 6), lane = tid & 63, wr = wid >> 2, wc = wid & 3, fr = lane & 15, fq = lane >> 4;
    const int K = g.K, nt = K / BK;
    unsigned voffA[2], voffB[2];
#pragma unroll
    for (int i = 0; i < 2; ++i) { int R, C; stage_rc(tid * 16 + i * 8192, R, C); const int Rb = Epi::PERM ? ((R & ~31) + perm32(R & 31)) : R;
        voffA[i] = (unsigned)(R * K + C) * 2u; voffB[i] = (unsigned)(Rb * K + C) * 2u; }
    const size_t kstep = (size_t)(BK * 2);
    const size_t hstep = (size_t)HALF * K * 2;
    const size_t tstep = 2 * hstep;
    const unsigned ldsw = (unsigned)wid * 1024u;
    const int aoff = lds_byte(wr * 64 + fr, fq * 8), boff = lds_byte(wc * 32 + fr, fq * 8);
#define PG8_SA(b, h) (((b) * 2 + (h)) * HTB)
#define PG8_SB(b, h) ((4 + (b) * 2 + (h)) * HTB)
#define PG8_STAGE(bufoff, gbase, voff) do { _Pragma("unroll") for (int _i = 0; _i < 2; ++_i) \
        __builtin_amdgcn_global_load_lds((const unsigned*)((const char*)(gbase) + (voff)[_i]), (PG8_LAS unsigned*)(lds + (bufoff) + ldsw + _i * 8192), 16, 0, 0); } while (0)
#define PG8_LDA(dst, b, h) do { _Pragma("unroll") for (int m = 0; m < 4; ++m) _Pragma("unroll") for (int k = 0; k < 2; ++k) dst[m][k] = *(const PG8_LAS bf16x8*)(lds + PG8_SA(b, h) + aoff + m * 2048 + k * 1024); } while (0)
#define PG8_LDB(dst, b, h) do { _Pragma("unroll") for (int n = 0; n < 2; ++n) _Pragma("unroll") for (int k = 0; k < 2; ++k) dst[n][k] = *(const PG8_LAS bf16x8*)(lds + PG8_SB(b, h) + boff + n * 2048 + k * 1024); } while (0)
#define PG8_MMA(ai, bj, At, Bt) do { __builtin_amdgcn_s_setprio(1); _Pragma("unroll") for (int m = 0; m < 4; ++m) _Pragma("unroll") for (int n = 0; n < 2; ++n) _Pragma("unroll") for (int k = 0; k < 2; ++k) \
        acc[ai][bj][m][n] = __builtin_amdgcn_mfma_f32_16x16x32_bf16(Bt[n][k], At[m][k], acc[ai][bj][m][n], 0, 0, 0); __builtin_amdgcn_s_setprio(0); } while (0)
#define PG8_WAIT_V(n) asm volatile("s_waitcnt vmcnt(" #n ")" ::: "memory")
#define PG8_WAIT_L(n) asm volatile("s_waitcnt lgkmcnt(" #n ")" ::: "memory")
#define PG8_BAR __builtin_amdgcn_s_barrier()
#define PG8_SCHED __builtin_amdgcn_sched_barrier(0)
    Unit cur, nxt; int ui = 0;
    if (!S.next(0, cur)) return;
    f32x4 acc[2][2][4][2];
#pragma unroll
    for (int a = 0; a < 2; ++a)
#pragma unroll
        for (int b = 0; b < 2; ++b)
#pragma unroll
            for (int m = 0; m < 4; ++m)
#pragma unroll
                for (int n = 0; n < 2; ++n) acc[a][b][m][n] = (f32x4){0.f, 0.f, 0.f, 0.f};
    bf16x8 At[4][2], B0[2][2], B1[2][2];
    const char* cA = (const char*)g.A + (size_t)cur.pm * tstep; const char* cB = (const char*)g.Bt + (size_t)cur.pn * tstep;
    S.a_ready(cur);
    if constexpr (SP2) {
        PG8_STAGE(PG8_SB(0, 0), cB, voffB); PG8_STAGE(PG8_SB(0, 1), cB + hstep, voffB); PG8_STAGE(PG8_SA(0, 0), cA, voffA); PG8_STAGE(PG8_SA(0, 1), cA + hstep, voffA);
        if (wr == 1) PG8_BAR;
        PG8_WAIT_V(2); PG8_BAR;
        PG8_STAGE(PG8_SB(1, 0), cB + kstep, voffB); PG8_STAGE(PG8_SA(1, 0), cA + kstep, voffA); PG8_STAGE(PG8_SB(1, 1), cB + hstep + kstep, voffB);
        PG8_WAIT_V(6); PG8_BAR;
    } else {
        PG8_STAGE(PG8_SB(0, 0), cB, voffB); PG8_STAGE(PG8_SA(0, 0), cA, voffA); PG8_STAGE(PG8_SB(0, 1), cB + hstep, voffB); PG8_STAGE(PG8_SA(0, 1), cA + hstep, voffA);
        if (wr == 1) PG8_BAR;
        PG8_WAIT_V(4); PG8_BAR;
        PG8_STAGE(PG8_SB(1, 0), cB + kstep, voffB); PG8_STAGE(PG8_SA(1, 0), cA + kstep, voffA); PG8_STAGE(PG8_SB(1, 1), cB + hstep + kstep, voffB);
        PG8_WAIT_V(6); PG8_BAR;
    }
    for (;;) {
        const bool has_next = S.next(ui + 1, nxt);
        const char* nA = has_next ? (const char*)g.A + (size_t)nxt.pm * tstep : cA; const char* nB = has_next ? (const char*)g.Bt + (size_t)nxt.pn * tstep : cB;
        for (int t = 0; t < nt; t += 2) {
            const bool last = (t == nt - 2);
            const char* a1 = cA + (size_t)(t + 1) * kstep;
            const char* a2 = last ? nA : cA + (size_t)(t + 2) * kstep; const char* b2 = last ? nB : cB + (size_t)(t + 2) * kstep;
            const char* a3 = a2 + kstep; const char* b3 = b2 + kstep;
            if (last && has_next) S.a_ready(nxt);
            if constexpr (SP2) {
            PG8_LDB(B0, 0, 0); PG8_LDB(B1, 0, 1); PG8_SCHED; PG8_LDA(At, 0, 0); PG8_STAGE(PG8_SA(1, 1), a1 + hstep, voffA);
            PG8_WAIT_V(8); PG8_WAIT_L(0); PG8_BAR; PG8_MMA(0, 0, At, B0); PG8_MMA(0, 1, At, B1); PG8_BAR; PG8_SCHED;
            PG8_LDA(At, 0, 1); PG8_STAGE(PG8_SB(0, 0), b2, voffB); PG8_STAGE(PG8_SB(0, 1), b2 + hstep, voffB); PG8_STAGE(PG8_SA(0, 0), a2, voffA);
            PG8_WAIT_V(8); PG8_WAIT_L(0); PG8_BAR; PG8_MMA(1, 0, At, B0); PG8_MMA(1, 1, At, B1); PG8_BAR; PG8_SCHED;
            PG8_LDB(B0, 1, 0); PG8_LDB(B1, 1, 1); PG8_SCHED; PG8_LDA(At, 1, 0); PG8_STAGE(PG8_SA(0, 1), a2 + hstep, voffA);
            PG8_WAIT_V(8); PG8_WAIT_L(0); PG8_BAR; PG8_MMA(0, 0, At, B0); PG8_MMA(0, 1, At, B1); PG8_BAR; PG8_SCHED;
            PG8_LDA(At, 1, 1); PG8_STAGE(PG8_SB(1, 0), b3, voffB); PG8_STAGE(PG8_SB(1, 1), b3 + hstep, voffB); PG8_STAGE(PG8_SA(1, 0), a3, voffA);
            PG8_WAIT_V(8); PG8_WAIT_L(0); PG8_BAR; PG8_MMA(1, 0, At, B0); PG8_MMA(1, 1, At, B1); PG8_BAR; PG8_SCHED;
            } else {
            PG8_LDB(B0, 0, 0); PG8_SCHED; PG8_LDA(At, 0, 0); PG8_STAGE(PG8_SA(1, 1), a1 + hstep, voffA);
            PG8_WAIT_L(8); PG8_BAR; PG8_WAIT_L(0); PG8_MMA(0, 0, At, B0); PG8_BAR; PG8_SCHED;
            PG8_LDB(B1, 0, 1); PG8_STAGE(PG8_SB(0, 0), b2, voffB);
            PG8_BAR; PG8_WAIT_L(0); PG8_MMA(0, 1, At, B1); PG8_BAR;
            PG8_LDA(At, 0, 1); PG8_STAGE(PG8_SA(0, 0), a2, voffA);
            PG8_BAR; PG8_WAIT_L(0); PG8_MMA(1, 0, At, B0); PG8_BAR; PG8_SCHED;
            PG8_STAGE(PG8_SB(0, 1), b2 + hstep, voffB);
            PG8_WAIT_V(6); PG8_BAR; PG8_MMA(1, 1, At, B1); PG8_BAR;
            PG8_LDB(B0, 1, 0); PG8_SCHED; PG8_LDA(At, 1, 0); PG8_STAGE(PG8_SA(0, 1), a2 + hstep, voffA);
            PG8_WAIT_L(8); PG8_BAR; PG8_WAIT_L(0); PG8_MMA(0, 0, At, B0); PG8_BAR; PG8_SCHED;
            PG8_LDB(B1, 1, 1); PG8_STAGE(PG8_SB(1, 0), b3, voffB);
            PG8_BAR; PG8_WAIT_L(0); PG8_MMA(0, 1, At, B1); PG8_BAR;
            PG8_LDA(At, 1, 1); PG8_STAGE(PG8_SA(1, 0), a3, voffA);
            PG8_BAR; PG8_WAIT_L(0); PG8_MMA(1, 0, At, B0); PG8_BAR; PG8_SCHED;
            PG8_STAGE(PG8_SB(1, 1), b3 + hstep, voffB);
            PG8_WAIT_V(6); PG8_BAR; PG8_MMA(1, 1, At, B1); PG8_BAR;
            }
        }
        if constexpr (ALIGN_EPI) { if (wr == 0) PG8_BAR; }
        if constexpr (!Epi::AFTER_DRAIN) { E(acc, cur, wr, wc, fr, fq); S.done(cur); }
        if (!has_next) break;
#pragma unroll
        for (int a = 0; a < 2; ++a)
#pragma unroll
            for (int b = 0; b < 2; ++b)
#pragma unroll
                for (int m = 0; m < 4; ++m)
#pragma unroll
                    for (int n = 0; n < 2; ++n) acc[a][b][m][n] = (f32x4){0.f, 0.f, 0.f, 0.f};
        cur = nxt; cA = nA; cB = nB; ++ui;
        if constexpr (ALIGN_EPI) { if (wr == 1) PG8_BAR; }
    }
    PG8_WAIT_V(0);
    if constexpr (!ALIGN_EPI) { if (wr == 0) PG8_BAR; }
    PG8_BAR;
    if constexpr (Epi::AFTER_DRAIN) { E.fused(acc, cur, wr, wc, fr, fq, lds, wid, lane); S.done(cur); }
#undef PG8_SA
#undef PG8_SB
#undef PG8_STAGE
#undef PG8_LDA
#undef PG8_LDB
#undef PG8_MMA
#undef PG8_WAIT_V
#undef PG8_WAIT_L
#undef PG8_BAR
#undef PG8_SCHED
}
}
#ifndef MK_MULTI
#define MK_MULTI 0
#endif
constexpr int NWAVES = 8;
constexpr int BATCH = 2, SEQ = 4096, M = BATCH * SEQ, D = 2048, FF = 5632, DEPTH = 4;
constexpr int ZW = 4096, INW = 4104, MIXW = 2048;
constexpr int Z_AQ = 0, Z_AK = 1024, Z_AV = 1280, Z_DQKV = 1536, Z_DZ = 3072, Z_S5 = 3584;
constexpr int SRC_AB = 3584, SRC_S5 = 3592;
constexpr float NORM_EPS = 1e-6f;
constexpr size_t al256(size_t x) { return (x + 255) & ~(size_t)255; }
constexpr size_t MiB = 1u << 20;
constexpr size_t WS_CTL = 0, CTL_ZERO_BYTES = 1 * MiB;
constexpr size_t SZ_WGU = (size_t)2 * FF * D * 2, SZ_WD = (size_t)D * FF * 2, SZ_WIN = (size_t)ZW * D * 2, SZ_WOUT = (size_t)D * MIXW * 2, SZ_WGLU = (size_t)512 * 512 * 2;
constexpr size_t SZ_LAYER_W = 2 * SZ_WGU + 2 * SZ_WD + SZ_WIN + SZ_WOUT + SZ_WGLU;
constexpr size_t OFF_WGU1 = 0, OFF_WD1 = OFF_WGU1 + SZ_WGU, OFF_WIN = OFF_WD1 + SZ_WD, OFF_WOUT = OFF_WIN + SZ_WIN, OFF_WGU2 = OFF_WOUT + SZ_WOUT, OFF_WD2 = OFF_WGU2 + SZ_WGU, OFF_WGLU = OFF_WD2 + SZ_WD;
constexpr size_t WS_ROPE = WS_CTL + CTL_ZERO_BYTES;
constexpr size_t WS_W = WS_ROPE + 2 * MiB;
constexpr size_t WS_H = al256(WS_W + DEPTH * SZ_LAYER_W);
constexpr size_t WS_ACT = WS_H + (size_t)M * D * 2;
constexpr size_t WS_Y = WS_ACT + (size_t)M * FF * 2;
constexpr size_t WS_Z = WS_Y + (size_t)M * D * 4;
constexpr size_t WS_MIXED = WS_Z + (size_t)M * ZW * 2;
constexpr size_t WS_AB = WS_MIXED + (size_t)M * MIXW * 2;
constexpr size_t WS_BG = WS_AB + (size_t)M * 8 * 4;
constexpr size_t WS_KR = WS_BG + (size_t)M * 8 * 4;
constexpr size_t WS_QN = WS_KR + (size_t)M * 256 * 4;
constexpr size_t WS_KN = WS_QN + (size_t)M * 512 * 4;
constexpr size_t WS_VC = WS_KN + (size_t)M * 512 * 4;
constexpr size_t WS_ORAW = WS_VC + (size_t)M * 512 * 4;
constexpr size_t WS_YS = WS_ORAW + (size_t)M * 512 * 4;
constexpr size_t WS_YSB = WS_YS + (size_t)M * 512 * 4;
constexpr size_t WS_S5T = WS_YSB + (size_t)M * 512 * 2;
constexpr size_t WS_S5E = WS_S5T + (size_t)DEPTH * 32 * 140288;
constexpr size_t WS_DNC = WS_S5E + (size_t)2 * 16 * 32 * 128 * 4;
constexpr size_t WS_END = WS_DNC + (size_t)512 * 106752;
static_assert(WS_KN == WS_QN + (size_t)M * 512 * 4 && WS_VC == WS_KN + (size_t)M * 512 * 4, "qn | kn | vc consecutive");
constexpr int CW_TMO = 0, CW_CODE = 1, CW_BAR = 4096;
constexpr int RING_OFF = 0, RING_BYTES = 131072;
constexpr int LDS_BYTES = 155648;
constexpr int MISC_OFF = LDS_BYTES - 512;

#define GAS __attribute__((address_space(1)))
#define LAS __attribute__((address_space(3)))
typedef unsigned short bf16;
typedef unsigned v4u __attribute__((ext_vector_type(4)));
typedef unsigned v2u __attribute__((ext_vector_type(2)));
typedef float f32x4 __attribute__((ext_vector_type(4)));
typedef short bf16x8 __attribute__((ext_vector_type(8)));
#define LDS_WAIT() asm volatile("s_waitcnt lgkmcnt(0)" ::: "memory")
#define VM_WAIT() asm volatile("s_waitcnt vmcnt(0)" ::: "memory")
__device__ __forceinline__ unsigned f2bf(float f) { unsigned u = __builtin_bit_cast(unsigned, f); return (u + 0x7fffu + ((u >> 16) & 1u)) >> 16; }
__device__ __forceinline__ unsigned pk2(float lo, float hi) { return f2bf(lo) | (f2bf(hi) << 16); }
__device__ __forceinline__ float bf2f(bf16 b) { return __builtin_bit_cast(float, (unsigned)b << 16); }
__device__ __forceinline__ float bflo(unsigned w) { return __builtin_bit_cast(float, w << 16); }
__device__ __forceinline__ float bfhi(unsigned w) { return __builtin_bit_cast(float, w & 0xffff0000u); }
__device__ __forceinline__ float wave_sum(float v) {
#pragma unroll
    for (int o = 1; o < 64; o <<= 1) v += __shfl_xor(v, o);
    return v;
}
__device__ __forceinline__ float wave_max(float v) {
#pragma unroll
    for (int o = 1; o < 64; o <<= 1) v = fmaxf(v, __shfl_xor(v, o));
    return v;
}
__device__ __forceinline__ float sigmoid_f(float x) { return 1.0f / (1.0f + __expf(-x)); }
__device__ __forceinline__ float gelu_tanh(float x) { const float u = 0.7978845608028654f * (x + 0.044715f * x * x * x); const float e = __expf(2.0f * u); const float th = 1.0f - 2.0f / (e + 1.0f); return 0.5f * x * (1.0f + th); }
#define XB_TMO      128
#define XB_XCNT(j)  (256  + 64 * (j))
#define XB_XSUB(j)  (1280 + 64 * (j))
#define XB_XGEN(j)  (2304 + 64 * (j))
#define XB_TOP      3328
#define XB_TOPGEN   3392
#define XCD_BAR_WORDS 3456
#define XB_SPIN_CAP (1u << 24)

__device__ __forceinline__ unsigned xb_ld(unsigned* p)              { return __hip_atomic_load(p, __ATOMIC_RELAXED, __HIP_MEMORY_SCOPE_AGENT); }
__device__ __forceinline__ unsigned xb_add(unsigned* p, unsigned v) { return __hip_atomic_fetch_add(p, v, __ATOMIC_RELAXED, __HIP_MEMORY_SCOPE_AGENT); }
__device__ __forceinline__ unsigned xb_xcc_id() { return (unsigned)__builtin_amdgcn_s_getreg((3 << 11) | 20) & 0xFu; }
#define XB_SPIN(cond, bar) do { unsigned _sp = 0; while (cond) { __builtin_amdgcn_s_sleep(1); \
    if ((++_sp & 255u) == 0u) { if (xb_ld(&(bar)[XB_TMO])) break; if (_sp > XB_SPIN_CAP) { atomicAdd(&(bar)[XB_TMO], 1u); break; } } } } while (0)

struct XcdBarrier {
    unsigned* bar; unsigned x;
    volatile LAS unsigned* st;
};

__device__ __forceinline__ XcdBarrier xcd_barrier_post(unsigned* bar, volatile LAS unsigned* st) {
    XcdBarrier b; b.bar = bar; b.x = xb_xcc_id(); b.st = st;
    if (threadIdx.x == 0) (void)xb_add(&bar[XB_XCNT(b.x)], 1u);
    return b;
}
__device__ __forceinline__ void xcd_barrier_complete(unsigned* bar, unsigned x, unsigned& nloc, unsigned& nx) {
    const unsigned G = gridDim.x * gridDim.y * gridDim.z;
    unsigned sum, cnt, mine, sp = 0u;
    for (;;) {
        sum = 0u; cnt = 0u; mine = 0u;
#pragma unroll
        for (unsigned j = 0; j < 16; ++j) { const unsigned c = xb_ld(&bar[XB_XCNT(j)]); sum += c; cnt += (c > 0u) ? 1u : 0u; mine = (j == x) ? c : mine; }
        if (sum == G) break;
        __builtin_amdgcn_s_sleep(1);
        if ((++sp & 255u) == 0u) { if (xb_ld(&bar[XB_TMO])) break; if (sp > XB_SPIN_CAP) { atomicAdd(&bar[XB_TMO], 1u); break; } }
    }
    nloc = mine > 0u ? mine : 1u; nx = cnt > 0u ? cnt : 1u;
}

__device__ __forceinline__ void xcd_barrier(const XcdBarrier& b) {
    asm volatile("s_waitcnt vmcnt(0)" ::: "memory");
    __syncthreads();
    if (threadIdx.x == 0) {
        unsigned* bar = b.bar; unsigned bx = b.x;
        asm volatile("" : "+s"(bar), "+s"(bx));
        __builtin_amdgcn_s_waitcnt(0);
        unsigned nloc = b.st[0], nx = b.st[1];
        if (nloc == 0u) { xcd_barrier_complete(bar, bx, nloc, nx); b.st[0] = nloc; b.st[1] = nx; }
        const unsigned old = xb_add(&bar[XB_XSUB(bx)], 1u);
        const unsigned gen = old / nloc;
        if (old + 1u == (gen + 1u) * nloc) {
            __builtin_amdgcn_fence(__ATOMIC_RELEASE, "agent");
            asm volatile("s_waitcnt vmcnt(0)" ::: "memory");
            const unsigned og = xb_add(&bar[XB_TOP], 1u);
            const unsigned tg = og / nx;
            if (og + 1u == (tg + 1u) * nx) xb_add(&bar[XB_TOPGEN], 1u);
            else XB_SPIN(xb_ld(&bar[XB_TOPGEN]) == tg, bar);
            __builtin_amdgcn_fence(__ATOMIC_ACQUIRE, "agent");
            xb_add(&bar[XB_XGEN(bx)], 1u);
            asm volatile("s_waitcnt vmcnt(0)" ::: "memory");
        } else {
            XB_SPIN(xb_ld(&bar[XB_XGEN(bx)]) == gen, bar);
            __builtin_amdgcn_fence(__ATOMIC_ACQUIRE, "agent");
            asm volatile("s_waitcnt vmcnt(0)" ::: "memory");
        }
    }
    __syncthreads();
}
struct Frame {
    LAS unsigned char* lds;
    int bid, wave, G, gw, NGW;
};
#define PHASE_TID() int tid = threadIdx.x; asm volatile("" : "+v"(tid)); const int lane = tid & 63; (void)lane
struct LayerW { const bf16 *wgu1, *wd1, *win, *wout, *wgu2, *wd2, *wglu; };
__device__ __forceinline__ LayerW layer_w(unsigned char* ws, int l) {
    unsigned char* b = ws + WS_W + (size_t)l * SZ_LAYER_W; LayerW w;
    w.wgu1 = (const bf16*)(b + OFF_WGU1); w.wd1 = (const bf16*)(b + OFF_WD1); w.win = (const bf16*)(b + OFF_WIN); w.wout = (const bf16*)(b + OFF_WOUT);
    w.wgu2 = (const bf16*)(b + OFF_WGU2); w.wd2 = (const bf16*)(b + OFF_WD2); w.wglu = (const bf16*)(b + OFF_WGLU); return w;
}
__device__ __forceinline__ void transpose_item(const float* W, int K, int ldw, int sc0, int ncols, bf16* WT, int dr0, int mode, LAS float* scr, int item, int lane) {
    const int nblk = ncols / 32, kb = item / nblk, nb = item % nblk, k0 = 64 * kb, n0 = 32 * nb;
    const float* src = W + (size_t)k0 * ldw + sc0 + n0 + (lane & 31);
#pragma unroll 1
    for (int hf = 0; hf < 2; ++hf) { float tv[16];
#pragma unroll
        for (int i = 0; i < 16; ++i) tv[i] = src[(size_t)(32 * hf + 2 * i + (lane >> 5)) * ldw];
#pragma unroll
        for (int i = 0; i < 16; ++i) scr[(32 * hf + 2 * i + (lane >> 5)) * 33 + (lane & 31)] = tv[i]; }
    LDS_WAIT(); asm volatile("" ::: "memory");
    const int c = lane & 7;
    const int drow0 = (mode == 0) ? (dr0 + n0) : (256 * (n0 >> 7) + dr0 + (n0 & 127));
#pragma unroll
    for (int j = 0; j < 4; ++j) { const int n = (lane >> 3) + 8 * j; const LAS float* s = scr + (8 * c) * 33 + n;
        v4u o; o.x = pk2(s[0 * 33], s[1 * 33]); o.y = pk2(s[2 * 33], s[3 * 33]); o.z = pk2(s[4 * 33], s[5 * 33]); o.w = pk2(s[6 * 33], s[7 * 33]);
        *(GAS v4u*)(WT + (size_t)(drow0 + n) * K + k0 + 8 * c) = o; }
    LDS_WAIT(); asm volatile("" ::: "memory");
}
__device__ __forceinline__ void convert_matrix(Frame& F, const float* W, int K, int ldw, int sc0, int ncols, bf16* WT, int dr0, int mode, int rot) {
    PHASE_TID();
    LAS float* scr = (LAS float*)(F.lds + RING_OFF + F.wave * 16384);
    const int nitems = (K / 64) * (ncols / 32);
    int g = F.gw + rot; if (g >= F.NGW) g -= F.NGW;
    for (int it = g; it < nitems; it += F.NGW) transpose_item(W, K, ldw, sc0, ncols, WT, dr0, mode, scr, it, lane);
}
__device__ __forceinline__ void sincos_rev(double t, float& s, float& c) {
    const double t4 = t * 4.0; const double kd = __builtin_rint(t4); const int k = (int)kd & 3;
    const float y = (float)((t4 - kd) * 1.5707963267948966);
    const float z = y * y;
    const float sp = ((-1.9515295891e-4f * z + 8.3321608736e-3f) * z - 1.6666654611e-1f) * z * y + y;
    const float cp = ((2.443315711809948e-5f * z - 1.388731625493765e-3f) * z + 4.166664568298827e-2f) * z * z - 0.5f * z + 1.0f;
    s = (k == 0) ? sp : (k == 1) ? cp : (k == 2) ? -sp : -cp;
    c = (k == 0) ? cp : (k == 1) ? -sp : (k == 2) ? -cp : sp;
}
__device__ __forceinline__ void rms_row_to_bf16(int lane, const float* xrow, const float* gain, bf16* orow) {
    const GAS f32x4* xr = (const GAS f32x4*)xrow + lane; const GAS f32x4* gr = (const GAS f32x4*)gain + lane;
    f32x4 v[8]; float s = 0.f;
#pragma unroll
    for (int j = 0; j < 8; ++j) { v[j] = xr[64 * j]; s += (v[j].x * v[j].x + v[j].y * v[j].y) + (v[j].z * v[j].z + v[j].w * v[j].w); }
    const float rstd = 1.0f / sqrtf(wave_sum(s) * (1.f / D) + NORM_EPS);
    GAS v2u* o8 = (GAS v2u*)orow + lane;
#pragma unroll
    for (int j = 0; j < 8; ++j) { const f32x4 g = gr[64 * j]; v2u o; o.x = pk2(v[j].x * rstd * g.x, v[j].y * rstd * g.y); o.y = pk2(v[j].z * rstd * g.z, v[j].w * rstd * g.w); o8[64 * j] = o; }
}
template <bool HOUT, bool AB>
__device__ __forceinline__ void norm_phase(Frame& F, const float* y, const float* xsrc, float* xdst, const float* gpost, float rw, const float* gnext, bf16* h, const float* win_l, float* ab) {
    PHASE_TID();
    LAS float* w8 = (LAS float*)(F.lds + RING_OFF);
    if constexpr (AB) {
        for (int i = tid; i < D * 8; i += NWAVES * 64) { const int k = i >> 3, c = i & 7; w8[i] = win_l[(size_t)k * INW + SRC_AB + c]; }
        __syncthreads();
    }
    for (int m = F.gw; m < M; m += F.NGW) {
        asm volatile("" ::: "memory");
        const GAS f32x4* yr = (const GAS f32x4*)(y + (size_t)m * D) + lane; const GAS f32x4* xr = (const GAS f32x4*)(xsrc + (size_t)m * D) + lane;
        const GAS f32x4* gp = (const GAS f32x4*)gpost + lane;
        f32x4 v[8]; float s = 0.f;
#pragma unroll
        for (int j = 0; j < 8; ++j) { v[j] = yr[64 * j]; s += (v[j].x * v[j].x + v[j].y * v[j].y) + (v[j].z * v[j].z + v[j].w * v[j].w); }
        const float rstd = rw / sqrtf(wave_sum(s) * (1.f / D) + NORM_EPS);
        float s2 = 0.f;
        GAS f32x4* xo = (GAS f32x4*)(xdst + (size_t)m * D) + lane;
#pragma unroll
        for (int j = 0; j < 8; ++j) { const f32x4 g = gp[64 * j]; const f32x4 xv = xr[64 * j]; f32x4 o;
            o.x = xv.x + v[j].x * rstd * g.x; o.y = xv.y + v[j].y * rstd * g.y; o.z = xv.z + v[j].z * rstd * g.z; o.w = xv.w + v[j].w * rstd * g.w;
            xo[64 * j] = o; v[j] = o; s2 += (o.x * o.x + o.y * o.y) + (o.z * o.z + o.w * o.w); }
        if constexpr (HOUT) {
            const float r2 = 1.0f / sqrtf(wave_sum(s2) * (1.f / D) + NORM_EPS);
            const GAS f32x4* gn = (const GAS f32x4*)gnext + lane;
            GAS v2u* o8 = (GAS v2u*)(h + (size_t)m * D) + lane;
            float dot[8];
#pragma unroll
            for (int c = 0; c < 8; ++c) dot[c] = 0.f;
#pragma unroll
            for (int j = 0; j < 8; ++j) { const f32x4 g = gn[64 * j]; f32x4 hv; hv.x = v[j].x * r2 * g.x; hv.y = v[j].y * r2 * g.y; hv.z = v[j].z * r2 * g.z; hv.w = v[j].w * r2 * g.w;
                v2u o; o.x = pk2(hv.x, hv.y); o.y = pk2(hv.z, hv.w); o8[64 * j] = o;
                if constexpr (AB) {
                    const LAS f32x4* wp = (const LAS f32x4*)(w8 + (size_t)(j * 256 + lane * 4) * 8);
#pragma unroll
                    for (int e = 0; e < 4; ++e) { const f32x4 wa = wp[2 * e], wb = wp[2 * e + 1]; const float hh = hv[e];
                        dot[0] += hh * wa.x; dot[1] += hh * wa.y; dot[2] += hh * wa.z; dot[3] += hh * wa.w; dot[4] += hh * wb.x; dot[5] += hh * wb.y; dot[6] += hh * wb.z; dot[7] += hh * wb.w; }
                } }
            if constexpr (AB) {
#pragma unroll
                for (int c = 0; c < 8; ++c) dot[c] = wave_sum(dot[c]);
                if (lane == 0) { GAS f32x4* ao = (GAS f32x4*)(ab + (size_t)m * 8); ao[0] = (f32x4){dot[0], dot[1], dot[2], dot[3]}; ao[1] = (f32x4){dot[4], dot[5], dot[6], dot[7]}; }
            }
        }
    }
    if constexpr (AB) __syncthreads();
}
struct MixP {
    const float *sinks, *convw, *a_log, *dt_bias, *dn_norm_w, *s5_a_re, *s5_a_im, *s5_log_dt, *s5_b_re, *s5_b_im, *s5_c_re, *s5_c_im, *s5_d;
    const float *rope_cos, *rope_sin;
    const bf16* z; const float* ab; float* bg; float* kr; float *qn, *kn, *vc; float* oraw; float* ys; bf16* ysb; bf16* mixed;
};
__device__ __forceinline__ void prep_phase(Frame& F, const MixP& P) {
    PHASE_TID();
    for (int t = F.gw; t < M; t += F.NGW) {
        const int pos = t & (SEQ - 1);
        const bf16* zr = P.z + (size_t)t * ZW;
        const float c = P.rope_cos[pos * 64 + lane], s = P.rope_sin[pos * 64 + lane];
#pragma unroll
        for (int hh = 0; hh < 2; ++hh) { const float x1 = bf2f(zr[Z_AK + hh * 128 + lane]), x2 = bf2f(zr[Z_AK + hh * 128 + 64 + lane]);
            P.kr[(size_t)t * 256 + hh * 128 + lane] = x1 * c - x2 * s; P.kr[(size_t)t * 256 + hh * 128 + 64 + lane] = x2 * c + x1 * s; }
#pragma unroll 1
        for (int hc = 0; hc < 12; ++hc) {
            float v0 = 0.f, v1 = 0.f; const int ch = hc * 128 + lane;
#pragma unroll
            for (int k = 0; k < 4; ++k) { const int tp = pos - 3 + k; if (tp >= 0) { const bf16* zq = P.z + (size_t)(t - 3 + k) * ZW + Z_DQKV + ch; const float* cw = P.convw + k * 1536 + ch;
                v0 += cw[0] * bf2f(zq[0]); v1 += cw[64] * bf2f(zq[64]); } }
            v0 = v0 * sigmoid_f(v0); v1 = v1 * sigmoid_f(v1);
            if (hc < 8) { const float r = 1.0f / sqrtf(wave_sum(v0 * v0 + v1 * v1) + NORM_EPS); v0 *= r; v1 *= r; }
            float* dst = P.qn + (size_t)(hc >> 2) * ((size_t)M * 512) + (size_t)t * 512 + (hc & 3) * 128 + lane;
            dst[0] = v0; dst[64] = v1;
        }
        if (lane < 4) { const float br = P.ab[(size_t)t * 8 + lane], ar = P.ab[(size_t)t * 8 + 4 + lane] + P.dt_bias[lane];
            const float sp = fmaxf(ar, 0.f) + log1pf(__expf(-fabsf(ar)));
            P.bg[(size_t)t * 8 + lane] = sigmoid_f(br); P.bg[(size_t)t * 8 + 4 + lane] = -__expf(P.a_log[lane]) * sp; }
    }
}
__device__ __forceinline__ void slow_deltanet(Frame& F, const MixP& P, int bh) {
    PHASE_TID();
    const int b = bh >> 2, h = bh & 3, v = tid & 127, rg = tid >> 7;
    LAS float* qs = (LAS float*)(F.lds + RING_OFF); LAS float* ks = qs + 64 * 128; LAS float* vs = ks + 64 * 128; LAS float* bgs = vs + 64 * 128;
    LAS float* part = bgs + 128; LAS float* part2 = part + 512;
    float S[32];
#pragma unroll
    for (int i = 0; i < 32; ++i) S[i] = 0.f;
    for (int cch = 0; cch < SEQ / 64; ++cch) {
        const int t0 = b * SEQ + cch * 64;
        __syncthreads();
        for (int i = tid; i < 64 * 128; i += 512) { const int r = i >> 7, cc = i & 127; const size_t g = (size_t)(t0 + r) * 512 + h * 128 + cc; qs[i] = P.qn[g]; ks[i] = P.kn[g]; vs[i] = P.vc[g]; }
        if (tid < 64) { bgs[tid * 2] = P.bg[(size_t)(t0 + tid) * 8 + h]; bgs[tid * 2 + 1] = P.bg[(size_t)(t0 + tid) * 8 + 4 + h]; }
        __syncthreads();
        for (int i = 0; i < 64; ++i) {
            const LAS float* kp = ks + i * 128 + rg * 32; const LAS float* qp = qs + i * 128 + rg * 32;
            float r = 0.f;
#pragma unroll
            for (int kk = 0; kk < 32; ++kk) r += kp[kk] * S[kk];
            part[rg * 128 + v] = r;
            __syncthreads();
            const float rt = (part[v] + part[128 + v]) + (part[256 + v] + part[384 + v]);
            const float beta = bgs[2 * i], eg = __expf(bgs[2 * i + 1]);
            const float vn = beta * (vs[i * 128 + v] - eg * rt);
            float o = 0.f;
#pragma unroll
            for (int kk = 0; kk < 32; ++kk) { S[kk] = eg * S[kk] + kp[kk] * vn; o += qp[kk] * S[kk]; }
            part2[rg * 128 + v] = o;
            __syncthreads();
            if (rg == 0) P.oraw[(size_t)(t0 + i) * 512 + h * 128 + v] = ((part2[v] + part2[128 + v]) + (part2[256 + v] + part2[384 + v])) * 0.08838834764831845f;
        }
    }
}
__device__ __forceinline__ void slow_s5(Frame& F, const MixP& P, int task) {
    PHASE_TID();
    const int b = task >> 5, g = task & 31, p = lane;
    const double dt = (double)expf(P.s5_log_dt[g]);
    const double are = (double)P.s5_a_re[g * 64 + p], aim = (double)P.s5_a_im[g * 64 + p];
    double trev = aim * dt * 0.15915494309189535; trev -= __builtin_rint(trev);
    float sn, cs; sincos_rev(trev, sn, cs);
    const float er = __expf((float)(are * dt));
    const float ar = er * cs, ai = er * sn;
    const float lr = (float)are, li = (float)aim, den = lr * lr + li * li;
    const float nr = ar - 1.0f, ni = ai;
    const float cfr = (nr * lr + ni * li) / den, cfi = (ni * lr - nr * li) / den;
    float bbr[16], bbi[16], ccr[16], cci[16], dd[16];
#pragma unroll
    for (int hh = 0; hh < 16; ++hh) { const float br = P.s5_b_re[(g * 64 + p) * 16 + hh], bi = P.s5_b_im[(g * 64 + p) * 16 + hh];
        bbr[hh] = cfr * br - cfi * bi; bbi[hh] = cfr * bi + cfi * br;
        ccr[hh] = P.s5_c_re[(g * 16 + hh) * 64 + p]; cci[hh] = P.s5_c_im[(g * 16 + hh) * 64 + p]; dd[hh] = P.s5_d[g * 16 + hh]; }
    float xr = 0.f, xi = 0.f;
    for (int t = 0; t < SEQ; ++t) {
        const size_t tok = (size_t)b * SEQ + t;
        const v4u u0 = *(const GAS v4u*)(P.z + tok * ZW + Z_S5 + g * 16), u1 = *(const GAS v4u*)(P.z + tok * ZW + Z_S5 + g * 16 + 8);
        float u[16]; u[0] = bflo(u0.x); u[1] = bfhi(u0.x); u[2] = bflo(u0.y); u[3] = bfhi(u0.y); u[4] = bflo(u0.z); u[5] = bfhi(u0.z); u[6] = bflo(u0.w); u[7] = bfhi(u0.w);
        u[8] = bflo(u1.x); u[9] = bfhi(u1.x); u[10] = bflo(u1.y); u[11] = bfhi(u1.y); u[12] = bflo(u1.z); u[13] = bfhi(u1.z); u[14] = bflo(u1.w); u[15] = bfhi(u1.w);
        float br = 0.f, bi = 0.f;
#pragma unroll
        for (int hh = 0; hh < 16; ++hh) { br += bbr[hh] * u[hh]; bi += bbi[hh] * u[hh]; }
        const float nxr = ar * xr - ai * xi + br, nxi = ar * xi + ai * xr + bi; xr = nxr; xi = nxi;
        float yo = 0.f;
#pragma unroll
        for (int hh = 0; hh < 16; ++hh) { const float yy = wave_sum(ccr[hh] * xr - cci[hh] * xi) + dd[hh] * u[hh]; yo = (p == hh) ? yy : yo; }
        if (p < 16) { const float ge = gelu_tanh(yo); P.ys[tok * 512 + g * 16 + p] = ge; P.ysb[tok * 512 + g * 16 + p] = (bf16)f2bf(ge); }
    }
}
__device__ __forceinline__ void slow_attention(Frame& F, const MixP& P, int aw, int naw) {
    PHASE_TID();
    LAS float* qs = (LAS float*)(F.lds + RING_OFF + F.wave * 1024);
    for (int task = aw; task < M * 8; task += naw) {
        const int t = task >> 3, head = task & 7, pos = t & (SEQ - 1), kvh = head >> 2;
        const bf16* zr = P.z + (size_t)t * ZW;
        { const float x1 = bf2f(zr[Z_AQ + head * 128 + lane]), x2 = bf2f(zr[Z_AQ + head * 128 + 64 + lane]);
          const float c = P.rope_cos[pos * 64 + lane], s = P.rope_sin[pos * 64 + lane];
          LDS_WAIT(); asm volatile("" ::: "memory");
          qs[lane] = (x1 * c - x2 * s) * 0.08838834764831845f; qs[lane + 64] = (x2 * c + x1 * s) * 0.08838834764831845f;
          LDS_WAIT(); asm volatile("" ::: "memory"); }
        float sc[2];
#pragma unroll
        for (int kk = 0; kk < 2; ++kk) { const int off = lane + 64 * kk; float a = -INFINITY;
            if (pos - off >= 0) { const GAS f32x4* kp = (const GAS f32x4*)(P.kr + (size_t)(t - off) * 256 + kvh * 128); const LAS f32x4* qp = (const LAS f32x4*)qs; float d = 0.f;
#pragma unroll 8
                for (int i = 0; i < 32; ++i) { const f32x4 kv = kp[i], qv = qp[i]; d += (kv.x * qv.x + kv.y * qv.y) + (kv.z * qv.z + kv.w * qv.w); }
                a = d; }
            sc[kk] = a; }
        const float sink = P.sinks[head];
        const float mx = fmaxf(wave_max(fmaxf(sc[0], sc[1])), sink);
        const float p0 = __expf(sc[0] - mx), p1 = __expf(sc[1] - mx);
        const float denom = wave_sum(p0 + p1) + __expf(sink - mx);
        float o0 = 0.f, o1 = 0.f;
        const int nk = (pos + 1 < 128) ? pos + 1 : 128;
        for (int jj = 0; jj < nk; ++jj) { const float pj = (jj < 64) ? __shfl(p0, jj) : __shfl(p1, jj - 64);
            const unsigned w = *(const GAS unsigned*)(P.z + (size_t)(t - jj) * ZW + Z_AV + kvh * 128 + 2 * lane);
            o0 += pj * bflo(w); o1 += pj * bfhi(w); }
        const float inv = 1.0f / denom;
        *(GAS unsigned*)(P.mixed + (size_t)t * MIXW + head * 128 + 2 * lane) = pk2(o0 * inv, o1 * inv);
    }
}
__device__ __forceinline__ void dn_post_rows(Frame& F, const MixP& P) {
    PHASE_TID();
    for (int t = F.gw; t < M; t += F.NGW) {
#pragma unroll
        for (int h = 0; h < 4; ++h) { const float a = P.oraw[(size_t)t * 512 + h * 128 + lane], b2 = P.oraw[(size_t)t * 512 + h * 128 + 64 + lane];
            const float r = 1.0f / sqrtf(wave_sum(a * a + b2 * b2) * (1.f / 128.f) + NORM_EPS);
            const float z0 = bf2f(P.z[(size_t)t * ZW + Z_DZ + h * 128 + lane]), z1 = bf2f(P.z[(size_t)t * ZW + Z_DZ + h * 128 + 64 + lane]);
            P.mixed[(size_t)t * MIXW + 1024 + h * 128 + lane] = (bf16)f2bf(a * r * P.dn_norm_w[lane] * z0 * sigmoid_f(z0));
            P.mixed[(size_t)t * MIXW + 1024 + h * 128 + 64 + lane] = (bf16)f2bf(b2 * r * P.dn_norm_w[64 + lane] * z1 * sigmoid_f(z1)); }
    }
}
constexpr int AT_KS = 136, AT_VS = 264;
constexpr int AT_K_OFF = 0, AT_V_OFF = 256 * AT_KS * 2;
static_assert(AT_V_OFF + 128 * AT_VS * 2 <= MISC_OFF, "attention LDS");
constexpr int ATT_UNITS = 256;
__device__ __forceinline__ void rope8(const v4u a, const v4u b, const float* cp, const float* sp, float scale, v4u& o1, v4u& o2) {
    const f32x4 c0 = *(const GAS f32x4*)cp, c1 = *(const GAS f32x4*)(cp + 4), s0 = *(const GAS f32x4*)sp, s1 = *(const GAS f32x4*)(sp + 4);
    const float c[8] = {c0.x, c0.y, c0.z, c0.w, c1.x, c1.y, c1.z, c1.w}, s[8] = {s0.x, s0.y, s0.z, s0.w, s1.x, s1.y, s1.z, s1.w};
    const unsigned aw[4] = {a.x, a.y, a.z, a.w}, bw[4] = {b.x, b.y, b.z, b.w}; unsigned r1[4], r2[4];
#pragma unroll
    for (int i = 0; i < 4; ++i) { const float x1l = bflo(aw[i]), x1h = bfhi(aw[i]), x2l = bflo(bw[i]), x2h = bfhi(bw[i]);
        r1[i] = pk2((x1l * c[2 * i] - x2l * s[2 * i]) * scale, (x1h * c[2 * i + 1] - x2h * s[2 * i + 1]) * scale);
        r2[i] = pk2((x2l * c[2 * i] + x1l * s[2 * i]) * scale, (x2h * c[2 * i + 1] + x1h * s[2 * i + 1]) * scale); }
    o1 = (v4u){r1[0], r1[1], r1[2], r1[3]}; o2 = (v4u){r2[0], r2[1], r2[2], r2[3]};
}
__device__ __forceinline__ void attn_unit(Frame& F, const MixP& P, int unit) {
    PHASE_TID();
    const int half = unit & 1, kvh = (unit >> 1) & 1, blk = (unit >> 2) & 31, b = unit >> 7;
    LAS bf16* Kl = (LAS bf16*)(F.lds + AT_K_OFF); LAS bf16* Vt = (LAS bf16*)(F.lds + AT_V_OFF);
    const int tok0 = b * SEQ + (blk - 1) * 128;
    for (int it = tid; it < 2048; it += NWAVES * 64) {
        const int key = it >> 3, dg = it & 7; v4u o1 = (v4u){0u, 0u, 0u, 0u}, o2 = o1;
        if (blk > 0 || key >= 128) { const int pos = (blk - 1) * 128 + key; const bf16* zr = P.z + (size_t)(tok0 + key) * ZW + Z_AK + kvh * 128 + 8 * dg;
            rope8(*(const GAS v4u*)zr, *(const GAS v4u*)(zr + 64), P.rope_cos + pos * 64 + 8 * dg, P.rope_sin + pos * 64 + 8 * dg, 1.0f, o1, o2); }
        *(LAS v4u*)(Kl + key * AT_KS + 8 * dg) = o1; *(LAS v4u*)(Kl + key * AT_KS + 64 + 8 * dg) = o2;
    }
    for (int it = tid; it < 4096; it += NWAVES * 64) {
        const int key = it >> 4, dg = it & 15; v4u a = (v4u){0u, 0u, 0u, 0u};
        if (blk > 0 || key >= 128) a = *(const GAS v4u*)(P.z + (size_t)(tok0 + key) * ZW + Z_AV + kvh * 128 + 8 * dg);
        LAS bf16* vp = Vt + (8 * dg) * AT_VS + key;
        vp[0 * AT_VS] = (bf16)(a.x & 0xffffu); vp[1 * AT_VS] = (bf16)(a.x >> 16); vp[2 * AT_VS] = (bf16)(a.y & 0xffffu); vp[3 * AT_VS] = (bf16)(a.y >> 16);
        vp[4 * AT_VS] = (bf16)(a.z & 0xffffu); vp[5 * AT_VS] = (bf16)(a.z >> 16); vp[6 * AT_VS] = (bf16)(a.w & 0xffffu); vp[7 * AT_VS] = (bf16)(a.w >> 16);
    }
    __syncthreads();
    const int w = F.wave, n = lane & 15, q4 = lane >> 4, r0 = 16 * w, T0 = w & ~1;
    const int posq = blk * 128 + r0 + n; const size_t tq = (size_t)b * SEQ + posq;
#pragma unroll 1
    for (int hh = 0; hh < 2; ++hh) {
        asm volatile("" ::: "memory");
        const int head = kvh * 4 + half * 2 + hh;
        bf16x8 qf[4];
        { const bf16* zq = P.z + tq * ZW + Z_AQ + head * 128 + 8 * q4;
          const v4u x0 = *(const GAS v4u*)zq, x1 = *(const GAS v4u*)(zq + 32), x2 = *(const GAS v4u*)(zq + 64), x3 = *(const GAS v4u*)(zq + 96);
          v4u o0, o1, o2, o3;
          rope8(x0, x2, P.rope_cos + posq * 64 + 8 * q4, P.rope_sin + posq * 64 + 8 * q4, 0.08838834764831845f, o0, o2);
          rope8(x1, x3, P.rope_cos + posq * 64 + 32 + 8 * q4, P.rope_sin + posq * 64 + 32 + 8 * q4, 0.08838834764831845f, o1, o3);
          qf[0] = __builtin_bit_cast(bf16x8, o0); qf[1] = __builtin_bit_cast(bf16x8, o1); qf[2] = __builtin_bit_cast(bf16x8, o2); qf[3] = __builtin_bit_cast(bf16x8, o3); }
        f32x4 sacc[10];
#pragma unroll
        for (int kt = 0; kt < 10; ++kt) { sacc[kt] = (f32x4){0.f, 0.f, 0.f, 0.f};
#pragma unroll
            for (int ks = 0; ks < 4; ++ks) { const bf16x8 kf = *(const LAS bf16x8*)(Kl + (16 * (T0 + kt) + n) * AT_KS + 32 * ks + 8 * q4);
                sacc[kt] = __builtin_amdgcn_mfma_f32_16x16x32_bf16(kf, qf[ks], sacc[kt], 0, 0, 0); } }
        const float sink = P.sinks[head];
        float mx = -INFINITY;
#pragma unroll
        for (int kt = 0; kt < 10; ++kt)
#pragma unroll
            for (int r = 0; r < 4; ++r) { const int kw = 16 * (T0 + kt) + 4 * q4 + r, rel = 128 + r0 + n - kw; const bool vis = (rel >= 0) && (rel < 128) && (blk > 0 || kw >= 128);
                const float sv = vis ? sacc[kt][r] : -INFINITY; sacc[kt][r] = sv; mx = fmaxf(mx, sv); }
        mx = fmaxf(mx, __shfl_xor(mx, 16)); mx = fmaxf(mx, __shfl_xor(mx, 32)); mx = fmaxf(mx, sink);
        float sum = 0.f;
#pragma unroll
        for (int kt = 0; kt < 10; ++kt)
#pragma unroll
            for (int r = 0; r < 4; ++r) { const float p = __expf(sacc[kt][r] - mx); sacc[kt][r] = p; sum += p; }
        sum += __shfl_xor(sum, 16); sum += __shfl_xor(sum, 32); sum += __expf(sink - mx);
        f32x4 oacc[8];
#pragma unroll
        for (int dt = 0; dt < 8; ++dt) oacc[dt] = (f32x4){0.f, 0.f, 0.f, 0.f};
#pragma unroll
        for (int kp = 0; kp < 5; ++kp) {
            v4u pw; pw.x = pk2(sacc[2 * kp][0], sacc[2 * kp][1]); pw.y = pk2(sacc[2 * kp][2], sacc[2 * kp][3]); pw.z = pk2(sacc[2 * kp + 1][0], sacc[2 * kp + 1][1]); pw.w = pk2(sacc[2 * kp + 1][2], sacc[2 * kp + 1][3]);
            const bf16x8 pf = __builtin_bit_cast(bf16x8, pw);
#pragma unroll
            for (int dt = 0; dt < 8; ++dt) { const LAS bf16* vp = Vt + (16 * dt + n) * AT_VS + 16 * (T0 + 2 * kp) + 4 * q4;
                const v2u lo = *(const LAS v2u*)vp, hi = *(const LAS v2u*)(vp + 16);
                const bf16x8 vf = __builtin_bit_cast(bf16x8, (v4u){lo.x, lo.y, hi.x, hi.y});
                oacc[dt] = __builtin_amdgcn_mfma_f32_16x16x32_bf16(vf, pf, oacc[dt], 0, 0, 0); } }
        const float inv = 1.0f / sum;
        bf16* op = P.mixed + tq * MIXW + head * 128 + 4 * q4;
#pragma unroll
        for (int dt = 0; dt < 8; ++dt) { v2u o; o.x = pk2(oacc[dt][0] * inv, oacc[dt][1] * inv); o.y = pk2(oacc[dt][2] * inv, oacc[dt][3] * inv); *(GAS v2u*)(op + 16 * dt) = o; }
    }
    __syncthreads();
}
constexpr size_t S5T_K = 0, S5T_P = 8704, S5T_Q = S5T_P + 65536, S5T_A16 = S5T_Q + 65536, S5T_STRIDE = S5T_A16 + 512;
static_assert(S5T_STRIDE % 256 == 0, "s5 table stride");
__device__ __forceinline__ void s5_tables(Frame& F, const float* a_re, const float* a_im, const float* log_dt, const float* b_re, const float* b_im, const float* c_re, const float* c_im, unsigned char* tb, int g) {
    PHASE_TID();
    LAS float* apow = (LAS float*)(F.lds + RING_OFF);
    LAS float* bbar = apow + 17 * 128;
    LAS float* cc = bbar + 2048;
    __syncthreads();
    const float dtf = expf(log_dt[g]);
    for (int e = tid; e < 17 * 64; e += NWAVES * 64) { const int nn = e >> 6, p = e & 63; const double dt = (double)dtf;
        double trev = (double)a_im[g * 64 + p] * dt * (double)nn * 0.15915494309189535; trev -= __builtin_rint(trev);
        float sn, cs; sincos_rev(trev, sn, cs); const float er = expf((float)((double)a_re[g * 64 + p] * dt * (double)nn));
        apow[e * 2] = er * cs; apow[e * 2 + 1] = er * sn; }
    __syncthreads();
    for (int e = tid; e < 1024; e += NWAVES * 64) { const int p = e >> 4;
        const float lr = a_re[g * 64 + p], li = a_im[g * 64 + p], den = lr * lr + li * li, nr = apow[(64 + p) * 2] - 1.0f, ni = apow[(64 + p) * 2 + 1];
        const float cfr = (nr * lr + ni * li) / den, cfi = (ni * lr - nr * li) / den; const float br = b_re[g * 1024 + e], bi = b_im[g * 1024 + e];
        bbar[e * 2] = cfr * br - cfi * bi; bbar[e * 2 + 1] = cfr * bi + cfi * br;
        cc[e * 2] = c_re[g * 1024 + e]; cc[e * 2 + 1] = c_im[g * 1024 + e]; }
    __syncthreads();
    bf16* Ktab = (bf16*)(tb + S5T_K); bf16* Pt = (bf16*)(tb + S5T_P); bf16* Qt = (bf16*)(tb + S5T_Q); float* A16 = (float*)(tb + S5T_A16);
    for (int e = tid; e < 17 * 256; e += NWAVES * 64) { const int lag1 = e >> 8, ho = (e >> 4) & 15, hi = e & 15; float acc = 0.f;
        if (lag1 > 0) { const LAS float* ap = apow + (lag1 - 1) * 128;
            for (int p = 0; p < 64; ++p) { const float ar = ap[2 * p], ai = ap[2 * p + 1], br = bbar[(p * 16 + hi) * 2], bi = bbar[(p * 16 + hi) * 2 + 1], cr = cc[(ho * 64 + p) * 2], ci = cc[(ho * 64 + p) * 2 + 1];
                const float tr = ar * br - ai * bi, ti = ar * bi + ai * br; acc += cr * tr - ci * ti; } }
        Ktab[e] = (bf16)f2bf(acc); }
    for (int e = tid; e < 128 * 256; e += NWAVES * 64) { const int qp = e >> 8, k = e & 255, s = k >> 4, hi = k & 15, p = qp & 63;
        const float ar = apow[((15 - s) * 64 + p) * 2], ai = apow[((15 - s) * 64 + p) * 2 + 1], br = bbar[(p * 16 + hi) * 2], bi = bbar[(p * 16 + hi) * 2 + 1];
        Pt[e] = (bf16)f2bf((qp < 64) ? (ar * br - ai * bi) : (ar * bi + ai * br)); }
    for (int e = tid; e < 256 * 128; e += NWAVES * 64) { const int row = e >> 7, slot = e & 127, i = row >> 4, ho = row & 15, kp = slot >> 5, q4 = (slot >> 3) & 3, j = slot & 7;
        const int qp = (j < 4) ? (32 * kp + 4 * q4 + j) : (32 * kp + 16 + 4 * q4 + (j - 4)), p = qp & 63;
        const float ar = apow[((i + 1) * 64 + p) * 2], ai = apow[((i + 1) * 64 + p) * 2 + 1], cr = cc[(ho * 64 + p) * 2], ci = cc[(ho * 64 + p) * 2 + 1];
        Qt[e] = (bf16)f2bf((qp < 64) ? (cr * ar - ci * ai) : -(cr * ai + ci * ar)); }
    if (tid < 128) A16[tid] = apow[16 * 128 + tid];
    __syncthreads();
}
constexpr int S5_UNITS = 128;
template <bool PHB>
__device__ __forceinline__ void s5_unit(Frame& F, const MixP& P, const unsigned char* tabs_l, float* E, int unit) {
    PHASE_TID();
    const int span = unit >> 2, goct = unit & 3, b = span >> 4, u = span & 15, n = lane & 15, q4 = lane >> 4; const size_t tok0 = (size_t)b * SEQ + u * 256;
    const int g = goct * 8 + F.wave;
    const unsigned char* tb = tabs_l + (size_t)g * S5T_STRIDE;
    const bf16* Ktab = (const bf16*)(tb + S5T_K); const bf16* Pt = (const bf16*)(tb + S5T_P); const bf16* Qt = (const bf16*)(tb + S5T_Q); const float* A16 = (const float*)(tb + S5T_A16);
    float* Eb = E + ((size_t)(b * 16) * 32 + g) * 128 + 4 * q4;
    float ar[16], ai[16], yre[16], yim[16], Xr[16], Xi[16];
#define S5_LOAD_A16() _Pragma("unroll") for (int T = 0; T < 4; ++T) { const f32x4 v0 = *(const GAS f32x4*)(A16 + (16 * T + 4 * q4) * 2), v1 = *(const GAS f32x4*)(A16 + (16 * T + 4 * q4) * 2 + 4); \
        ar[4 * T] = v0.x; ai[4 * T] = v0.y; ar[4 * T + 1] = v0.z; ai[4 * T + 1] = v0.w; ar[4 * T + 2] = v1.x; ai[4 * T + 2] = v1.y; ar[4 * T + 3] = v1.z; ai[4 * T + 3] = v1.w; }
    bf16x8 ub[8];
#define S5_LOAD_UB() _Pragma("unroll") for (int ks = 0; ks < 8; ++ks) ub[ks] = *(const GAS bf16x8*)(P.z + (tok0 + 16 * n + 2 * ks + (q4 >> 1)) * ZW + Z_S5 + g * 16 + (q4 & 1) * 8)
    S5_LOAD_UB();
#pragma unroll
    for (int k = 0; k < 16; ++k) { Xr[k] = 0.f; Xi[k] = 0.f; }
    if constexpr (PHB) {
        S5_LOAD_A16();
        f32x4 en[8];
        if (u > 0) {
#pragma unroll
            for (int T = 0; T < 8; ++T) en[T] = *(const GAS f32x4*)(Eb + 16 * T);
        }
#pragma unroll
        for (int sq = 0; sq < 4; ++sq)
#pragma unroll
            for (int k = 0; k < 16; ++k) { const float a2 = ar[k] * ar[k] - ai[k] * ai[k]; ai[k] = 2.f * ar[k] * ai[k]; ar[k] = a2; }
        for (int up = 0; up < u; ++up) {
            f32x4 ec[8];
#pragma unroll
            for (int T = 0; T < 8; ++T) ec[T] = en[T];
            if (up + 1 < u) {
#pragma unroll
                for (int T = 0; T < 8; ++T) en[T] = *(const GAS f32x4*)(Eb + (size_t)(up + 1) * 4096 + 16 * T);
            }
#pragma unroll
            for (int k = 0; k < 16; ++k) { const float xr = Xr[k], xi = Xi[k]; Xr[k] = ar[k] * xr - ai[k] * xi + ec[k >> 2][k & 3]; Xi[k] = ar[k] * xi + ai[k] * xr + ec[4 + (k >> 2)][k & 3]; }
        }
    }
    {
        f32x4 xl[8]; bf16x8 fa[8], fb[8];
        const bf16* pt = Pt + n * 256 + 8 * q4;
#pragma unroll
        for (int ks = 0; ks < 8; ++ks) fa[ks] = *(const GAS bf16x8*)(pt + 32 * ks);
#pragma unroll
        for (int T = 0; T < 8; T += 2) {
            asm volatile("" ::: "memory");
#pragma unroll
            for (int ks = 0; ks < 8; ++ks) fb[ks] = *(const GAS bf16x8*)(pt + (T + 1) * 4096 + 32 * ks);
            asm volatile("" ::: "memory");
            xl[T] = (f32x4){0.f, 0.f, 0.f, 0.f};
#pragma unroll
            for (int ks = 0; ks < 8; ++ks) xl[T] = __builtin_amdgcn_mfma_f32_16x16x32_bf16(fa[ks], ub[ks], xl[T], 0, 0, 0);
            if (T + 2 < 8) {
#pragma unroll
                for (int ks = 0; ks < 8; ++ks) fa[ks] = *(const GAS bf16x8*)(pt + (T + 2) * 4096 + 32 * ks);
            }
            asm volatile("" ::: "memory");
            xl[T + 1] = (f32x4){0.f, 0.f, 0.f, 0.f};
#pragma unroll
            for (int ks = 0; ks < 8; ++ks) xl[T + 1] = __builtin_amdgcn_mfma_f32_16x16x32_bf16(fb[ks], ub[ks], xl[T + 1], 0, 0, 0);
        }
#pragma unroll
        for (int k = 0; k < 16; ++k) { yre[k] = xl[k >> 2][k & 3]; yim[k] = xl[4 + (k >> 2)][k & 3]; }
    }
    asm volatile("" ::: "memory");
    S5_LOAD_A16();
    if constexpr (PHB) { if (n == 0) {
#pragma unroll
        for (int k = 0; k < 16; ++k) { yre[k] += ar[k] * Xr[k] - ai[k] * Xi[k]; yim[k] += ar[k] * Xi[k] + ai[k] * Xr[k]; } } }
#pragma unroll
    for (int d = 1; d < 16; d <<= 1) {
#pragma unroll
        for (int k = 0; k < 16; ++k) {
            const float pr = __shfl_up(yre[k], d, 16), pi = __shfl_up(yim[k], d, 16);
            if (n >= d) { yre[k] += ar[k] * pr - ai[k] * pi; yim[k] += ar[k] * pi + ai[k] * pr; }
            const float a2 = ar[k] * ar[k] - ai[k] * ai[k]; ai[k] = 2.f * ar[k] * ai[k]; ar[k] = a2; }
    }
    if constexpr (!PHB) {
        if (n == 15) {
#pragma unroll
            for (int T = 0; T < 4; ++T) { *(GAS f32x4*)(Eb + (size_t)u * 4096 + 16 * T) = (f32x4){yre[4 * T], yre[4 * T + 1], yre[4 * T + 2], yre[4 * T + 3]};
                *(GAS f32x4*)(Eb + (size_t)u * 4096 + 64 + 16 * T) = (f32x4){yim[4 * T], yim[4 * T + 1], yim[4 * T + 2], yim[4 * T + 3]}; }
        }
    } else {
#pragma unroll
        for (int k = 0; k < 16; ++k) { const float pr = __shfl_up(yre[k], 1, 16), pi = __shfl_up(yim[k], 1, 16); yre[k] = (n == 0) ? Xr[k] : pr; yim[k] = (n == 0) ? Xi[k] : pi; }
        bf16x8 xb[4];
#pragma unroll
        for (int kp = 0; kp < 2; ++kp) { v4u w; w.x = pk2(yre[8 * kp], yre[8 * kp + 1]); w.y = pk2(yre[8 * kp + 2], yre[8 * kp + 3]); w.z = pk2(yre[8 * kp + 4], yre[8 * kp + 5]); w.w = pk2(yre[8 * kp + 6], yre[8 * kp + 7]);
            xb[kp] = __builtin_bit_cast(bf16x8, w);
            v4u w2; w2.x = pk2(yim[8 * kp], yim[8 * kp + 1]); w2.y = pk2(yim[8 * kp + 2], yim[8 * kp + 3]); w2.z = pk2(yim[8 * kp + 4], yim[8 * kp + 5]); w2.w = pk2(yim[8 * kp + 6], yim[8 * kp + 7]);
            xb[2 + kp] = __builtin_bit_cast(bf16x8, w2); }
        const f32x4 dsk = *(const GAS f32x4*)(P.s5_d + g * 16 + 4 * q4);
        const bf16* qp0 = Qt + n * 128 + q4 * 8;
        const bf16* kp00 = Ktab + (1 - (q4 >> 1)) * 256 + n * 16 + (q4 & 1) * 8;
        const bf16* zu = P.z + (tok0 + 16 * n) * ZW + Z_S5 + g * 16 + 4 * q4;
        float* yo = P.ys + (tok0 + 16 * n) * 512 + g * 16 + 4 * q4; bf16* yob = P.ysb + (tok0 + 16 * n) * 512 + g * 16 + 4 * q4;
        bf16x8 qa[4], ka[8], qb[4], kb[8]; v2u ua, ubw;
#define S5_REQ(i_, qf, kf, uw) do { _Pragma("unroll") for (int kp = 0; kp < 4; ++kp) qf[kp] = *(const GAS bf16x8*)(qp0 + (i_) * 2048 + kp * 32); \
            _Pragma("unroll") for (int ks = 0; ks < 8; ++ks) if (2 * ks <= (i_)) kf[ks] = *(const GAS bf16x8*)(kp00 + (i_) * 256 - ks * 512); \
            uw = *(const GAS v2u*)(zu + (size_t)(i_) * ZW); } while (0)
#define S5_OUT(i_, qf, kf, uw) do { f32x4 acc = (f32x4){0.f, 0.f, 0.f, 0.f}; \
            _Pragma("unroll") for (int kp = 0; kp < 4; ++kp) acc = __builtin_amdgcn_mfma_f32_16x16x32_bf16(qf[kp], xb[kp], acc, 0, 0, 0); \
            _Pragma("unroll") for (int ks = 0; ks < 8; ++ks) if (2 * ks <= (i_)) acc = __builtin_amdgcn_mfma_f32_16x16x32_bf16(kf[ks], ub[ks], acc, 0, 0, 0); \
            f32x4 yv; yv.x = gelu_tanh(acc.x + dsk.x * bflo(uw.x)); yv.y = gelu_tanh(acc.y + dsk.y * bfhi(uw.x)); yv.z = gelu_tanh(acc.z + dsk.z * bflo(uw.y)); yv.w = gelu_tanh(acc.w + dsk.w * bfhi(uw.y)); \
            *(GAS f32x4*)(yo + (size_t)(i_) * 512) = yv; v2u ob; ob.x = pk2(yv.x, yv.y); ob.y = pk2(yv.z, yv.w); *(GAS v2u*)(yob + (size_t)(i_) * 512) = ob; } while (0)
        S5_REQ(0, qa, ka, ua);
#pragma unroll 1
        for (int i = 0; i < 16; i += 2) {
            asm volatile("" ::: "memory");
            S5_REQ(i + 1, qb, kb, ubw);
            asm volatile("" ::: "memory");
            S5_OUT(i, qa, ka, ua);
            if (i + 2 < 16) S5_REQ(i + 2, qa, ka, ua);
            asm volatile("" ::: "memory");
            S5_OUT(i + 1, qb, kb, ubw);
        }
#undef S5_REQ
#undef S5_OUT
    }
}
#undef S5_LOAD_A16
#undef S5_LOAD_UB
constexpr int DN_LS = 132, DN_MS = 68, DN_TS = 20;
constexpr int DN_Q_OFF = 0, DN_K_OFF = 64 * DN_LS * 4, DN_V_OFF = 2 * DN_K_OFF, DN_L_OFF = 3 * DN_K_OFF, DN_A_OFF = DN_L_OFF + 64 * DN_MS * 4, DN_T_OFF = DN_A_OFF + 64 * DN_MS * 4, DN_G_OFF = DN_T_OFF + 64 * DN_TS * 4;
static_assert(DN_G_OFF + 1024 <= MISC_OFF, "deltanet chunk LDS");
constexpr size_t DNC_W = 0, DNC_QD = 16384, DNC_AT = 32768, DNC_KD = 40960, DNC_U = 57344, DNC_GATE = 90112, DNC_EGL = 106496, DNC_STRIDE = 106752;
constexpr int DNC_OPS = 57344;
__device__ __forceinline__ void dn_chunk_unit(Frame& F, const MixP& P, unsigned char* dnc, int unit) {
    PHASE_TID();
    const int h = unit & 3, cn = (unit >> 2) & 63, b = unit >> 8;
    const int t0 = b * SEQ + cn * 64, pos0 = cn * 64;
    unsigned char* cb = dnc + (size_t)((b * 4 + h) * 64 + cn) * DNC_STRIDE;
    LAS float* qs = (LAS float*)(F.lds + DN_Q_OFF); LAS float* ks = (LAS float*)(F.lds + DN_K_OFF); LAS float* vs = (LAS float*)(F.lds + DN_V_OFF);
    LAS float* Lm = (LAS float*)(F.lds + DN_L_OFF); LAS float* At = (LAS float*)(F.lds + DN_A_OFF); LAS float* Td = (LAS float*)(F.lds + DN_T_OFF);
    LAS float* gcs = (LAS float*)(F.lds + DN_G_OFF); LAS float* betas = gcs + 64; LAS float* egs = gcs + 128; LAS float* gsm = gcs + 192;
    __syncthreads();
#pragma unroll 1
    for (int rep = 0; rep < 6; ++rep) { const int it = tid + rep * (NWAVES * 64), tok = it / 48, rem = it - tok * 48, part = rem >> 4, cg = rem & 15;
        const int ch = part * 512 + h * 128 + 8 * cg; float acc[8];
#pragma unroll
        for (int e = 0; e < 8; ++e) acc[e] = 0.f;
#pragma unroll
        for (int k = 0; k < 4; ++k) { if (pos0 + tok - 3 + k >= 0) { const v4u zw = *(const GAS v4u*)(P.z + (size_t)(t0 + tok - 3 + k) * ZW + Z_DQKV + ch);
                const f32x4 w0 = *(const GAS f32x4*)(P.convw + k * 1536 + ch), w1 = *(const GAS f32x4*)(P.convw + k * 1536 + ch + 4);
                acc[0] += w0.x * bflo(zw.x); acc[1] += w0.y * bfhi(zw.x); acc[2] += w0.z * bflo(zw.y); acc[3] += w0.w * bfhi(zw.y);
                acc[4] += w1.x * bflo(zw.z); acc[5] += w1.y * bfhi(zw.z); acc[6] += w1.z * bflo(zw.w); acc[7] += w1.w * bfhi(zw.w); } }
#pragma unroll
        for (int e = 0; e < 8; ++e) acc[e] = acc[e] * sigmoid_f(acc[e]);
        LAS float* dst = (LAS float*)(F.lds + part * DN_K_OFF) + tok * DN_LS + 8 * cg;
        *(LAS f32x4*)dst = (f32x4){acc[0], acc[1], acc[2], acc[3]}; *(LAS f32x4*)(dst + 4) = (f32x4){acc[4], acc[5], acc[6], acc[7]}; }
    if (tid < 64) { const float br = P.ab[(size_t)(t0 + tid) * 8 + h], ar = P.ab[(size_t)(t0 + tid) * 8 + 4 + h] + P.dt_bias[h];
        const float sp = fmaxf(ar, 0.f) + log1pf(__expf(-fabsf(ar)));
        betas[tid] = sigmoid_f(br); gsm[tid] = -__expf(P.a_log[h]) * sp; }
    __syncthreads();
    { const int w = F.wave;
#pragma unroll 1
      for (int rr = 0; rr < 8; ++rr) { const int row = 8 * w + rr;
          { LAS float* p = qs + row * DN_LS; const float a = p[lane], c = p[lane + 64]; const float r = 0.08838834764831845f / sqrtf(wave_sum(a * a + c * c) + NORM_EPS); p[lane] = a * r; p[lane + 64] = c * r; }
          { LAS float* p = ks + row * DN_LS; const float a = p[lane], c = p[lane + 64]; const float r = 1.0f / sqrtf(wave_sum(a * a + c * c) + NORM_EPS); p[lane] = a * r; p[lane + 64] = c * r; } }
      if (w == 0) { float g = gsm[lane];
#pragma unroll
          for (int d = 1; d < 64; d <<= 1) { const float pv = __shfl_up(g, d, 64); if (lane >= d) g += pv; }
          gcs[lane] = g; egs[lane] = __expf(g); } }
    __syncthreads();
    const int m = lane & 15, q = lane >> 4;
#pragma unroll 1
    for (int job = F.wave; job < 20; job += NWAVES) { const int kind = job >= 10, idx = job - 10 * kind; const int ti = (idx >= 6) ? 3 : (idx >= 3) ? 2 : (idx >= 1) ? 1 : 0, tj = idx - ((ti * (ti + 1)) >> 1);
        const LAS float* ap = (kind ? qs : ks) + (16 * ti + m) * DN_LS + 4 * q; const LAS float* bp = ks + (16 * tj + m) * DN_LS + 4 * q;
        f32x4 acc = (f32x4){0.f, 0.f, 0.f, 0.f};
#pragma unroll
        for (int kg = 0; kg < 8; ++kg) { const f32x4 a4 = *(const LAS f32x4*)(ap + 16 * kg), b4 = *(const LAS f32x4*)(bp + 16 * kg);
#pragma unroll
            for (int s = 0; s < 4; ++s) acc = __builtin_amdgcn_mfma_f32_16x16x4f32(a4[s], b4[s], acc, 0, 0, 0); }
        const int j = 16 * tj + m; const float gj = gcs[j];
#pragma unroll
        for (int r = 0; r < 4; ++r) { const int i = 16 * ti + 4 * q + r; const float dec = __expf(gcs[i] - gj);
            if (kind) At[i * DN_MS + j] = (i >= j) ? acc[r] * dec : 0.f; else Lm[i * DN_MS + j] = (i > j) ? acc[r] * dec * betas[i] : 0.f; } }
    __syncthreads();
    if (F.wave == 0) { float Tr[16];
#pragma unroll
        for (int r = 0; r < 16; ++r) { float acc = (m == r) ? 1.f : 0.f;
#pragma unroll
            for (int j = 0; j < 16; ++j) if (j < r) acc -= Lm[(16 * q + r) * DN_MS + 16 * q + j] * Tr[j];
            Tr[r] = acc; Td[(16 * q + r) * DN_TS + m] = acc; } }
    __syncthreads();
#pragma unroll 1
    for (int half = 0; half < 2; ++half) {
        const int ct = F.wave + 8 * half; const LAS float* rsrc = (half ? ks : vs) + 16 * F.wave + m;
        f32x4 X[4];
#pragma unroll
        for (int i = 0; i < 4; ++i) { f32x4 acc;
#pragma unroll
            for (int r = 0; r < 4; ++r) { const int row = 16 * i + 4 * q + r; const float sc = half ? betas[row] * egs[row] : betas[row]; acc[r] = rsrc[row * DN_LS] * sc; }
            f32x4 s = (f32x4){0.f, 0.f, 0.f, 0.f};
#pragma unroll
            for (int j = 0; j < 4; ++j) if (j < i) { const f32x4 a4 = *(const LAS f32x4*)(Lm + (16 * i + m) * DN_MS + 16 * j + 4 * q);
#pragma unroll
                for (int s4 = 0; s4 < 4; ++s4) s = __builtin_amdgcn_mfma_f32_16x16x4f32(a4[s4], X[j][s4], s, 0, 0, 0); }
            acc -= s;
            const f32x4 t4 = *(const LAS f32x4*)(Td + (16 * i + m) * DN_TS + 4 * q); f32x4 xi = (f32x4){0.f, 0.f, 0.f, 0.f};
#pragma unroll
            for (int s4 = 0; s4 < 4; ++s4) xi = __builtin_amdgcn_mfma_f32_16x16x4f32(t4[s4], acc[s4], xi, 0, 0, 0);
            X[i] = xi; }
        if (half == 0) {
#pragma unroll
            for (int i = 0; i < 4; ++i) *(GAS f32x4*)(cb + DNC_U + (size_t)((ct * 4 + i) * 64 + lane) * 16) = X[i];
            __syncthreads();
        } else {
#pragma unroll
            for (int i = 0; i < 4; ++i)
#pragma unroll
                for (int r = 0; r < 4; ++r) vs[(16 * i + 4 * q + r) * DN_LS + 16 * F.wave + m] = X[i][r];
        }
    }
    __syncthreads();
    const float gl = gcs[63];
#pragma unroll
    for (int rep = 0; rep < 7; ++rep) { const int e = tid + rep * (NWAVES * 64); v4u o;
        if (rep < 4) { const int e2 = e & 1023, tile = e2 >> 6, fl = e2 & 63, fm = fl & 15, fq = fl >> 4, it = tile >> 2, kss = tile & 3, tok = 16 * it + fm;
            const LAS float* src = ((rep < 2) ? vs : qs) + tok * DN_LS + 32 * kss + 4 * fq; const float sc = (rep < 2) ? 1.0f : egs[tok];
            const f32x4 lo = *(const LAS f32x4*)src, hi = *(const LAS f32x4*)(src + 16);
            o.x = pk2(lo.x * sc, lo.y * sc); o.y = pk2(lo.z * sc, lo.w * sc); o.z = pk2(hi.x * sc, hi.y * sc); o.w = pk2(hi.z * sc, hi.w * sc);
        } else if (rep == 4) { const int e2 = e - 2048, tile = e2 >> 6, fl = e2 & 63, fm = fl & 15, fq = fl >> 4, it = tile >> 1, ks2 = tile & 1, i = 16 * it + fm, j0 = 32 * ks2 + 4 * fq;
            const f32x4 lo = *(const LAS f32x4*)(At + i * DN_MS + j0), hi = *(const LAS f32x4*)(At + i * DN_MS + j0 + 16);
            float v[8] = {lo.x, lo.y, lo.z, lo.w, hi.x, hi.y, hi.z, hi.w};
#pragma unroll
            for (int jj = 0; jj < 8; ++jj) { const int j = j0 + (jj & 3) + 16 * (jj >> 2); if (j > i) v[jj] = 0.f; }
            o.x = pk2(v[0], v[1]); o.y = pk2(v[2], v[3]); o.z = pk2(v[4], v[5]); o.w = pk2(v[6], v[7]);
        } else { const int e2 = e - 2560, tile = e2 >> 6, fl = e2 & 63, fm = fl & 15, fq = fl >> 4, dt = tile >> 1, ks2 = tile & 1, dk = 16 * dt + fm, j0 = 32 * ks2 + 4 * fq; float v[8];
#pragma unroll
            for (int jj = 0; jj < 8; ++jj) { const int j = j0 + (jj & 3) + 16 * (jj >> 2); v[jj] = ks[j * DN_LS + dk] * __expf(gl - gcs[j]); }
            o.x = pk2(v[0], v[1]); o.y = pk2(v[2], v[3]); o.z = pk2(v[4], v[5]); o.w = pk2(v[6], v[7]); }
        *(GAS v4u*)(cb + (size_t)e * 16) = o; }
    if (tid == 0) *(GAS float*)(cb + DNC_EGL) = __expf(gl);
    { const int w = F.wave; const float nwv = P.dn_norm_w[16 * w + m];
#pragma unroll
      for (int it = 0; it < 4; ++it) { float gv[4];
#pragma unroll
          for (int r = 0; r < 4; ++r) { const float zz = bf2f(P.z[(size_t)(t0 + 16 * it + 4 * q + r) * ZW + Z_DZ + h * 128 + 16 * w + m]); gv[r] = nwv * zz * sigmoid_f(zz); }
          v2u o; o.x = pk2(gv[0], gv[1]); o.y = pk2(gv[2], gv[3]); *(GAS v2u*)(cb + DNC_GATE + (size_t)((w * 4 + it) * 64 + lane) * 8) = o; } }
}
constexpr int DNX_BUF0 = 0, DNX_BUF1 = DNC_OPS, DNX_RED = 2 * DNC_OPS;
static_assert(DNX_RED + 2 * 8 * 64 * 4 <= MISC_OFF, "deltanet chain LDS");
#ifndef DN_DMA
#define DN_DMA 0
#endif
template <int CTRL> __device__ __forceinline__ float dppf(float x) { return __builtin_bit_cast(float, __builtin_amdgcn_mov_dpp(__builtin_bit_cast(int, x), CTRL, 0xf, 0xf, true)); }
__device__ __forceinline__ float row16_sum(float x) { x += dppf<0xB1>(x); x += dppf<0x4E>(x); x += dppf<0x141>(x); x += dppf<0x128>(x); return x; }
typedef float f32x2_t __attribute__((ext_vector_type(2))); typedef __bf16 bf16x2_t __attribute__((ext_vector_type(2)));
__device__ __forceinline__ unsigned cvtpk(float lo, float hi) { const f32x2_t v = {lo, hi}; const bf16x2_t b = __builtin_convertvector(v, bf16x2_t); return __builtin_bit_cast(unsigned, b); }
__device__ __forceinline__ bf16x8 pack8(const f32x4 a, const f32x4 b) { v4u w; w.x = cvtpk(a[0], a[1]); w.y = cvtpk(a[2], a[3]); w.z = cvtpk(b[0], b[1]); w.w = cvtpk(b[2], b[3]); return __builtin_bit_cast(bf16x8, w); }
__device__ __forceinline__ void dn_chain(Frame& F, const MixP& P, const unsigned char* dnc, int unit) {
    PHASE_TID();
    const int bh = unit >> 1, half = unit & 1, b = bh >> 2, h = bh & 3, w = F.wave, n = lane & 15, q4 = lane >> 4;
    const unsigned char* cb0 = dnc + (size_t)(bh * 64) * DNC_STRIDE;
    __syncthreads();
    if (w >= 4) {
        const unsigned so = (unsigned)((tid - 256) * 16);
        v4u sa[14], sb[14];
#pragma unroll
        for (int r = 0; r < 14; ++r) sa[r] = *(const GAS v4u*)(cb0 + so + r * 4096);
#pragma unroll
        for (int r = 0; r < 14; ++r) *(LAS v4u*)(F.lds + DNX_BUF0 + so + r * 4096) = sa[r];
#pragma unroll
        for (int r = 0; r < 14; ++r) sa[r] = *(const GAS v4u*)(cb0 + DNC_STRIDE + so + r * 4096);
#pragma unroll
        for (int r = 0; r < 14; ++r) sb[r] = *(const GAS v4u*)(cb0 + 2 * DNC_STRIDE + so + r * 4096);
        __syncthreads();
#pragma unroll 1
        for (int c = 0; c < 64; c += 2) {
#pragma unroll
            for (int r = 0; r < 14; ++r) *(LAS v4u*)(F.lds + DNX_BUF1 + so + r * 4096) = sa[r];
            { const unsigned char* src = cb0 + (size_t)(c + 3 < 64 ? c + 3 : 63) * DNC_STRIDE + so;
#pragma unroll
              for (int r = 0; r < 14; ++r) sa[r] = *(const GAS v4u*)(src + r * 4096); }
            asm volatile("s_waitcnt lgkmcnt(0)" ::: "memory"); __builtin_amdgcn_s_barrier(); asm volatile("" ::: "memory");
#pragma unroll
            for (int r = 0; r < 14; ++r) *(LAS v4u*)(F.lds + DNX_BUF0 + so + r * 4096) = sb[r];
            { const unsigned char* src = cb0 + (size_t)(c + 4 < 64 ? c + 4 : 63) * DNC_STRIDE + so;
#pragma unroll
              for (int r = 0; r < 14; ++r) sb[r] = *(const GAS v4u*)(src + r * 4096); }
            asm volatile("s_waitcnt lgkmcnt(0)" ::: "memory"); __builtin_amdgcn_s_barrier(); asm volatile("" ::: "memory");
        }
    } else {
        const int sl = half * 4 + w;
        float* ob = P.oraw + ((size_t)b * SEQ + 4 * q4) * 512 + h * 128 + 16 * sl + n;
        const unsigned uoff = (unsigned)(DNC_U + ((sl * 4) * 64 + lane) * 16);
        f32x4 S[8]; bf16x8 Sb[4];
#pragma unroll
        for (int T = 0; T < 8; ++T) S[T] = (f32x4){0.f, 0.f, 0.f, 0.f};
#pragma unroll
        for (int k = 0; k < 4; ++k) Sb[k] = __builtin_bit_cast(bf16x8, (v4u){0u, 0u, 0u, 0u});
        f32x4 U0[4], U1[4]; float eg0, eg1;
#pragma unroll
        for (int it = 0; it < 4; ++it) { U0[it] = *(const GAS f32x4*)(cb0 + uoff + it * 1024); U1[it] = *(const GAS f32x4*)(cb0 + DNC_STRIDE + uoff + it * 1024); }
        eg0 = *(const GAS float*)(cb0 + DNC_EGL); eg1 = *(const GAS float*)(cb0 + DNC_STRIDE + DNC_EGL);
        __syncthreads();
#define DN_STEP(c_, BUFOFF, U_, eg_) do { \
        const LAS unsigned char* buf = F.lds + (BUFOFF); \
        f32x4 ws[4]; \
        { bf16x8 af[16]; \
          _Pragma("unroll") for (int t = 0; t < 16; ++t) af[t] = *(const LAS bf16x8*)(buf + DNC_W + (t * 64 + lane) * 16); \
          _Pragma("unroll") for (int it = 0; it < 4; ++it) ws[it] = (f32x4){0.f, 0.f, 0.f, 0.f}; \
          _Pragma("unroll") for (int ks = 0; ks < 4; ++ks) _Pragma("unroll") for (int it = 0; it < 4; ++it) ws[it] = __builtin_amdgcn_mfma_f32_16x16x32_bf16(af[it * 4 + ks], Sb[ks], ws[it], 0, 0, 0); } \
        bf16x8 vb[2]; vb[0] = pack8(U_[0] - ws[0], U_[1] - ws[1]); vb[1] = pack8(U_[2] - ws[2], U_[3] - ws[3]); \
        f32x4 o[4]; \
        { bf16x8 af[16]; \
          _Pragma("unroll") for (int t = 0; t < 16; ++t) af[t] = *(const LAS bf16x8*)(buf + DNC_QD + (t * 64 + lane) * 16); \
          _Pragma("unroll") for (int it = 0; it < 4; ++it) o[it] = (f32x4){0.f, 0.f, 0.f, 0.f}; \
          _Pragma("unroll") for (int ks = 0; ks < 4; ++ks) _Pragma("unroll") for (int it = 0; it < 4; ++it) o[it] = __builtin_amdgcn_mfma_f32_16x16x32_bf16(af[it * 4 + ks], Sb[ks], o[it], 0, 0, 0); } \
        { bf16x8 af[8]; \
          _Pragma("unroll") for (int t = 0; t < 8; ++t) if (32 * (t & 1) <= 16 * (t >> 1) + 15) af[t] = *(const LAS bf16x8*)(buf + DNC_AT + (t * 64 + lane) * 16); \
          _Pragma("unroll") for (int k2 = 0; k2 < 2; ++k2) _Pragma("unroll") for (int it = 0; it < 4; ++it) if (32 * k2 <= 16 * it + 15) o[it] = __builtin_amdgcn_mfma_f32_16x16x32_bf16(af[it * 2 + k2], vb[k2], o[it], 0, 0, 0); } \
        { bf16x8 af[16]; \
          _Pragma("unroll") for (int t = 0; t < 16; ++t) af[t] = *(const LAS bf16x8*)(buf + DNC_KD + (t * 64 + lane) * 16); \
          _Pragma("unroll") for (int T = 0; T < 8; ++T) S[T] = S[T] * eg_; \
          _Pragma("unroll") for (int k2 = 0; k2 < 2; ++k2) _Pragma("unroll") for (int T = 0; T < 8; ++T) S[T] = __builtin_amdgcn_mfma_f32_16x16x32_bf16(af[T * 2 + k2], vb[k2], S[T], 0, 0, 0); } \
        _Pragma("unroll") for (int k = 0; k < 4; ++k) Sb[k] = pack8(S[2 * k], S[2 * k + 1]); \
        { float* op = ob + (size_t)(c_) * (64 * 512); \
          _Pragma("unroll") for (int it = 0; it < 4; ++it) _Pragma("unroll") for (int r = 0; r < 4; ++r) op[(16 * it + r) * 512] = o[it][r]; } \
        { const unsigned char* src = cb0 + (size_t)((c_) + 2 < 64 ? (c_) + 2 : 63) * DNC_STRIDE; \
          _Pragma("unroll") for (int it = 0; it < 4; ++it) U_[it] = *(const GAS f32x4*)(src + uoff + it * 1024); \
          eg_ = *(const GAS float*)(src + DNC_EGL); } \
        asm volatile("s_waitcnt lgkmcnt(0)" ::: "memory"); __builtin_amdgcn_s_barrier(); asm volatile("" ::: "memory"); } while (0)
#pragma unroll 1
        for (int c = 0; c < 64; c += 2) {
            DN_STEP(c, DNX_BUF0, U0, eg0);
            DN_STEP(c + 1, DNX_BUF1, U1, eg1);
        }
#undef DN_STEP
    }
    asm volatile("s_waitcnt vmcnt(0)" ::: "memory");
    __syncthreads();
}
constexpr int NPH = 12;
constexpr int NSTEPS = 1 + DEPTH * NPH;
struct Args { const float* in[30]; float* out; unsigned char* ws; int s_lo, s_hi; };
enum { I_X = 0, I_FF1_PRE, I_FF1_G, I_FF1_U, I_FF1_D, I_FF1_POST, I_MIX_PRE, I_WIN, I_SINKS, I_CONVW, I_ALOG, I_DTB, I_DNNW, I_S5ARE, I_S5AIM, I_S5LDT, I_S5BRE, I_S5BIM, I_S5CRE, I_S5CIM, I_S5D,
       I_GLUW, I_GLUB, I_WOUT, I_MIX_POST, I_FF2_PRE, I_FF2_G, I_FF2_U, I_FF2_D, I_FF2_POST };
typedef const __attribute__((address_space(4))) Args* CArgsP;
__device__ __forceinline__ CArgsP kargs() { CArgsP p = (CArgsP)__builtin_amdgcn_kernarg_segment_ptr(); asm volatile("" : "+s"(p)); return p; }
__device__ __forceinline__ MixP make_mixp(CArgsP A, unsigned char* ws, int l) {
    MixP P;
    P.sinks = A->in[I_SINKS] + l * 8; P.convw = A->in[I_CONVW] + l * 4 * 1536; P.a_log = A->in[I_ALOG] + l * 4; P.dt_bias = A->in[I_DTB] + l * 4; P.dn_norm_w = A->in[I_DNNW] + l * 128;
    P.s5_a_re = A->in[I_S5ARE] + l * 2048; P.s5_a_im = A->in[I_S5AIM] + l * 2048; P.s5_log_dt = A->in[I_S5LDT] + l * 32;
    P.s5_b_re = A->in[I_S5BRE] + l * 32768; P.s5_b_im = A->in[I_S5BIM] + l * 32768; P.s5_c_re = A->in[I_S5CRE] + l * 32768; P.s5_c_im = A->in[I_S5CIM] + l * 32768; P.s5_d = A->in[I_S5D] + l * 512;
    P.rope_cos = (float*)(ws + WS_ROPE); P.rope_sin = P.rope_cos + SEQ * 64; P.z = (bf16*)(ws + WS_Z); P.ab = (float*)(ws + WS_AB); P.bg = (float*)(ws + WS_BG); P.kr = (float*)(ws + WS_KR);
    P.qn = (float*)(ws + WS_QN); P.kn = (float*)(ws + WS_KN); P.vc = (float*)(ws + WS_VC); P.oraw = (float*)(ws + WS_ORAW); P.ys = (float*)(ws + WS_YS); P.ysb = (bf16*)(ws + WS_YSB); P.mixed = (bf16*)(ws + WS_MIXED);
    return P;
}
constexpr int CV_G1 = 0, CV_U1 = 5632, CV_D1 = 11264, CV_WA = 16896, CV_WB = 20480, CV_WO = 20992, CV_G2 = 23040, CV_U2 = 28672, CV_D2 = 34304, CV_GL = 39936, CV_END = 40064;
__device__ __forceinline__ void convert_layer_items(Frame& F, CArgsP A, unsigned char* ws, int tl, int ibeg, int iend, int w0, int nw) {
    PHASE_TID();
    LAS float* scr = (LAS float*)(F.lds + RING_OFF + F.wave * 16384);
    const LayerW w = layer_w(ws, tl);
    for (int it = ibeg + (F.gw - w0); it < iend; it += nw) {
        if (it < CV_U1)      transpose_item(A->in[I_FF1_G] + (size_t)tl * D * FF, D, FF, 0, FF, (bf16*)w.wgu1, 0, 1, scr, it - CV_G1, lane);
        else if (it < CV_D1) transpose_item(A->in[I_FF1_U] + (size_t)tl * D * FF, D, FF, 0, FF, (bf16*)w.wgu1, 128, 1, scr, it - CV_U1, lane);
        else if (it < CV_WA) transpose_item(A->in[I_FF1_D] + (size_t)tl * FF * D, FF, D, 0, D, (bf16*)w.wd1, 0, 0, scr, it - CV_D1, lane);
        else if (it < CV_WB) transpose_item(A->in[I_WIN] + (size_t)tl * D * INW, D, INW, 0, SRC_AB, (bf16*)w.win, 0, 0, scr, it - CV_WA, lane);
        else if (it < CV_WO) transpose_item(A->in[I_WIN] + (size_t)tl * D * INW, D, INW, SRC_S5, 512, (bf16*)w.win, Z_S5, 0, scr, it - CV_WB, lane);
        else if (it < CV_G2) transpose_item(A->in[I_WOUT] + (size_t)tl * MIXW * D, MIXW, D, 0, D, (bf16*)w.wout, 0, 0, scr, it - CV_WO, lane);
        else if (it < CV_U2) transpose_item(A->in[I_FF2_G] + (size_t)tl * D * FF, D, FF, 0, FF, (bf16*)w.wgu2, 0, 1, scr, it - CV_G2, lane);
        else if (it < CV_D2) transpose_item(A->in[I_FF2_U] + (size_t)tl * D * FF, D, FF, 0, FF, (bf16*)w.wgu2, 128, 1, scr, it - CV_U2, lane);
        else if (it < CV_GL) transpose_item(A->in[I_FF2_D] + (size_t)tl * FF * D, FF, D, 0, D, (bf16*)w.wd2, 0, 0, scr, it - CV_D2, lane);
        else                 transpose_item(A->in[I_GLUW] + (size_t)tl * 512 * 512, 512, 512, 0, 512, (bf16*)w.wglu, 0, 0, scr, it - CV_GL, lane);
    }
}
#ifndef CVQA
#define CVQA 12000
#endif
#ifndef CVQB
#define CVQB 24000
#endif
constexpr int CVQ_A = CVQA, CVQ_B = CVQB;
#define PHASE_BEGIN() Frame F; F.lds = (LAS unsigned char*)lds; { int bx_ = blockIdx.x, gx_ = gridDim.x, tw_ = threadIdx.x; asm volatile("" : "+s"(bx_), "+s"(gx_), "+v"(tw_)); \
        F.bid = bx_; F.G = gx_; F.wave = __builtin_amdgcn_readfirstlane(tw_ >> 6); F.gw = bx_ * NWAVES + F.wave; F.NGW = gx_ * NWAVES; } \
    const CArgsP A = kargs(); unsigned char* const ws = A->ws; (void)ws; \
    bf16* const Hb = (bf16*)(ws + WS_H); bf16* const ACT = (bf16*)(ws + WS_ACT); float* const Yb = (float*)(ws + WS_Y); bf16* const Zb = (bf16*)(ws + WS_Z); bf16* const MIXED = (bf16*)(ws + WS_MIXED); \
    float* const xout = A->out; (void)Hb; (void)ACT; (void)Yb; (void)Zb; (void)MIXED; (void)xout

__global__ void __launch_bounds__(NWAVES * 64, 2) mk_fwd(Args args) {
    extern __shared__ __attribute__((aligned(16))) unsigned char lds[];
    if (threadIdx.x < 128) ((LAS unsigned*)((LAS unsigned char*)lds + MISC_OFF))[threadIdx.x] = 0u;
    __syncthreads();
    XcdBarrier bar; bar.bar = (unsigned*)(kargs()->ws + WS_CTL) + CW_BAR; bar.x = 0; bar.st = nullptr;
    if (!MK_MULTI) bar = xcd_barrier_post((unsigned*)(kargs()->ws + WS_CTL) + CW_BAR, (volatile LAS unsigned*)((LAS unsigned char*)lds + MISC_OFF) + 8);
    const int lo = kargs()->s_lo, hi = kargs()->s_hi;
#define IN(s) (lo <= (s) && (s) < hi)
#define SEAM(s) do { if (!MK_MULTI) { if (IN(s) && IN((s) + 1)) xcd_barrier(bar); } } while (0)

    if (IN(0)) for (int rp_ = 0; rp_ < 1 + ((PROBE_DBL_MASK >> 12) & 1); ++rp_) {
        PHASE_BEGIN();
        convert_layer_items(F, A, ws, 0, 0, CV_END, 0, F.NGW);
        for (int c = F.bid; c < DEPTH * 32; c += F.G) { const int tl = c >> 5, tg = c & 31;
            s5_tables(F, A->in[I_S5ARE] + tl * 2048, A->in[I_S5AIM] + tl * 2048, A->in[I_S5LDT] + tl * 32, A->in[I_S5BRE] + tl * 32768, A->in[I_S5BIM] + tl * 32768, A->in[I_S5CRE] + tl * 32768, A->in[I_S5CIM] + tl * 32768,
                      ws + WS_S5T + (size_t)c * S5T_STRIDE, tg); }
        { PHASE_TID(); float* rope_cos = (float*)(ws + WS_ROPE); float* rope_sin = rope_cos + SEQ * 64;
          for (int i = F.bid * (NWAVES * 64) + tid; i < SEQ * 64; i += F.G * NWAVES * 64) {
            const int pos = i >> 6, d = i & 63;
            const float invf = exp2f(-(float)d * (13.287712379549449f / 64.0f));
            const float ang = (float)pos * invf;
            double t = (double)ang * 0.15915494309189535; t -= __builtin_rint(t);
            float s, c; sincos_rev(t, s, c); rope_cos[i] = c; rope_sin[i] = s;
          } }
        { PHASE_TID(); for (int m = F.gw; m < M; m += F.NGW) rms_row_to_bf16(lane, A->in[I_X] + (size_t)m * D, A->in[I_FF1_PRE], Hb + (size_t)m * D); }
    }
    SEAM(0);

#pragma unroll 1
    for (int l = 0; l < DEPTH; ++l) {
        const int sb = 1 + l * NPH;
        if (IN(sb + 0)) for (int rp_ = 0; rp_ < 1 + ((PROBE_DBL_MASK >> 0) & 1); ++rp_) { PHASE_BEGIN(); const LayerW w = layer_w(ws, l); pg8::Gemm g{Hb, w.wgu1, M, 2 * FF, D}; pg8::StaticOrder S; S.init(M, 2 * FF, F.G, F.bid); pg8::EpiSwiGLU E{ACT, FF};
            pg8::gemm_phase<pg8::EpiSwiGLU, pg8::StaticOrder, true, true>(F.lds + RING_OFF, g, S, E);
            if (F.bid >= 128 && l + 1 < DEPTH) convert_layer_items(F, A, ws, l + 1, 0, CVQ_A, 128 * NWAVES, (F.G - 128) * NWAVES); }
        SEAM(sb + 0);
        if (IN(sb + 1)) for (int rp_ = 0; rp_ < 1 + ((PROBE_DBL_MASK >> 1) & 1); ++rp_) { PHASE_BEGIN(); const LayerW w = layer_w(ws, l); pg8::Gemm g{ACT, w.wd1, M, D, FF}; pg8::StaticOrder S; S.init(M, D, F.G, F.bid); pg8::EpiF32 E{Yb, D};
            pg8::gemm_phase<pg8::EpiF32, pg8::StaticOrder, true, true>(F.lds + RING_OFF, g, S, E); }
        SEAM(sb + 1);
        if (IN(sb + 2)) { PHASE_BEGIN(); norm_phase<true, true>(F, Yb, l == 0 ? A->in[I_X] : xout, xout, A->in[I_FF1_POST] + l * D, 0.5f, A->in[I_MIX_PRE] + l * D, Hb, A->in[I_WIN] + (size_t)l * D * INW, (float*)(ws + WS_AB));
            if ((PROBE_DBL_MASK >> 18) & 1) norm_phase<true, true>(F, Yb, xout, (float*)ACT, A->in[I_FF1_POST] + l * D, 0.5f, A->in[I_MIX_PRE] + l * D, Zb, A->in[I_WIN] + (size_t)l * D * INW, (float*)(ws + WS_BG)); }
        SEAM(sb + 2);
        if (IN(sb + 3)) for (int rp_ = 0; rp_ < 1 + ((PROBE_DBL_MASK >> 3) & 1); ++rp_) { PHASE_BEGIN(); const LayerW w = layer_w(ws, l); pg8::Gemm g{Hb, w.win, M, ZW, D}; pg8::StaticOrder S; S.init(M, ZW, F.G, F.bid); pg8::EpiBf16P E{Zb, ZW};
            pg8::gemm_phase<pg8::EpiBf16P, pg8::StaticOrder, true, true>(F.lds + RING_OFF, g, S, E); }
        SEAM(sb + 3);
        if (IN(sb + 4)) for (int rp_ = 0; rp_ < 1 + ((PROBE_DBL_MASK >> 4) & 1); ++rp_) { PHASE_BEGIN(); const MixP P = make_mixp(A, ws, l);
#if FAST_S5
            if (F.bid < S5_UNITS) for (int r2_ = 0; r2_ < 1 + ((PROBE_DBL_MASK >> 17) & 1); ++r2_) s5_unit<false>(F, P, ws + WS_S5T + (size_t)l * 32 * S5T_STRIDE, (float*)(ws + WS_S5E), F.bid);
#endif
#if FAST_DN
            for (int r2_ = 0; r2_ < 1 + ((PROBE_DBL_MASK >> 16) & 1); ++r2_) for (int u = F.bid; u < 512; u += F.G) dn_chunk_unit(F, P, ws + WS_DNC, u);
#else
            prep_phase(F, P);
#endif
            }
        SEAM(sb + 4);
        if (IN(sb + 5)) for (int rp_ = 0; rp_ < 1 + ((PROBE_DBL_MASK >> 5) & 1); ++rp_) {
            PHASE_BEGIN(); const MixP P = make_mixp(A, ws, l); const int bid = F.bid;
#if FAST_DN
            if (bid < 16) { for (int r2_ = 0; r2_ < 1 + ((PROBE_DBL_MASK >> 13) & 1); ++r2_) dn_chain(F, P, ws + WS_DNC, bid); }
#else
            if (bid < 8) slow_deltanet(F, P, bid);
#endif
#if FAST_S5
            else { for (int u = bid - 16; u < S5_UNITS + ATT_UNITS; u += F.G - 16) { if (u < S5_UNITS) { for (int r2_ = 0; r2_ < 1 + ((PROBE_DBL_MASK >> 14) & 1); ++r2_) s5_unit<true>(F, P, ws + WS_S5T + (size_t)l * 32 * S5T_STRIDE, (float*)(ws + WS_S5E), u); }
                else { for (int r2_ = 0; r2_ < 1 + ((PROBE_DBL_MASK >> 15) & 1); ++r2_) attn_unit(F, P, u - S5_UNITS); } }
                if (l + 1 < DEPTH) convert_layer_items(F, A, ws, l + 1, CVQ_B, CV_END, 16 * NWAVES, (F.G - 16) * NWAVES); }
#else
            else if (bid < 16) slow_s5(F, P, (bid - 8) * NWAVES + F.wave);
            else { for (int u = bid - 16; u < ATT_UNITS; u += F.G - 16) attn_unit(F, P, u); }
#endif
        }
        SEAM(sb + 5);
        if (IN(sb + 6)) for (int rp_ = 0; rp_ < 1 + ((PROBE_DBL_MASK >> 6) & 1); ++rp_) { PHASE_BEGIN(); const LayerW w = layer_w(ws, l); const MixP P = make_mixp(A, ws, l); pg8::Gemm g{P.ysb, w.wglu, M, 512, 512}; pg8::StaticOrder S; S.init(M, 512, F.G, F.bid);
            pg8::EpiGlu E{P.ys, 512, A->in[I_GLUB] + l * 512, MIXED, MIXW, 1536};
            pg8::gemm_phase<pg8::EpiGlu, pg8::StaticOrder, true, true>(F.lds + RING_OFF, g, S, E);
            dn_post_rows(F, P);
            }
        SEAM(sb + 6);
        if (IN(sb + 7)) for (int rp_ = 0; rp_ < 1 + ((PROBE_DBL_MASK >> 7) & 1); ++rp_) { PHASE_BEGIN(); const LayerW w = layer_w(ws, l); pg8::Gemm g{MIXED, w.wout, M, D, MIXW}; pg8::StaticOrder S; S.init(M, D, F.G, F.bid); pg8::EpiF32 E{Yb, D};
            pg8::gemm_phase<pg8::EpiF32, pg8::StaticOrder, true, true>(F.lds + RING_OFF, g, S, E); }
        SEAM(sb + 7);
        if (IN(sb + 8)) { PHASE_BEGIN(); norm_phase<true, false>(F, Yb, xout, xout, A->in[I_MIX_POST] + l * D, 1.0f, A->in[I_FF2_PRE] + l * D, Hb, nullptr, nullptr);
            if ((PROBE_DBL_MASK >> 18) & 1) norm_phase<true, false>(F, Yb, xout, (float*)ACT, A->in[I_MIX_POST] + l * D, 1.0f, A->in[I_FF2_PRE] + l * D, Zb, nullptr, nullptr); }
        SEAM(sb + 8);
        if (IN(sb + 9)) for (int rp_ = 0; rp_ < 1 + ((PROBE_DBL_MASK >> 9) & 1); ++rp_) { PHASE_BEGIN(); const LayerW w = layer_w(ws, l); pg8::Gemm g{Hb, w.wgu2, M, 2 * FF, D}; pg8::StaticOrder S; S.init(M, 2 * FF, F.G, F.bid); pg8::EpiSwiGLU E{ACT, FF};
            pg8::gemm_phase<pg8::EpiSwiGLU, pg8::StaticOrder, true, true>(F.lds + RING_OFF, g, S, E);
            if (F.bid >= 128 && l + 1 < DEPTH) convert_layer_items(F, A, ws, l + 1, CVQ_A, CVQ_B, 128 * NWAVES, (F.G - 128) * NWAVES); }
        SEAM(sb + 9);
        if (IN(sb + 10)) for (int rp_ = 0; rp_ < 1 + ((PROBE_DBL_MASK >> 10) & 1); ++rp_) { PHASE_BEGIN(); const LayerW w = layer_w(ws, l); pg8::Gemm g{ACT, w.wd2, M, D, FF}; pg8::StaticOrder S; S.init(M, D, F.G, F.bid); pg8::EpiF32 E{Yb, D};
            pg8::gemm_phase<pg8::EpiF32, pg8::StaticOrder, true, true>(F.lds + RING_OFF, g, S, E); }
        SEAM(sb + 10);
        if (IN(sb + 11)) { PHASE_BEGIN();
            if (l + 1 < DEPTH) norm_phase<true, false>(F, Yb, xout, xout, A->in[I_FF2_POST] + l * D, 0.5f, A->in[I_FF1_PRE] + (l + 1) * D, Hb, nullptr, nullptr);
            else norm_phase<false, false>(F, Yb, xout, xout, A->in[I_FF2_POST] + l * D, 0.5f, nullptr, nullptr, nullptr, nullptr);
            if ((PROBE_DBL_MASK >> 18) & 1) norm_phase<true, false>(F, Yb, xout, (float*)ACT, A->in[I_FF2_POST] + l * D, 0.5f, A->in[I_FF1_PRE] + l * D, Zb, nullptr, nullptr);
        }
        SEAM(sb + 11);
    }
#undef IN
#undef SEAM
}

extern "C" void kernel_launch(void* const* d_in, const int* in_sizes, int n_in, void* d_out, int out_size, void* d_ws, size_t ws_size, hipStream_t stream) {
    static int grid = 0;
    if (grid == 0) {
        if (n_in != 30 || in_sizes[0] != M * D || out_size != M * D || ws_size < WS_END) { fprintf(stderr, "kernel_launch: unexpected shapes (n_in %d, in0 %d, out %d, ws %zu need %zu)\n", n_in, n_in > 0 ? in_sizes[0] : -1, out_size, ws_size, (size_t)WS_END); grid = -1; return; }
        int dev = 0, cus = 0, per_cu = 0;
        if (hipGetDevice(&dev) != hipSuccess || hipDeviceGetAttribute(&cus, hipDeviceAttributeMultiprocessorCount, dev) != hipSuccess) { grid = -1; return; }
        if (hipFuncSetAttribute((const void*)mk_fwd, hipFuncAttributeMaxDynamicSharedMemorySize, LDS_BYTES) != hipSuccess) { fprintf(stderr, "kernel_launch: hipFuncSetAttribute failed\n"); grid = -1; return; }
        if (hipOccupancyMaxActiveBlocksPerMultiprocessor(&per_cu, (const void*)mk_fwd, NWAVES * 64, LDS_BYTES) != hipSuccess || per_cu < 1) fprintf(stderr, "kernel_launch: occupancy query says %d\n", per_cu);
        (void)hipGetLastError();
        grid = cus;
    }
    if (grid < 0) return;
    if (hipMemsetAsync((char*)d_ws + WS_CTL, 0, CTL_ZERO_BYTES, stream) != hipSuccess) return;
    Args a{};
    for (int i = 0; i < 30; ++i) a.in[i] = (const float*)d_in[i];
    a.out = (float*)d_out; a.ws = (unsigned char*)d_ws;
#if MK_MULTI
    for (int s = 0; s < NSTEPS; ++s) { a.s_lo = s; a.s_hi = s + 1; hipLaunchKernelGGL(mk_fwd, dim3(grid), dim3(NWAVES * 64), LDS_BYTES, stream, a); }
#else
    a.s_lo = 0; a.s_hi = NSTEPS;
    hipLaunchKernelGGL(mk_fwd, dim3(grid), dim3(NWAVES * 64), LDS_BYTES, stream, a);
#endif
}
```

```cpp
#define NORM2ROW 1
#define PRO_SPLIT 1
#define GLU_IN5 1
#include <hip/hip_runtime.h>
#include <cstdio>
#include <cstdint>
#ifndef EPI_WT
#define EPI_WT 0
#endif
#ifndef FILLER_FIRST
#define FILLER_FIRST 0
#endif
#ifndef CONV_SPLIT
#define CONV_SPLIT 0
#endif
#ifndef GLU_BF16Y
#define GLU_BF16Y 1
#endif
#ifndef GLU_DIRECT
#define GLU_DIRECT 0
#endif
#ifndef Y_BF16
#define Y_BF16 1
#endif
#ifndef FUSED_NORM
#define FUSED_NORM 0
#endif
#ifndef PROBE_DBL_MASK
#define PROBE_DBL_MASK 0
#endif
#ifndef FAST_DN
#define FAST_DN 1
#endif
#ifndef FAST_S5
#define FAST_S5 1
#endif
#ifndef FAST_ATTN
#define FAST_ATTN 1
#endif
namespace pg8 {
#define PG8_LAS __attribute__((address_space(3)))
typedef unsigned short bf16_t;
typedef short bf16x8 __attribute__((ext_vector_type(8)));
typedef float f32x4 __attribute__((ext_vector_type(4)));
typedef unsigned u32x4 __attribute__((ext_vector_type(4)));
constexpr int BM = 256, BK = 64, HALF = 128, HTB = HALF * BK * 2  , STAGE_BYTES = 8 * HTB, NXCD = 8, WGM = 8;

__host__ __device__ __forceinline__ int lds_byte(int r, int c) { const int st = (r >> 4) * 2 + (c >> 5), rr = r & 15, cc = c & 31, ob = rr * 64 + cc * 2; return st * 1024 + (ob ^ (((ob >> 9) & 1) << 5)); }
__host__ __device__ __forceinline__ void stage_rc(int b, int& R, int& C) { const int st = b / 1024, sb = b % 1024, swz = sb ^ (((sb >> 9) & 1) << 5); R = (st >> 1) * 16 + swz / 64; C = (st & 1) * 32 + (swz % 64) / 2; }
__host__ __device__ __forceinline__ int perm32(int rho) { const int n = rho >> 4, i = rho & 15; return 8 * (i >> 2) + 4 * n + (i & 3); }

struct Unit { int pm, pn; };
struct Gemm { const bf16_t* A; const bf16_t* Bt; int M, N, K; };

struct StaticOrder {
    int nM, nN, nwg, G, c;
    __host__ __device__ void init(int M, int N, int G_, int c_) { nM = M / BM; nN = N / BM; nwg = nM * nN; G = G_; c = c_; }
    __host__ __device__ bool next(int i, Unit& u) const {
        const long L = (long)i * G + c; if (L >= nwg) return false;
        int wgid = (int)L; { const int q = nwg / NXCD, r = nwg % NXCD, xcd = wgid % NXCD, off = wgid / NXCD; wgid = (xcd < r ? xcd * (q + 1) : r * (q + 1) + (xcd - r) * q) + off; }
        const int nig = WGM * nN, gid = wgid / nig, fm = gid * WGM, gsz = (nM - fm) < WGM ? (nM - fm) : WGM;
        u.pm = fm + ((wgid % nig) % gsz); u.pn = (wgid % nig) / gsz; return true;
    }
    __device__ __forceinline__ void a_ready(const Unit&) const {}
    __device__ __forceinline__ void done(const Unit&) const {}
};
typedef float f32x2 __attribute__((ext_vector_type(2)));
typedef __bf16 pg8_bf16x2 __attribute__((ext_vector_type(2)));
__device__ __forceinline__ unsigned cvt_pk_bf16(float lo, float hi) { const f32x2 v = {lo, hi}; const pg8_bf16x2 b = __builtin_convertvector(v, pg8_bf16x2); return __builtin_bit_cast(unsigned, b); }
__device__ __forceinline__ float fast_sigmoid(float x) { return __builtin_amdgcn_rcpf(1.0f + __expf(-x)); }
__device__ __forceinline__ float silu_f(float x) { return x * fast_sigmoid(x); }
struct EpiF32 {
    static constexpr bool PERM = false, AFTER_DRAIN = false;
    float* C; int ldc;
    __device__ __forceinline__ void operator()(const f32x4 (&acc)[2][2][4][2], const Unit& u, int wr, int wc, int fr, int fq) const {
        const int row0 = u.pm * BM + wr * 64 + fr, col0 = u.pn * BM + wc * 32 + 4 * fq;
#pragma unroll
        for (int ai = 0; ai < 2; ++ai)
#pragma unroll
            for (int m = 0; m < 4; ++m) { float* rowp = C + (size_t)(row0 + ai * HALF + m * 16) * ldc + col0;
#pragma unroll
                for (int bj = 0; bj < 2; ++bj)
#pragma unroll
                    for (int n = 0; n < 2; ++n) *(f32x4*)(rowp + bj * HALF + n * 16) = acc[ai][bj][m][n]; }
    }
};
struct EpiBf16P {
    static constexpr bool PERM = true, AFTER_DRAIN = false;
    bf16_t* O; int ldc;
    __device__ __forceinline__ void operator()(const f32x4 (&acc)[2][2][4][2], const Unit& u, int wr, int wc, int fr, int fq) const {
#if EPI_WT
        const __amdgpu_buffer_rsrc_t rs = __builtin_amdgcn_make_buffer_rsrc((void*)O, (short)0, 0x7ffffff0, 0x00020000);
#endif
        const int row0 = u.pm * BM + wr * 64 + fr, col0 = u.pn * BM + wc * 32 + 8 * fq;
#pragma unroll
        for (int ai = 0; ai < 2; ++ai)
#pragma unroll
            for (int m = 0; m < 4; ++m) { bf16_t* rowp = O + (size_t)(row0 + ai * HALF + m * 16) * ldc + col0;
#pragma unroll
                for (int bj = 0; bj < 2; ++bj) { const f32x4 v0 = acc[ai][bj][m][0], v1 = acc[ai][bj][m][1];
                    u32x4 w; w.x = cvt_pk_bf16(v0[0], v0[1]); w.y = cvt_pk_bf16(v0[2], v0[3]); w.z = cvt_pk_bf16(v1[0], v1[1]); w.w = cvt_pk_bf16(v1[2], v1[3]);
#if EPI_WT
                    __builtin_amdgcn_raw_buffer_store_b128(w, rs, (int)((size_t)((rowp + bj * HALF) - O) * 2), 0, 16);
#else
                    *(u32x4*)(rowp + bj * HALF) = w;
#endif
                    } }
    }
};
struct EpiSwiGLU {
    static constexpr bool PERM = true, AFTER_DRAIN = false;
    bf16_t* O; int ldc;
    __device__ __forceinline__ void operator()(const f32x4 (&acc)[2][2][4][2], const Unit& u, int wr, int wc, int fr, int fq) const {
        const int row0 = u.pm * BM + wr * 64 + fr, col0 = u.pn * HALF + wc * 32 + 8 * fq;
#if EPI_WT
        const __amdgpu_buffer_rsrc_t rs = __builtin_amdgcn_make_buffer_rsrc((void*)O, (short)0, 0x7ffffff0, 0x00020000);
#endif
#pragma unroll
        for (int ai = 0; ai < 2; ++ai)
#pragma unroll
            for (int m = 0; m < 4; ++m) { bf16_t* rowp = O + (size_t)(row0 + ai * HALF + m * 16) * ldc + col0;
                const f32x4 g0 = acc[ai][0][m][0], g1 = acc[ai][0][m][1], u0 = acc[ai][1][m][0], u1 = acc[ai][1][m][1];
                f32x4 v0, v1;
#pragma unroll
                for (int j = 0; j < 4; ++j) { v0[j] = silu_f(g0[j]) * u0[j]; v1[j] = silu_f(g1[j]) * u1[j]; }
                u32x4 w; w.x = cvt_pk_bf16(v0[0], v0[1]); w.y = cvt_pk_bf16(v0[2], v0[3]); w.z = cvt_pk_bf16(v1[0], v1[1]); w.w = cvt_pk_bf16(v1[2], v1[3]);
#if EPI_WT
                __builtin_amdgcn_raw_buffer_store_b128(w, rs, (int)((size_t)(rowp - O) * 2), 0, 16);
#else
                *(u32x4*)rowp = w;
#endif
                }
    }
};
#if GLU_BF16Y
struct EpiGlu {
    static constexpr bool PERM = true, AFTER_DRAIN = false;
    const bf16_t* Y; int ldy; const float* bias; bf16_t* O; int ldo; int ocol0;
    __device__ __forceinline__ void operator()(const f32x4 (&acc)[2][2][4][2], const Unit& u, int wr, int wc, int fr, int fq) const {
        const int row0 = u.pm * BM + wr * 64 + fr, col0 = u.pn * BM + wc * 32 + 8 * fq;
        f32x4 bb[2][2];
#pragma unroll
        for (int bj = 0; bj < 2; ++bj) { bb[bj][0] = *(const f32x4*)(bias + col0 + bj * HALF); bb[bj][1] = *(const f32x4*)(bias + col0 + bj * HALF + 4); }
#pragma unroll
        for (int ai = 0; ai < 2; ++ai) {
            u32x4 yv[4][2];
#pragma unroll
            for (int m = 0; m < 4; ++m)
#pragma unroll
                for (int bj = 0; bj < 2; ++bj) yv[m][bj] = *(const u32x4*)(Y + (size_t)(row0 + ai * HALF + m * 16) * ldy + col0 + bj * HALF);
            asm volatile("" ::: "memory");
#pragma unroll
            for (int m = 0; m < 4; ++m) { const int row = row0 + ai * HALF + m * 16;
#pragma unroll
                for (int bj = 0; bj < 2; ++bj) { const int c = col0 + bj * HALF; const u32x4 y = yv[m][bj];
                    const f32x4 y0 = {__builtin_bit_cast(float, y.x << 16), __builtin_bit_cast(float, y.x & 0xffff0000u), __builtin_bit_cast(float, y.y << 16), __builtin_bit_cast(float, y.y & 0xffff0000u)};
                    const f32x4 y1 = {__builtin_bit_cast(float, y.z << 16), __builtin_bit_cast(float, y.z & 0xffff0000u), __builtin_bit_cast(float, y.w << 16), __builtin_bit_cast(float, y.w & 0xffff0000u)};
                    f32x4 v0, v1;
#pragma unroll
                    for (int j = 0; j < 4; ++j) { v0[j] = y0[j] * fast_sigmoid(acc[ai][bj][m][0][j] + bb[bj][0][j]); v1[j] = y1[j] * fast_sigmoid(acc[ai][bj][m][1][j] + bb[bj][1][j]); }
                    u32x4 w; w.x = cvt_pk_bf16(v0[0], v0[1]); w.y = cvt_pk_bf16(v0[2], v0[3]); w.z = cvt_pk_bf16(v1[0], v1[1]); w.w = cvt_pk_bf16(v1[2], v1[3]);
                    *(u32x4*)(O + (size_t)row * ldo + ocol0 + c) = w; } }
            asm volatile("" ::: "memory");
        }
    }
};
#else
struct EpiGlu {
    static constexpr bool PERM = true, AFTER_DRAIN = false;
    const float* Y; int ldy; const float* bias; bf16_t* O; int ldo; int ocol0;
    __device__ __forceinline__ void operator()(const f32x4 (&acc)[2][2][4][2], const Unit& u, int wr, int wc, int fr, int fq) const {
        const int row0 = u.pm * BM + wr * 64 + fr, col0 = u.pn * BM + wc * 32 + 8 * fq;
#pragma unroll
        for (int ai = 0; ai < 2; ++ai)
#pragma unroll
            for (int m = 0; m < 4; ++m) { const int row = row0 + ai * HALF + m * 16;
#pragma unroll
                for (int bj = 0; bj < 2; ++bj) { const int c = col0 + bj * HALF;
                    const f32x4 y0 = *(const f32x4*)(Y + (size_t)row * ldy + c), y1 = *(const f32x4*)(Y + (size_t)row * ldy + c + 4);
                    const f32x4 b0 = *(const f32x4*)(bias + c), b1 = *(const f32x4*)(bias + c + 4);
                    f32x4 v0, v1;
#pragma unroll
                    for (int j = 0; j < 4; ++j) { v0[j] = y0[j] * fast_sigmoid(acc[ai][bj][m][0][j] + b0[j]); v1[j] = y1[j] * fast_sigmoid(acc[ai][bj][m][1][j] + b1[j]); }
                    u32x4 w; w.x = cvt_pk_bf16(v0[0], v0[1]); w.y = cvt_pk_bf16(v0[2], v0[3]); w.z = cvt_pk_bf16(v1[0], v1[1]); w.w = cvt_pk_bf16(v1[2], v1[3]);
                    *(u32x4*)(O + (size_t)row * ldo + ocol0 + c) = w; } }
    }
};
#endif
struct EpiRmsRes {
    static constexpr bool PERM = false, AFTER_DRAIN = true;
    const float* xsrc; float* xdst; bf16_t* h; const float* g1; const float* g2; float rw;
    unsigned long long* slots;
    unsigned* cnt; unsigned target; unsigned* tmo;
    __device__ __forceinline__ void refuse(size_t, size_t, int, int) const {}
    __device__ __forceinline__ void fused(f32x4 (&acc)[2][2][4][2], const Unit& u, int wr, int wc, int fr, int fq, PG8_LAS unsigned char* lds, int wid, int lane) const {
        typedef unsigned u32x2v __attribute__((ext_vector_type(2)));
        constexpr int DD = 2048; constexpr float EPS = 1e-6f;
#pragma unroll
        for (int ai = 0; ai < 2; ++ai)
#pragma unroll
            for (int m = 0; m < 4; ++m) { const int r = ai * HALF + wr * 64 + m * 16 + fr;
#pragma unroll
                for (int bj = 0; bj < 2; ++bj)
#pragma unroll
                    for (int n = 0; n < 2; ++n) { const int c = bj * HALF + wc * 32 + n * 16 + 4 * fq; const f32x4 y = acc[ai][bj][m][n];
                        u32x2v w; w.x = cvt_pk_bf16(y[0], y[1]); w.y = cvt_pk_bf16(y[2], y[3]);
                        *(PG8_LAS u32x2v*)(lds + r * 512 + ((2 * c) ^ ((r & 15) << 3))) = w; } }
        asm volatile("s_waitcnt lgkmcnt(0)" ::: "memory"); __builtin_amdgcn_s_barrier(); asm volatile("" ::: "memory");
        const int cb = u.pn * BM + 4 * lane;
        const f32x4 g1v = *(const f32x4*)(g1 + cb);
        float* slf = (float*)slots + (size_t)(u.pm * BM) * 32 + u.pn * 4;
        f32x4 xa[32];
#pragma unroll
        for (int rr = 0; rr < 32; ++rr) xa[rr] = *(const f32x4*)(xsrc + (size_t)(u.pm * BM + wid * 32 + rr) * DD + cb);
#pragma unroll
        for (int qd = 0; qd < 4; ++qd) { const int rb = wid * 32 + qd * 8;
            float v[32];
#pragma unroll
            for (int rr = 0; rr < 8; ++rr) { const int r = rb + rr; const u32x2v yw = *(const PG8_LAS u32x2v*)(lds + r * 512 + ((8 * lane) ^ ((r & 15) << 3)));
                const f32x4 y = (f32x4){__uint_as_float(yw.x << 16), __uint_as_float(yw.x & 0xffff0000u), __uint_as_float(yw.y << 16), __uint_as_float(yw.y & 0xffff0000u)};
                const f32x4 gy = g1v * y, xx = xa[8 * qd + rr];
                v[4 * rr + 0] = (y[0] * y[0] + y[1] * y[1]) + (y[2] * y[2] + y[3] * y[3]); v[4 * rr + 1] = (xx[0] * xx[0] + xx[1] * xx[1]) + (xx[2] * xx[2] + xx[3] * xx[3]);
                v[4 * rr + 2] = (xx[0] * gy[0] + xx[1] * gy[1]) + (xx[2] * gy[2] + xx[3] * gy[3]); v[4 * rr + 3] = (gy[0] * gy[0] + gy[1] * gy[1]) + (gy[2] * gy[2] + gy[3] * gy[3]); }
#pragma unroll
            for (int B = 4; B >= 0; --B) { const int half = 1 << B; const bool up = (lane >> B) & 1;
#pragma unroll
                for (int k = 0; k < 16; ++k) if (k < half) { const float lo = v[k], hi = v[k + half]; const float snd = up ? lo : hi, kp = up ? hi : lo; v[k] = kp + __shfl_xor(snd, half); } }
            v[0] += __shfl_xor(v[0], 32);
            if (lane < 32) __hip_atomic_store(slf + (size_t)(rb + (lane >> 2)) * 32 + (lane & 3), v[0], __ATOMIC_RELAXED, __HIP_MEMORY_SCOPE_AGENT);
        }
        asm volatile("s_waitcnt vmcnt(0)" ::: "memory");
        if (lane == 0) __hip_atomic_fetch_add(cnt + 64 * u.pm, 1u, __ATOMIC_RELAXED, __HIP_MEMORY_SCOPE_AGENT);
        if (wid == 0) { const unsigned long long t0 = __builtin_amdgcn_s_memrealtime();
            for (;;) { if ((unsigned)__builtin_amdgcn_readfirstlane(__hip_atomic_load(cnt + 64 * u.pm, __ATOMIC_RELAXED, __HIP_MEMORY_SCOPE_AGENT)) >= target) break;
                if (__builtin_amdgcn_s_memrealtime() - t0 > 2000000ull) { if (lane == 0) __hip_atomic_store(tmo, 1u, __ATOMIC_RELAXED, __HIP_MEMORY_SCOPE_AGENT); break; }
                __builtin_amdgcn_s_sleep(2); }
            __builtin_amdgcn_fence(__ATOMIC_ACQUIRE, "agent"); }
        asm volatile("s_waitcnt vmcnt(0) lgkmcnt(0)" ::: "memory"); __builtin_amdgcn_s_barrier(); asm volatile("" ::: "memory");
        const f32x4 g2v = h ? *(const f32x4*)(g2 + cb) : (f32x4){0.f, 0.f, 0.f, 0.f};
#pragma unroll
        for (int qd = 0; qd < 4; ++qd) { const int rb = wid * 32 + qd * 8; const int l5 = lane & 31;
            const float* sl = (const float*)slots + (size_t)(u.pm * BM + rb + (l5 >> 2)) * 32 + (l5 & 3); float tot = 0.f;
#pragma unroll
            for (int t = 0; t < 8; ++t) tot += __hip_atomic_load(sl + 4 * t, __ATOMIC_RELAXED, __HIP_MEMORY_SCOPE_AGENT);
            const float syy = __shfl(tot, lane & ~3), sxx = __shfl(tot, (lane & ~3) + 1), sxy = __shfl(tot, (lane & ~3) + 2), sgg = __shfl(tot, (lane & ~3) + 3);
            const float alpha = rw / sqrtf(syy * (1.0f / DD) + EPS); const float q = sxx + 2.0f * alpha * sxy + alpha * alpha * sgg;
            const float r2 = 1.0f / sqrtf(q * (1.0f / DD) + EPS);
#pragma unroll
            for (int rr = 0; rr < 8; ++rr) { const int r = rb + rr; const float a = __shfl(alpha, 4 * rr), b2 = __shfl(r2, 4 * rr);
                const u32x2v yw = *(const PG8_LAS u32x2v*)(lds + r * 512 + ((8 * lane) ^ ((r & 15) << 3)));
                const f32x4 y = (f32x4){__uint_as_float(yw.x << 16), __uint_as_float(yw.x & 0xffff0000u), __uint_as_float(yw.y << 16), __uint_as_float(yw.y & 0xffff0000u)};
                const f32x4 xn = xa[8 * qd + rr] + (g1v * y) * a; const size_t off = (size_t)(u.pm * BM + r) * DD + cb;
                *(f32x4*)(xdst + off) = xn;
                if (h) { const f32x4 hv = (xn * g2v) * b2; u32x2v w; w.x = cvt_pk_bf16(hv[0], hv[1]); w.y = cvt_pk_bf16(hv[2], hv[3]); *(u32x2v*)(h + off) = w; } }
        }
    }
};
template <class Epi, class Sched, bool ALIGN_EPI = false, bool SP2 = false>
__device__ __forceinline__ void gemm_phase(PG8_LAS unsigned char* lds, const Gemm g, const Sched& S, const Epi& E) {
    int tid_ = threadIdx.x; asm volatile("" : "+v"(tid_));
    const int tid = tid_, wid = __builtin_amdgcn_readfirstlane(tid >> 6), lane = tid & 63, wr = wid >> 2, wc = wid & 3, fr = lane & 15, fq = lane >> 4;
    const int K = g.K, nt = K / BK;
    unsigned voffA[2], voffB[2];
#pragma unroll
    for (int i = 0; i < 2; ++i) { int R, C; stage_rc(tid * 16 + i * 8192, R, C); const int Rb = Epi::PERM ? ((R & ~31) + perm32(R & 31)) : R;
        voffA[i] = (unsigned)(R * K + C) * 2u; voffB[i] = (unsigned)(Rb * K + C) * 2u; }
    const size_t kstep = (size_t)(BK * 2);
    const size_t hstep = (size_t)HALF * K * 2;
    const size_t tstep = 2 * hstep;
    const unsigned ldsw = (unsigned)wid * 1024u;
    const int aoff = lds_byte(wr * 64 + fr, fq * 8), boff = lds_byte(wc * 32 + fr, fq * 8);
#define PG8_SA(b, h) (((b) * 2 + (h)) * HTB)
#define PG8_SB(b, h) ((4 + (b) * 2 + (h)) * HTB)
#define PG8_STAGE(bufoff, gbase, voff) do { _Pragma("unroll") for (int _i = 0; _i < 2; ++_i) \
        __builtin_amdgcn_global_load_lds((const unsigned*)((const char*)(gbase) + (voff)[_i]), (PG8_LAS unsigned*)(lds + (bufoff) + ldsw + _i * 8192), 16, 0, 0); } while (0)
#define PG8_LDA(dst, b, h) do { _Pragma("unroll") for (int m = 0; m < 4; ++m) _Pragma("unroll") for (int k = 0; k < 2; ++k) dst[m][k] = *(const PG8_LAS bf16x8*)(lds + PG8_SA(b, h) + aoff + m * 2048 + k * 1024); } while (0)
#define PG8_LDB(dst, b, h) do { _Pragma("unroll") for (int n = 0; n < 2; ++n) _Pragma("unroll") for (int k = 0; k < 2; ++k) dst[n][k] = *(const PG8_LAS bf16x8*)(lds + PG8_SB(b, h) + boff + n * 2048 + k * 1024); } while (0)
#define PG8_MMA(ai, bj, At, Bt) do { __builtin_amdgcn_s_setprio(1); _Pragma("unroll") for (int m = 0; m < 4; ++m) _Pragma("unroll") for (int n = 0; n < 2; ++n) _Pragma("unroll") for (int k = 0; k < 2; ++k) \
        acc[ai][bj][m][n] = __builtin_amdgcn_mfma_f32_16x16x32_bf16(Bt[n][k], At[m][k], acc[ai][bj][m][n], 0, 0, 0); __builtin_amdgcn_s_setprio(0); } while (0)
#define PG8_WAIT_V(n) asm volatile("s_waitcnt vmcnt(" #n ")" ::: "memory")
#define PG8_WAIT_L(n) asm volatile("s_waitcnt lgkmcnt(" #n ")" ::: "memory")
#define PG8_BAR __builtin_amdgcn_s_barrier()
#define PG8_SCHED __builtin_amdgcn_sched_barrier(0)
    Unit cur, nxt; int ui = 0;
    if (!S.next(0, cur)) return;
    f32x4 acc[2][2][4][2];
#pragma unroll
    for (int a = 0; a < 2; ++a)
#pragma unroll
        for (int b = 0; b < 2; ++b)
#pragma unroll
            for (int m = 0; m < 4; ++m)
#pragma unroll
                for (int n = 0; n < 2; ++n) acc[a][b][m][n] = (f32x4){0.f, 0.f, 0.f, 0.f};
    bf16x8 At[4][2], B0[2][2], B1[2][2];
    const char* cA = (const char*)g.A + (size_t)cur.pm * tstep; const char* cB = (const char*)g.Bt + (size_t)cur.pn * tstep;
    S.a_ready(cur);
    if constexpr (SP2) {
        PG8_STAGE(PG8_SB(0, 0), cB, voffB); PG8_STAGE(PG8_SB(0, 1), cB + hstep, voffB); PG8_STAGE(PG8_SA(0, 0), cA, voffA); PG8_STAGE(PG8_SA(0, 1), cA + hstep, voffA);
        if (wr == 1) PG8_BAR;
        PG8_WAIT_V(2); PG8_BAR;
        PG8_STAGE(PG8_SB(1, 0), cB + kstep, voffB); PG8_STAGE(PG8_SA(1, 0), cA + kstep, voffA); PG8_STAGE(PG8_SB(1, 1), cB + hstep + kstep, voffB);
        PG8_WAIT_V(6); PG8_BAR;
    } else {
        PG8_STAGE(PG8_SB(0, 0), cB, voffB); PG8_STAGE(PG8_SA(0, 0), cA, voffA); PG8_STAGE(PG8_SB(0, 1), cB + hstep, voffB); PG8_STAGE(PG8_SA(0, 1), cA + hstep, voffA);
        if (wr == 1) PG8_BAR;
        PG8_WAIT_V(4); PG8_BAR;
        PG8_STAGE(PG8_SB(1, 0), cB + kstep, voffB); PG8_STAGE(PG8_SA(1, 0), cA + kstep, voffA); PG8_STAGE(PG8_SB(1, 1), cB + hstep + kstep, voffB);
        PG8_WAIT_V(6); PG8_BAR;
    }
    for (;;) {
        const bool has_next = S.next(ui + 1, nxt);
        const char* nA = has_next ? (const char*)g.A + (size_t)nxt.pm * tstep : cA; const char* nB = has_next ? (const char*)g.Bt + (size_t)nxt.pn * tstep : cB;
        for (int t = 0; t < nt; t += 2) {
            const bool last = (t == nt - 2);
            const char* a1 = cA + (size_t)(t + 1) * kstep;
            const char* a2 = last ? nA : cA + (size_t)(t + 2) * kstep; const char* b2 = last ? nB : cB + (size_t)(t + 2) * kstep;
            const char* a3 = a2 + kstep; const char* b3 = b2 + kstep;
            if (last && has_next) S.a_ready(nxt);
            if constexpr (SP2) {
            PG8_LDB(B0, 0, 0); PG8_LDB(B1, 0, 1); PG8_SCHED; PG8_LDA(At, 0, 0); PG8_STAGE(PG8_SA(1, 1), a1 + hstep, voffA);
            PG8_WAIT_V(8); PG8_WAIT_L(0); PG8_BAR; PG8_MMA(0, 0, At, B0); PG8_MMA(0, 1, At, B1); PG8_BAR; PG8_SCHED;
            PG8_LDA(At, 0, 1); PG8_STAGE(PG8_SB(0, 0), b2, voffB); PG8_STAGE(PG8_SB(0, 1), b2 + hstep, voffB); PG8_STAGE(PG8_SA(0, 0), a2, voffA);
            PG8_WAIT_V(8); PG8_WAIT_L(0); PG8_BAR; PG8_MMA(1, 0, At, B0); PG8_MMA(1, 1, At, B1); PG8_BAR; PG8_SCHED;
            PG8_LDB(B0, 1, 0); PG8_LDB(B1, 1, 1); PG8_SCHED; PG8_LDA(At, 1, 0); PG8_STAGE(PG8_SA(0, 1), a2 + hstep, voffA);
            PG8_WAIT_V(8); PG8_WAIT_L(0); PG8_BAR; PG8_MMA(0, 0, At, B0); PG8_MMA(0, 1, At, B1); PG8_BAR; PG8_SCHED;
            PG8_LDA(At, 1, 1); PG8_STAGE(PG8_SB(1, 0), b3, voffB); PG8_STAGE(PG8_SB(1, 1), b3 + hstep, voffB); PG8_STAGE(PG8_SA(1, 0), a3, voffA);
            PG8_WAIT_V(8); PG8_WAIT_L(0); PG8_BAR; PG8_MMA(1, 0, At, B0); PG8_MMA(1, 1, At, B1); PG8_BAR; PG8_SCHED;
            } else {
            PG8_LDB(B0, 0, 0); PG8_SCHED; PG8_LDA(At, 0, 0); PG8_STAGE(PG8_SA(1, 1), a1 + hstep, voffA);
            PG8_WAIT_L(8); PG8_BAR; PG8_WAIT_L(0); PG8_MMA(0, 0, At, B0); PG8_BAR; PG8_SCHED;
            PG8_LDB(B1, 0, 1); PG8_STAGE(PG8_SB(0, 0), b2, voffB);
            PG8_BAR; PG8_WAIT_L(0); PG8_MMA(0, 1, At, B1); PG8_BAR;
            PG8_LDA(At, 0, 1); PG8_STAGE(PG8_SA(0, 0), a2, voffA);
            PG8_BAR; PG8_WAIT_L(0); PG8_MMA(1, 0, At, B0); PG8_BAR; PG8_SCHED;
            PG8_STAGE(PG8_SB(0, 1), b2 + hstep, voffB);
            PG8_WAIT_V(6); PG8_BAR; PG8_MMA(1, 1, At, B1); PG8_BAR;
            PG8_LDB(B0, 1, 0); PG8_SCHED; PG8_LDA(At, 1, 0); PG8_STAGE(PG8_SA(0, 1), a2 + hstep, voffA);
            PG8_WAIT_L(8); PG8_BAR; PG8_WAIT_L(0); PG8_MMA(0, 0, At, B0); PG8_BAR; PG8_SCHED;
            PG8_LDB(B1, 1, 1); PG8_STAGE(PG8_SB(1, 0), b3, voffB);
            PG8_BAR; PG8_WAIT_L(0); PG8_MMA(0, 1, At, B1); PG8_BAR;
            PG8_LDA(At, 1, 1); PG8_STAGE(PG8_SA(1, 0), a3, voffA);
            PG8_BAR; PG8_WAIT_L(0); PG8_MMA(1, 0, At, B0); PG8_BAR; PG8_SCHED;
            PG8_STAGE(PG8_SB(1, 1), b3 + hstep, voffB);
            PG8_WAIT_V(6); PG8_BAR; PG8_MMA(1, 1, At, B1); PG8_BAR;
            }
        }
        if constexpr (ALIGN_EPI) { if (wr == 0) PG8_BAR; }
        if constexpr (!Epi::AFTER_DRAIN) { E(acc, cur, wr, wc, fr, fq); S.done(cur); }
        if (!has_next) break;
#pragma unroll
        for (int a = 0; a < 2; ++a)
#pragma unroll
            for (int b = 0; b < 2; ++b)
#pragma unroll
                for (int m = 0; m < 4; ++m)
#pragma unroll
                    for (int n = 0; n < 2; ++n) acc[a][b][m][n] = (f32x4){0.f, 0.f, 0.f, 0.f};
        cur = nxt; cA = nA; cB = nB; ++ui;
        if constexpr (ALIGN_EPI) { if (wr == 1) PG8_BAR; }
    }
    PG8_WAIT_V(0);
    if constexpr (!ALIGN_EPI) { if (wr == 0) PG8_BAR; }
    PG8_BAR;
    if constexpr (Epi::AFTER_DRAIN) { E.fused(acc, cur, wr, wc, fr, fq, lds, wid, lane); S.done(cur); }
#undef PG8_SA
#undef PG8_SB
#undef PG8_STAGE
#undef PG8_LDA
#undef PG8_LDB
#undef PG8_MMA
#undef PG8_WAIT_V
#undef PG8_WAIT_L
#undef PG8_BAR
#undef PG8_SCHED
}
}
#ifndef MK_MULTI
#define MK_MULTI 0
#endif
constexpr int NWAVES = 8;
constexpr int BATCH = 2, SEQ = 4096, M = BATCH * SEQ, D = 2048, FF = 5632, DEPTH = 4;
constexpr int ZW = 4096, INW = 4104, MIXW = 2048;
constexpr int Z_AQ = 0, Z_AK = 1024, Z_AV = 1280, Z_DQKV = 1536, Z_DZ = 3072, Z_S5 = 3584;
constexpr int SRC_AB = 3584, SRC_S5 = 3592;
constexpr float NORM_EPS = 1e-6f;
constexpr size_t al256(size_t x) { return (x + 255) & ~(size_t)255; }
constexpr size_t MiB = 1u << 20;
constexpr size_t WS_CTL = 0, CTL_ZERO_BYTES = 1 * MiB;
constexpr size_t SZ_WGU = (size_t)2 * FF * D * 2, SZ_WD = (size_t)D * FF * 2, SZ_WIN = (size_t)ZW * D * 2, SZ_WOUT = (size_t)D * MIXW * 2, SZ_WGLU = (size_t)512 * 512 * 2;
constexpr size_t SZ_LAYER_W = 2 * SZ_WGU + 2 * SZ_WD + SZ_WIN + SZ_WOUT + SZ_WGLU;
constexpr size_t OFF_WGU1 = 0, OFF_WD1 = OFF_WGU1 + SZ_WGU, OFF_WIN = OFF_WD1 + SZ_WD, OFF_WOUT = OFF_WIN + SZ_WIN, OFF_WGU2 = OFF_WOUT + SZ_WOUT, OFF_WD2 = OFF_WGU2 + SZ_WGU, OFF_WGLU = OFF_WD2 + SZ_WD;
constexpr size_t WS_ROPE = WS_CTL + CTL_ZERO_BYTES;
constexpr size_t WS_W = WS_ROPE + 2 * MiB;
constexpr size_t WS_H = al256(WS_W + DEPTH * SZ_LAYER_W);
constexpr size_t WS_ACT = WS_H + (size_t)M * D * 2;
constexpr size_t WS_Y = WS_ACT + (size_t)M * FF * 2;
constexpr size_t WS_Z = WS_Y + (size_t)M * D * 4;
constexpr size_t WS_MIXED = WS_Z + (size_t)M * ZW * 2;
constexpr size_t WS_AB = WS_MIXED + (size_t)M * MIXW * 2;
constexpr size_t WS_BG = WS_AB + (size_t)M * 8 * 4;
constexpr size_t WS_KR = WS_BG + (size_t)M * 8 * 4;
constexpr size_t WS_QN = WS_KR + (size_t)M * 256 * 4;
constexpr size_t WS_KN = WS_QN + (size_t)M * 512 * 4;
constexpr size_t WS_VC = WS_KN + (size_t)M * 512 * 4;
constexpr size_t WS_ORAW = WS_VC + (size_t)M * 512 * 4;
constexpr size_t WS_YS = WS_ORAW + (size_t)M * 512 * 4;
constexpr size_t WS_YSB = WS_YS + (size_t)M * 512 * 4;
constexpr size_t WS_S5T = WS_YSB + (size_t)M * 512 * 2;
constexpr size_t WS_S5E = WS_S5T + (size_t)DEPTH * 32 * 140288;
constexpr size_t WS_DNC = WS_S5E + (size_t)2 * 16 * 32 * 128 * 4;
constexpr size_t WS_XS = WS_DNC + (size_t)512 * 106752;
constexpr size_t WS_END = WS_XS + (size_t)32 * 256 * 8 * 16;
static_assert(WS_KN == WS_QN + (size_t)M * 512 * 4 && WS_VC == WS_KN + (size_t)M * 512 * 4, "qn | kn | vc consecutive");
constexpr int CW_TMO = 0, CW_CODE = 1, CW_BAR = 4096, CW_CNT = 16384;
constexpr int RING_OFF = 0, RING_BYTES = 131072;
constexpr int LDS_BYTES = 155648;
constexpr int MISC_OFF = LDS_BYTES - 512;

#define GAS __attribute__((address_space(1)))
#define LAS __attribute__((address_space(3)))
typedef unsigned short bf16;
typedef unsigned v4u __attribute__((ext_vector_type(4)));
typedef unsigned v2u __attribute__((ext_vector_type(2)));
typedef float f32x4 __attribute__((ext_vector_type(4)));
typedef short bf16x8 __attribute__((ext_vector_type(8)));
#define LDS_WAIT() asm volatile("s_waitcnt lgkmcnt(0)" ::: "memory")
#define VM_WAIT() asm volatile("s_waitcnt vmcnt(0)" ::: "memory")
__device__ __forceinline__ unsigned f2bf(float f) { unsigned u = __builtin_bit_cast(unsigned, f); return (u + 0x7fffu + ((u >> 16) & 1u)) >> 16; }
__device__ __forceinline__ unsigned pk2(float lo, float hi) { return f2bf(lo) | (f2bf(hi) << 16); }
__device__ __forceinline__ float bf2f(bf16 b) { return __builtin_bit_cast(float, (unsigned)b << 16); }
__device__ __forceinline__ float bflo(unsigned w) { return __builtin_bit_cast(float, w << 16); }
__device__ __forceinline__ float bfhi(unsigned w) { return __builtin_bit_cast(float, w & 0xffff0000u); }
__device__ __forceinline__ float wave_sum(float v) {
#pragma unroll
    for (int o = 1; o < 64; o <<= 1) v += __shfl_xor(v, o);
    return v;
}
__device__ __forceinline__ float wave_max(float v) {
#pragma unroll
    for (int o = 1; o < 64; o <<= 1) v = fmaxf(v, __shfl_xor(v, o));
    return v;
}
__device__ __forceinline__ float sigmoid_f(float x) { return 1.0f / (1.0f + __expf(-x)); }
__device__ __forceinline__ float gelu_tanh(float x) { const float u = 0.7978845608028654f * (x + 0.044715f * x * x * x); const float e = __expf(2.0f * u); const float th = 1.0f - 2.0f / (e + 1.0f); return 0.5f * x * (1.0f + th); }
#define XB_TMO      128
#define XB_XCNT(j)  (256  + 64 * (j))
#define XB_XSUB(j)  (1280 + 64 * (j))
#define XB_XGEN(j)  (2304 + 64 * (j))
#define XB_TOP      3328
#define XB_TOPGEN   3392
#define XCD_BAR_WORDS 3456
#define XB_SPIN_CAP (1u << 24)
#ifndef XB_EARLY_WB
#define XB_EARLY_WB 0
#endif

__device__ __forceinline__ unsigned xb_ld(unsigned* p)              { return __hip_atomic_load(p, __ATOMIC_RELAXED, __HIP_MEMORY_SCOPE_AGENT); }
__device__ __forceinline__ unsigned xb_add(unsigned* p, unsigned v) { return __hip_atomic_fetch_add(p, v, __ATOMIC_RELAXED, __HIP_MEMORY_SCOPE_AGENT); }
__device__ __forceinline__ unsigned xb_xcc_id() { return (unsigned)__builtin_amdgcn_s_getreg((3 << 11) | 20) & 0xFu; }
#define XB_SPIN(cond, bar) do { unsigned _sp = 0; while (cond) { __builtin_amdgcn_s_sleep(1); \
    if ((++_sp & 255u) == 0u) { if (xb_ld(&(bar)[XB_TMO])) break; if (_sp > XB_SPIN_CAP) { atomicAdd(&(bar)[XB_TMO], 1u); break; } } } } while (0)

struct XcdBarrier {
    unsigned* bar; unsigned x;
    volatile LAS unsigned* st;
    unsigned expect;
};

__device__ __forceinline__ XcdBarrier xcd_barrier_post(unsigned* bar, volatile LAS unsigned* st) {
    XcdBarrier b; b.bar = bar; b.x = xb_xcc_id(); b.st = st; b.expect = 0u;
    if (threadIdx.x == 0) (void)xb_add(&bar[XB_XCNT(b.x)], 1u);
    return b;
}
__device__ __forceinline__ void xcd_barrier_complete(unsigned* bar, unsigned x, unsigned& nloc, unsigned& nx, unsigned expect) {
    const unsigned G = expect ? expect : gridDim.x * gridDim.y * gridDim.z;
    unsigned sum, cnt, mine, sp = 0u;
    for (;;) {
        sum = 0u; cnt = 0u; mine = 0u;
#pragma unroll
        for (unsigned j = 0; j < 16; ++j) { const unsigned c = xb_ld(&bar[XB_XCNT(j)]); sum += c; cnt += (c > 0u) ? 1u : 0u; mine = (j == x) ? c : mine; }
        if (sum == G) break;
        __builtin_amdgcn_s_sleep(1);
        if ((++sp & 255u) == 0u) { if (xb_ld(&bar[XB_TMO])) break; if (sp > XB_SPIN_CAP) { atomicAdd(&bar[XB_TMO], 1u); break; } }
    }
    nloc = mine > 0u ? mine : 1u; nx = cnt > 0u ? cnt : 1u;
}

__device__ __forceinline__ void xcd_barrier(const XcdBarrier& b) {
    asm volatile("s_waitcnt vmcnt(0)" ::: "memory");
    __syncthreads();
    if (threadIdx.x == 0) {
        unsigned* bar = b.bar; unsigned bx = b.x;
        asm volatile("" : "+s"(bar), "+s"(bx));
        __builtin_amdgcn_s_waitcnt(0);
        unsigned nloc = b.st[0], nx = b.st[1];
        if (nloc == 0u) { xcd_barrier_complete(bar, bx, nloc, nx, b.expect); b.st[0] = nloc; b.st[1] = nx; }
        const unsigned old = xb_add(&bar[XB_XSUB(bx)], 1u);
        const unsigned gen = old / nloc;
        if (old + 1u == (gen + 1u) * nloc) {
            __builtin_amdgcn_fence(__ATOMIC_RELEASE, "agent");
            asm volatile("s_waitcnt vmcnt(0)" ::: "memory");
            const unsigned og = xb_add(&bar[XB_TOP], 1u);
            const unsigned tg = og / nx;
            if (og + 1u == (tg + 1u) * nx) xb_add(&bar[XB_TOPGEN], 1u);
            else XB_SPIN(xb_ld(&bar[XB_TOPGEN]) == tg, bar);
            __builtin_amdgcn_fence(__ATOMIC_ACQUIRE, "agent");
            xb_add(&bar[XB_XGEN(bx)], 1u);
            asm volatile("s_waitcnt vmcnt(0)" ::: "memory");
        } else {
#if XB_EARLY_WB
            { const unsigned pos = old - gen * nloc;
              if (pos == 0u || (XB_EARLY_WB > 1 && pos == nloc / 2u)) { __builtin_amdgcn_fence(__ATOMIC_RELEASE, "agent"); asm volatile("s_waitcnt vmcnt(0)" ::: "memory"); } }
#endif
            XB_SPIN(xb_ld(&bar[XB_XGEN(bx)]) == gen, bar);
            __builtin_amdgcn_fence(__ATOMIC_ACQUIRE, "agent");
            asm volatile("s_waitcnt vmcnt(0)" ::: "memory");
        }
    }
    __syncthreads();
}
struct Frame {
    LAS unsigned char* lds;
    int bid, wave, G, gw, NGW;
};
#define PHASE_TID() int tid = threadIdx.x; asm volatile("" : "+v"(tid)); const int lane = tid & 63; (void)lane
struct LayerW { const bf16 *wgu1, *wd1, *win, *wout, *wgu2, *wd2, *wglu; };
__device__ __forceinline__ LayerW layer_w(unsigned char* ws, int l) {
    unsigned char* b = ws + WS_W + (size_t)l * SZ_LAYER_W; LayerW w;
    w.wgu1 = (const bf16*)(b + OFF_WGU1); w.wd1 = (const bf16*)(b + OFF_WD1); w.win = (const bf16*)(b + OFF_WIN); w.wout = (const bf16*)(b + OFF_WOUT);
    w.wgu2 = (const bf16*)(b + OFF_WGU2); w.wd2 = (const bf16*)(b + OFF_WD2); w.wglu = (const bf16*)(b + OFF_WGLU); return w;
}
#ifndef CONV_WIDE
#define CONV_WIDE 0
#endif
__device__ __forceinline__ void transpose_item(const float* W, int K, int ldw, int sc0, int ncols, bf16* WT, int dr0, int mode, LAS float* scr, int item, int lane) {
    const int nblk = ncols / 32, kb = item / nblk, nb = item % nblk, k0 = 64 * kb, n0 = 32 * nb;
    const float* src = W + (size_t)k0 * ldw + sc0 + n0 + (lane & 31);
#if CONV_WIDE
    { f32x4 tv[8]; const int rr = lane >> 3, cq = lane & 7;
      const float* srow = W + (size_t)(k0 + rr) * ldw + sc0 + n0 + 4 * cq;
#pragma unroll
      for (int i = 0; i < 8; ++i) tv[i] = *(const GAS f32x4*)(srow + (size_t)(8 * i) * ldw);
#pragma unroll
      for (int i = 0; i < 8; ++i) { LAS float* d = scr + (8 * i + rr) * 33 + 4 * cq; d[0] = tv[i].x; d[1] = tv[i].y; d[2] = tv[i].z; d[3] = tv[i].w; } }
#else
#pragma unroll 1
    for (int hf = 0; hf < 2; ++hf) { float tv[16];
#pragma unroll
        for (int i = 0; i < 16; ++i) tv[i] = src[(size_t)(32 * hf + 2 * i + (lane >> 5)) * ldw];
#pragma unroll
        for (int i = 0; i < 16; ++i) scr[(32 * hf + 2 * i + (lane >> 5)) * 33 + (lane & 31)] = tv[i]; }
#endif
    LDS_WAIT(); asm volatile("" ::: "memory");
    const int c = lane & 7;
    const int drow0 = (mode == 0) ? (dr0 + n0) : (256 * (n0 >> 7) + dr0 + (n0 & 127));
#pragma unroll
    for (int j = 0; j < 4; ++j) { const int n = (lane >> 3) + 8 * j; const LAS float* s = scr + (8 * c) * 33 + n;
        v4u o; o.x = pk2(s[0 * 33], s[1 * 33]); o.y = pk2(s[2 * 33], s[3 * 33]); o.z = pk2(s[4 * 33], s[5 * 33]); o.w = pk2(s[6 * 33], s[7 * 33]);
        *(GAS v4u*)(WT + (size_t)(drow0 + n) * K + k0 + 8 * c) = o; }
    LDS_WAIT(); asm volatile("" ::: "memory");
}
__device__ __forceinline__ void convert_matrix(Frame& F, const float* W, int K, int ldw, int sc0, int ncols, bf16* WT, int dr0, int mode, int rot) {
    PHASE_TID();
    LAS float* scr = (LAS float*)(F.lds + RING_OFF + F.wave * 16384);
    const int nitems = (K / 64) * (ncols / 32);
    int g = F.gw + rot; if (g >= F.NGW) g -= F.NGW;
    for (int it = g; it < nitems; it += F.NGW) transpose_item(W, K, ldw, sc0, ncols, WT, dr0, mode, scr, it, lane);
}
__device__ __forceinline__ void sincos_rev(double t, float& s, float& c) {
    const double t4 = t * 4.0; const double kd = __builtin_rint(t4); const int k = (int)kd & 3;
    const float y = (float)((t4 - kd) * 1.5707963267948966);
    const float z = y * y;
    const float sp = ((-1.9515295891e-4f * z + 8.3321608736e-3f) * z - 1.6666654611e-1f) * z * y + y;
    float one = 1.0f; asm volatile("" : "+v"(one));
    const float cp = ((2.443315711809948e-5f * z - 1.388731625493765e-3f) * z + 4.166664568298827e-2f) * z * z - 0.5f * z + one;
    s = (k == 0) ? sp : (k == 1) ? cp : (k == 2) ? -sp : -cp;
    c = (k == 0) ? cp : (k == 1) ? -sp : (k == 2) ? -cp : sp;
}
__device__ __forceinline__ void rms_row_to_bf16(int lane, const float* xrow, const float* gain, bf16* orow) {
    const GAS f32x4* xr = (const GAS f32x4*)xrow + lane; const GAS f32x4* gr = (const GAS f32x4*)gain + lane;
    f32x4 v[8]; float s = 0.f;
#pragma unroll
    for (int j = 0; j < 8; ++j) { v[j] = xr[64 * j]; s += (v[j].x * v[j].x + v[j].y * v[j].y) + (v[j].z * v[j].z + v[j].w * v[j].w); }
    const float rstd = 1.0f / sqrtf(wave_sum(s) * (1.f / D) + NORM_EPS);
    GAS v2u* o8 = (GAS v2u*)orow + lane;
#pragma unroll
    for (int j = 0; j < 8; ++j) { const f32x4 g = gr[64 * j]; v2u o; o.x = pk2(v[j].x * rstd * g.x, v[j].y * rstd * g.y); o.y = pk2(v[j].z * rstd * g.z, v[j].w * rstd * g.w); o8[64 * j] = o; }
}
template <bool HOUT, bool AB>
__device__ __forceinline__ void norm_phase(Frame& F, const void* yv_, const float* xsrc, float* xdst, const float* gpost, float rw, const float* gnext, bf16* h, const float* win_l, float* ab) {
    PHASE_TID();
    LAS float* w8 = (LAS float*)(F.lds + RING_OFF);
    if constexpr (AB) {
        for (int i = tid; i < D * 8; i += NWAVES * 64) { const int k = i >> 3, c = i & 7; w8[i] = win_l[(size_t)k * INW + SRC_AB + c]; }
        __syncthreads();
    }
    for (int m = F.gw; m < M; m += F.NGW) {
        asm volatile("" ::: "memory");
#if Y_BF16
        const GAS v2u* yr = (const GAS v2u*)((const bf16*)yv_ + (size_t)m * D) + lane; const GAS f32x4* xr = (const GAS f32x4*)(xsrc + (size_t)m * D) + lane;
        const GAS f32x4* gp = (const GAS f32x4*)gpost + lane;
        f32x4 v[8]; float s = 0.f;
#pragma unroll
        for (int j = 0; j < 8; ++j) { const v2u yw = yr[64 * j]; v[j] = (f32x4){bflo(yw.x), bfhi(yw.x), bflo(yw.y), bfhi(yw.y)}; s += (v[j].x * v[j].x + v[j].y * v[j].y) + (v[j].z * v[j].z + v[j].w * v[j].w); }
#else
        const GAS f32x4* yr = (const GAS f32x4*)((const float*)yv_ + (size_t)m * D) + lane; const GAS f32x4* xr = (const GAS f32x4*)(xsrc + (size_t)m * D) + lane;
        const GAS f32x4* gp = (const GAS f32x4*)gpost + lane;
        f32x4 v[8]; float s = 0.f;
#pragma unroll
        for (int j = 0; j < 8; ++j) { v[j] = yr[64 * j]; s += (v[j].x * v[j].x + v[j].y * v[j].y) + (v[j].z * v[j].z + v[j].w * v[j].w); }
#endif
        const float rstd = rw / sqrtf(wave_sum(s) * (1.f / D) + NORM_EPS);
        float s2 = 0.f;
        GAS f32x4* xo = (GAS f32x4*)(xdst + (size_t)m * D) + lane;
#pragma unroll
        for (int j = 0; j < 8; ++j) { const f32x4 g = gp[64 * j]; const f32x4 xv = xr[64 * j]; f32x4 o;
            o.x = xv.x + v[j].x * rstd * g.x; o.y = xv.y + v[j].y * rstd * g.y; o.z = xv.z + v[j].z * rstd * g.z; o.w = xv.w + v[j].w * rstd * g.w;
            xo[64 * j] = o; v[j] = o; s2 += (o.x * o.x + o.y * o.y) + (o.z * o.z + o.w * o.w); }
        if constexpr (HOUT) {
            const float r2 = 1.0f / sqrtf(wave_sum(s2) * (1.f / D) + NORM_EPS);
            const GAS f32x4* gn = (const GAS f32x4*)gnext + lane;
            GAS v2u* o8 = (GAS v2u*)(h + (size_t)m * D) + lane;
            float dot[8];
#pragma unroll
            for (int c = 0; c < 8; ++c) dot[c] = 0.f;
#pragma unroll
            for (int j = 0; j < 8; ++j) { const f32x4 g = gn[64 * j]; f32x4 hv; hv.x = v[j].x * r2 * g.x; hv.y = v[j].y * r2 * g.y; hv.z = v[j].z * r2 * g.z; hv.w = v[j].w * r2 * g.w;
                v2u o; o.x = pk2(hv.x, hv.y); o.y = pk2(hv.z, hv.w); o8[64 * j] = o;
                if constexpr (AB) {
                    const LAS f32x4* wp = (const LAS f32x4*)(w8 + (size_t)(j * 256 + lane * 4) * 8);
#pragma unroll
                    for (int e = 0; e < 4; ++e) { const f32x4 wa = wp[2 * e], wb = wp[2 * e + 1]; const float hh = hv[e];
                        dot[0] += hh * wa.x; dot[1] += hh * wa.y; dot[2] += hh * wa.z; dot[3] += hh * wa.w; dot[4] += hh * wb.x; dot[5] += hh * wb.y; dot[6] += hh * wb.z; dot[7] += hh * wb.w; }
                } }
            if constexpr (AB) {
#pragma unroll
                for (int c = 0; c < 8; ++c) dot[c] = wave_sum(dot[c]);
                if (lane == 0) { GAS f32x4* ao = (GAS f32x4*)(ab + (size_t)m * 8); ao[0] = (f32x4){dot[0], dot[1], dot[2], dot[3]}; ao[1] = (f32x4){dot[4], dot[5], dot[6], dot[7]}; }
            }
        }
    }
    if constexpr (AB) __syncthreads();
}

template <bool HOUT, bool AB>
__device__ __forceinline__ void norm_phase2(Frame& F, const void* yv_, const float* xsrc, float* xdst, const float* gpost, float rw, const float* gnext, bf16* h, const float* win_l, float* ab) {
    PHASE_TID();
    LAS float* w8 = (LAS float*)(F.lds + RING_OFF);
    if constexpr (AB) {
        for (int i = tid; i < D * 8; i += NWAVES * 64) { const int k = i >> 3, c = i & 7; w8[i] = win_l[(size_t)k * INW + SRC_AB + c]; }
        __syncthreads();
    }
    for (int m0 = F.gw; m0 < M; m0 += 2 * F.NGW) {
        asm volatile("" ::: "memory");
        asm volatile("" : "+s"(yv_), "+s"(xsrc), "+s"(xdst), "+s"(gpost), "+s"(gnext), "+s"(h));
        const bool two = m0 + F.NGW < M; const int m1 = two ? m0 + F.NGW : m0;
        v2u yw[2][8]; f32x4 xv[2][8];
#pragma unroll
        for (int r = 0; r < 2; ++r) { const int m = r ? m1 : m0;
            const GAS v2u* yr = (const GAS v2u*)((const bf16*)yv_ + (size_t)m * D) + lane; const GAS f32x4* xr = (const GAS f32x4*)(xsrc + (size_t)m * D) + lane;
#pragma unroll
            for (int j = 0; j < 8; ++j) { yw[r][j] = yr[64 * j]; xv[r][j] = xr[64 * j]; } }
        const GAS f32x4* gp = (const GAS f32x4*)gpost + lane;
        float rstd[2], s2[2];
#pragma unroll
        for (int r = 0; r < 2; ++r) { float s = 0.f;
#pragma unroll
            for (int j = 0; j < 8; ++j) { const v2u w = yw[r][j]; const float a = bflo(w.x), b = bfhi(w.x), c = bflo(w.y), d = bfhi(w.y); s += (a * a + b * b) + (c * c + d * d); }
            rstd[r] = rw / sqrtf(wave_sum(s) * (1.f / D) + NORM_EPS); s2[r] = 0.f; }
#pragma unroll
        for (int j = 0; j < 8; ++j) { const f32x4 g = gp[64 * j];
#pragma unroll
            for (int r = 0; r < 2; ++r) { const v2u w = yw[r][j]; const f32x4 x = xv[r][j]; f32x4 o;
                o.x = x.x + bflo(w.x) * rstd[r] * g.x; o.y = x.y + bfhi(w.x) * rstd[r] * g.y; o.z = x.z + bflo(w.y) * rstd[r] * g.z; o.w = x.w + bfhi(w.y) * rstd[r] * g.w;
                xv[r][j] = o; s2[r] += (o.x * o.x + o.y * o.y) + (o.z * o.z + o.w * o.w);
                if (r == 0 || two) ((GAS f32x4*)(xdst + (size_t)(r ? m1 : m0) * D) + lane)[64 * j] = o; } }
        if constexpr (HOUT) {
            float r2[2];
#pragma unroll
            for (int r = 0; r < 2; ++r) r2[r] = 1.0f / sqrtf(wave_sum(s2[r]) * (1.f / D) + NORM_EPS);
#pragma unroll
            for (int r = 0; r < 2; ++r) {
                if constexpr (AB) asm volatile("" : "+s"(gnext), "+s"(h), "+s"(ab) :: "memory");
                const GAS f32x4* gn = (const GAS f32x4*)gnext + lane;
                float dot[8];
#pragma unroll
                for (int c = 0; c < 8; ++c) dot[c] = 0.f;
#pragma unroll
                for (int j = 0; j < 8; ++j) { const f32x4 g = gn[64 * j]; f32x4 hv; hv.x = xv[r][j].x * r2[r] * g.x; hv.y = xv[r][j].y * r2[r] * g.y; hv.z = xv[r][j].z * r2[r] * g.z; hv.w = xv[r][j].w * r2[r] * g.w;
                    v2u o; o.x = pk2(hv.x, hv.y); o.y = pk2(hv.z, hv.w);
                    if (r == 0 || two) ((GAS v2u*)(h + (size_t)(r ? m1 : m0) * D) + lane)[64 * j] = o;
                    if constexpr (AB) {
                        asm volatile("" ::: "memory");
                        const LAS f32x4* wp = (const LAS f32x4*)(w8 + (size_t)(j * 256 + lane * 4) * 8);
#pragma unroll
                        for (int e = 0; e < 4; ++e) { const f32x4 wa = wp[2 * e], wb = wp[2 * e + 1]; const float hh = hv[e];
                            dot[0] += hh * wa.x; dot[1] += hh * wa.y; dot[2] += hh * wa.z; dot[3] += hh * wa.w; dot[4] += hh * wb.x; dot[5] += hh * wb.y; dot[6] += hh * wb.z; dot[7] += hh * wb.w; }
                    } }
                if constexpr (AB) {
#pragma unroll
                    for (int c = 0; c < 8; ++c) dot[c] = wave_sum(dot[c]);
                    if (lane == 0 && (r == 0 || two)) { GAS f32x4* ao = (GAS f32x4*)(ab + (size_t)(r ? m1 : m0) * 8); ao[0] = (f32x4){dot[0], dot[1], dot[2], dot[3]}; ao[1] = (f32x4){dot[4], dot[5], dot[6], dot[7]}; }
                }
            }
        }
    }
    if constexpr (AB) __syncthreads();
}

__device__ __forceinline__ void ab_rows_phase(Frame& F, const float* x, const float* g, const float* win_l, float* ab) {
    PHASE_TID();
    LAS float* w8 = (LAS float*)(F.lds + RING_OFF);
    __syncthreads();
    for (int i = tid; i < D * 8; i += NWAVES * 64) { const int k = i >> 3, c = i & 7; w8[i] = win_l[(size_t)k * INW + SRC_AB + c]; }
    __syncthreads();
    for (int m = F.gw; m < M; m += F.NGW) {
        asm volatile("" ::: "memory");
        const GAS f32x4* xr = (const GAS f32x4*)(x + (size_t)m * D) + lane; const GAS f32x4* gn = (const GAS f32x4*)g + lane;
        f32x4 v[8]; float s = 0.f;
#pragma unroll
        for (int j = 0; j < 8; ++j) { v[j] = xr[64 * j]; s += (v[j].x * v[j].x + v[j].y * v[j].y) + (v[j].z * v[j].z + v[j].w * v[j].w); }
        const float r2 = 1.0f / sqrtf(wave_sum(s) * (1.f / D) + NORM_EPS);
        float dot[8];
#pragma unroll
        for (int c = 0; c < 8; ++c) dot[c] = 0.f;
#pragma unroll
        for (int j = 0; j < 8; ++j) { const f32x4 gg = gn[64 * j]; const f32x4 hv = (v[j] * gg) * r2;
            const LAS f32x4* wp = (const LAS f32x4*)(w8 + (size_t)(j * 256 + lane * 4) * 8);
#pragma unroll
            for (int e = 0; e < 4; ++e) { const f32x4 wa = wp[2 * e], wb = wp[2 * e + 1]; const float hh = hv[e];
                dot[0] += hh * wa.x; dot[1] += hh * wa.y; dot[2] += hh * wa.z; dot[3] += hh * wa.w; dot[4] += hh * wb.x; dot[5] += hh * wb.y; dot[6] += hh * wb.z; dot[7] += hh * wb.w; } }
#pragma unroll
        for (int c = 0; c < 8; ++c) dot[c] = wave_sum(dot[c]);
        if (lane == 0) { GAS f32x4* ao = (GAS f32x4*)(ab + (size_t)m * 8); ao[0] = (f32x4){dot[0], dot[1], dot[2], dot[3]}; ao[1] = (f32x4){dot[4], dot[5], dot[6], dot[7]}; }
    }
    __syncthreads();
}
struct MixP {
    const float *sinks, *convw, *a_log, *dt_bias, *dn_norm_w, *s5_a_re, *s5_a_im, *s5_log_dt, *s5_b_re, *s5_b_im, *s5_c_re, *s5_c_im, *s5_d;
    const float *rope_cos, *rope_sin;
    const bf16* z; const float* ab; float* bg; float* kr; float *qn, *kn, *vc; float* oraw; float* ys; bf16* ysb; bf16* mixed;
};
__device__ __forceinline__ void prep_phase(Frame& F, const MixP& P) {
    PHASE_TID();
    for (int t = F.gw; t < M; t += F.NGW) {
        const int pos = t & (SEQ - 1);
        const bf16* zr = P.z + (size_t)t * ZW;
        const float c = P.rope_cos[pos * 64 + lane], s = P.rope_sin[pos * 64 + lane];
#pragma unroll
        for (int hh = 0; hh < 2; ++hh) { const float x1 = bf2f(zr[Z_AK + hh * 128 + lane]), x2 = bf2f(zr[Z_AK + hh * 128 + 64 + lane]);
            P.kr[(size_t)t * 256 + hh * 128 + lane] = x1 * c - x2 * s; P.kr[(size_t)t * 256 + hh * 128 + 64 + lane] = x2 * c + x1 * s; }
#pragma unroll 1
        for (int hc = 0; hc < 12; ++hc) {
            float v0 = 0.f, v1 = 0.f; const int ch = hc * 128 + lane;
#pragma unroll
            for (int k = 0; k < 4; ++k) { const int tp = pos - 3 + k; if (tp >= 0) { const bf16* zq = P.z + (size_t)(t - 3 + k) * ZW + Z_DQKV + ch; const float* cw = P.convw + k * 1536 + ch;
                v0 += cw[0] * bf2f(zq[0]); v1 += cw[64] * bf2f(zq[64]); } }
            v0 = v0 * sigmoid_f(v0); v1 = v1 * sigmoid_f(v1);
            if (hc < 8) { const float r = 1.0f / sqrtf(wave_sum(v0 * v0 + v1 * v1) + NORM_EPS); v0 *= r; v1 *= r; }
            float* dst = P.qn + (size_t)(hc >> 2) * ((size_t)M * 512) + (size_t)t * 512 + (hc & 3) * 128 + lane;
            dst[0] = v0; dst[64] = v1;
        }
        if (lane < 4) { const float br = P.ab[(size_t)t * 8 + lane], ar = P.ab[(size_t)t * 8 + 4 + lane] + P.dt_bias[lane];
            const float sp = fmaxf(ar, 0.f) + log1pf(__expf(-fabsf(ar)));
            P.bg[(size_t)t * 8 + lane] = sigmoid_f(br); P.bg[(size_t)t * 8 + 4 + lane] = -__expf(P.a_log[lane]) * sp; }
    }
}
__device__ __forceinline__ void slow_deltanet(Frame& F, const MixP& P, int bh) {
    PHASE_TID();
    const int b = bh >> 2, h = bh & 3, v = tid & 127, rg = tid >> 7;
    LAS float* qs = (LAS float*)(F.lds + RING_OFF); LAS float* ks = qs + 64 * 128; LAS float* vs = ks + 64 * 128; LAS float* bgs = vs + 64 * 128;
    LAS float* part = bgs + 128; LAS float* part2 = part + 512;
    float S[32];
#pragma unroll
    for (int i = 0; i < 32; ++i) S[i] = 0.f;
    for (int cch = 0; cch < SEQ / 64; ++cch) {
        const int t0 = b * SEQ + cch * 64;
        __syncthreads();
        for (int i = tid; i < 64 * 128; i += 512) { const int r = i >> 7, cc = i & 127; const size_t g = (size_t)(t0 + r) * 512 + h * 128 + cc; qs[i] = P.qn[g]; ks[i] = P.kn[g]; vs[i] = P.vc[g]; }
        if (tid < 64) { bgs[tid * 2] = P.bg[(size_t)(t0 + tid) * 8 + h]; bgs[tid * 2 + 1] = P.bg[(size_t)(t0 + tid) * 8 + 4 + h]; }
        __syncthreads();
        for (int i = 0; i < 64; ++i) {
            const LAS float* kp = ks + i * 128 + rg * 32; const LAS float* qp = qs + i * 128 + rg * 32;
            float r = 0.f;
#pragma unroll
            for (int kk = 0; kk < 32; ++kk) r += kp[kk] * S[kk];
            part[rg * 128 + v] = r;
            __syncthreads();
            const float rt = (part[v] + part[128 + v]) + (part[256 + v] + part[384 + v]);
            const float beta = bgs[2 * i], eg = __expf(bgs[2 * i + 1]);
            const float vn = beta * (vs[i * 128 + v] - eg * rt);
            float o = 0.f;
#pragma unroll
            for (int kk = 0; kk < 32; ++kk) { S[kk] = eg * S[kk] + kp[kk] * vn; o += qp[kk] * S[kk]; }
            part2[rg * 128 + v] = o;
            __syncthreads();
            if (rg == 0) P.oraw[(size_t)(t0 + i) * 512 + h * 128 + v] = ((part2[v] + part2[128 + v]) + (part2[256 + v] + part2[384 + v])) * 0.08838834764831845f;
        }
    }
}
__device__ __forceinline__ void slow_s5(Frame& F, const MixP& P, int task) {
    PHASE_TID();
    const int b = task >> 5, g = task & 31, p = lane;
    const double dt = (double)expf(P.s5_log_dt[g]);
    const double are = (double)P.s5_a_re[g * 64 + p], aim = (double)P.s5_a_im[g * 64 + p];
    double trev = aim * dt * 0.15915494309189535; trev -= __builtin_rint(trev);
    float sn, cs; sincos_rev(trev, sn, cs);
    const float er = __expf((float)(are * dt));
    const float ar = er * cs, ai = er * sn;
    const float lr = (float)are, li = (float)aim, den = lr * lr + li * li;
    const float nr = ar - 1.0f, ni = ai;
    const float cfr = (nr * lr + ni * li) / den, cfi = (ni * lr - nr * li) / den;
    float bbr[16], bbi[16], ccr[16], cci[16], dd[16];
#pragma unroll
    for (int hh = 0; hh < 16; ++hh) { const float br = P.s5_b_re[(g * 64 + p) * 16 + hh], bi = P.s5_b_im[(g * 64 + p) * 16 + hh];
        bbr[hh] = cfr * br - cfi * bi; bbi[hh] = cfr * bi + cfi * br;
        ccr[hh] = P.s5_c_re[(g * 16 + hh) * 64 + p]; cci[hh] = P.s5_c_im[(g * 16 + hh) * 64 + p]; dd[hh] = P.s5_d[g * 16 + hh]; }
    float xr = 0.f, xi = 0.f;
    for (int t = 0; t < SEQ; ++t) {
        const size_t tok = (size_t)b * SEQ + t;
        const v4u u0 = *(const GAS v4u*)(P.z + tok * ZW + Z_S5 + g * 16), u1 = *(const GAS v4u*)(P.z + tok * ZW + Z_S5 + g * 16 + 8);
        float u[16]; u[0] = bflo(u0.x); u[1] = bfhi(u0.x); u[2] = bflo(u0.y); u[3] = bfhi(u0.y); u[4] = bflo(u0.z); u[5] = bfhi(u0.z); u[6] = bflo(u0.w); u[7] = bfhi(u0.w);
        u[8] = bflo(u1.x); u[9] = bfhi(u1.x); u[10] = bflo(u1.y); u[11] = bfhi(u1.y); u[12] = bflo(u1.z); u[13] = bfhi(u1.z); u[14] = bflo(u1.w); u[15] = bfhi(u1.w);
        float br = 0.f, bi = 0.f;
#pragma unroll
        for (int hh = 0; hh < 16; ++hh) { br += bbr[hh] * u[hh]; bi += bbi[hh] * u[hh]; }
        const float nxr = ar * xr - ai * xi + br, nxi = ar * xi + ai * xr + bi; xr = nxr; xi = nxi;
        float yo = 0.f;
#pragma unroll
        for (int hh = 0; hh < 16; ++hh) { const float yy = wave_sum(ccr[hh] * xr - cci[hh] * xi) + dd[hh] * u[hh]; yo = (p == hh) ? yy : yo; }
        if (p < 16) { const float ge = gelu_tanh(yo); P.ys[tok * 512 + g * 16 + p] = ge; P.ysb[tok * 512 + g * 16 + p] = (bf16)f2bf(ge); }
    }
}
__device__ __forceinline__ void slow_attention(Frame& F, const MixP& P, int aw, int naw) {
    PHASE_TID();
    LAS float* qs = (LAS float*)(F.lds + RING_OFF + F.wave * 1024);
    for (int task = aw; task < M * 8; task += naw) {
        const int t = task >> 3, head = task & 7, pos = t & (SEQ - 1), kvh = head >> 2;
        const bf16* zr = P.z + (size_t)t * ZW;
        { const float x1 = bf2f(zr[Z_AQ + head * 128 + lane]), x2 = bf2f(zr[Z_AQ + head * 128 + 64 + lane]);
          const float c = P.rope_cos[pos * 64 + lane], s = P.rope_sin[pos * 64 + lane];
          LDS_WAIT(); asm volatile("" ::: "memory");
          qs[lane] = (x1 * c - x2 * s) * 0.08838834764831845f; qs[lane + 64] = (x2 * c + x1 * s) * 0.08838834764831845f;
          LDS_WAIT(); asm volatile("" ::: "memory"); }
        float sc[2];
#pragma unroll
        for (int kk = 0; kk < 2; ++kk) { const int off = lane + 64 * kk; float a = -INFINITY;
            if (pos - off >= 0) { const GAS f32x4* kp = (const GAS f32x4*)(P.kr + (size_t)(t - off) * 256 + kvh * 128); const LAS f32x4* qp = (const LAS f32x4*)qs; float d = 0.f;
#pragma unroll 8
                for (int i = 0; i < 32; ++i) { const f32x4 kv = kp[i], qv = qp[i]; d += (kv.x * qv.x + kv.y * qv.y) + (kv.z * qv.z + kv.w * qv.w); }
                a = d; }
            sc[kk] = a; }
        const float sink = P.sinks[head];
        const float mx = fmaxf(wave_max(fmaxf(sc[0], sc[1])), sink);
        const float p0 = __expf(sc[0] - mx), p1 = __expf(sc[1] - mx);
        const float denom = wave_sum(p0 + p1) + __expf(sink - mx);
        float o0 = 0.f, o1 = 0.f;
        const int nk = (pos + 1 < 128) ? pos + 1 : 128;
        for (int jj = 0; jj < nk; ++jj) { const float pj = (jj < 64) ? __shfl(p0, jj) : __shfl(p1, jj - 64);
            const unsigned w = *(const GAS unsigned*)(P.z + (size_t)(t - jj) * ZW + Z_AV + kvh * 128 + 2 * lane);
            o0 += pj * bflo(w); o1 += pj * bfhi(w); }
        const float inv = 1.0f / denom;
        *(GAS unsigned*)(P.mixed + (size_t)t * MIXW + head * 128 + 2 * lane) = pk2(o0 * inv, o1 * inv);
    }
}
__device__ __forceinline__ void dn_post_rows(Frame& F, const MixP& P) {
    PHASE_TID();
    for (int t = F.gw; t < M; t += F.NGW) {
#pragma unroll
        for (int h = 0; h < 4; ++h) { const float a = P.oraw[(size_t)t * 512 + h * 128 + lane], b2 = P.oraw[(size_t)t * 512 + h * 128 + 64 + lane];
            const float r = 1.0f / sqrtf(wave_sum(a * a + b2 * b2) * (1.f / 128.f) + NORM_EPS);
            const float z0 = bf2f(P.z[(size_t)t * ZW + Z_DZ + h * 128 + lane]), z1 = bf2f(P.z[(size_t)t * ZW + Z_DZ + h * 128 + 64 + lane]);
            P.mixed[(size_t)t * MIXW + 1024 + h * 128 + lane] = (bf16)f2bf(a * r * P.dn_norm_w[lane] * z0 * sigmoid_f(z0));
            P.mixed[(size_t)t * MIXW + 1024 + h * 128 + 64 + lane] = (bf16)f2bf(b2 * r * P.dn_norm_w[64 + lane] * z1 * sigmoid_f(z1)); }
    }
}
constexpr int AT_KS = 136, AT_VS = 264;
constexpr int AT_K_OFF = 0, AT_V_OFF = 256 * AT_KS * 2;
static_assert(AT_V_OFF + 128 * AT_VS * 2 <= MISC_OFF, "attention LDS");
constexpr int ATT_UNITS = 256;
__device__ __forceinline__ void rope8(const v4u a, const v4u b, const float* cp, const float* sp, float scale, v4u& o1, v4u& o2) {
    const f32x4 c0 = *(const GAS f32x4*)cp, c1 = *(const GAS f32x4*)(cp + 4), s0 = *(const GAS f32x4*)sp, s1 = *(const GAS f32x4*)(sp + 4);
    const float c[8] = {c0.x, c0.y, c0.z, c0.w, c1.x, c1.y, c1.z, c1.w}, s[8] = {s0.x, s0.y, s0.z, s0.w, s1.x, s1.y, s1.z, s1.w};
    const unsigned aw[4] = {a.x, a.y, a.z, a.w}, bw[4] = {b.x, b.y, b.z, b.w}; unsigned r1[4], r2[4];
#pragma unroll
    for (int i = 0; i < 4; ++i) { const float x1l = bflo(aw[i]), x1h = bfhi(aw[i]), x2l = bflo(bw[i]), x2h = bfhi(bw[i]);
        r1[i] = pk2((x1l * c[2 * i] - x2l * s[2 * i]) * scale, (x1h * c[2 * i + 1] - x2h * s[2 * i + 1]) * scale);
        r2[i] = pk2((x2l * c[2 * i] + x1l * s[2 * i]) * scale, (x2h * c[2 * i + 1] + x1h * s[2 * i + 1]) * scale); }
    o1 = (v4u){r1[0], r1[1], r1[2], r1[3]}; o2 = (v4u){r2[0], r2[1], r2[2], r2[3]};
}
__device__ __forceinline__ void attn_unit(Frame& F, const MixP& P, int unit) {
    PHASE_TID();
    const int half = unit & 1, kvh = (unit >> 1) & 1, blk = (unit >> 2) & 31, b = unit >> 7;
    LAS bf16* Kl = (LAS bf16*)(F.lds + AT_K_OFF); LAS bf16* Vt = (LAS bf16*)(F.lds + AT_V_OFF);
    const int tok0 = b * SEQ + (blk - 1) * 128;
    for (int it = tid; it < 2048; it += NWAVES * 64) {
        const int key = it >> 3, dg = it & 7; v4u o1 = (v4u){0u, 0u, 0u, 0u}, o2 = o1;
        if (blk > 0 || key >= 128) { const int pos = (blk - 1) * 128 + key; const bf16* zr = P.z + (size_t)(tok0 + key) * ZW + Z_AK + kvh * 128 + 8 * dg;
            rope8(*(const GAS v4u*)zr, *(const GAS v4u*)(zr + 64), P.rope_cos + pos * 64 + 8 * dg, P.rope_sin + pos * 64 + 8 * dg, 1.0f, o1, o2); }
        *(LAS v4u*)(Kl + key * AT_KS + 8 * dg) = o1; *(LAS v4u*)(Kl + key * AT_KS + 64 + 8 * dg) = o2;
    }
    for (int it = tid; it < 4096; it += NWAVES * 64) {
        const int key = it >> 4, dg = it & 15; v4u a = (v4u){0u, 0u, 0u, 0u};
        if (blk > 0 || key >= 128) a = *(const GAS v4u*)(P.z + (size_t)(tok0 + key) * ZW + Z_AV + kvh * 128 + 8 * dg);
        LAS bf16* vp = Vt + (8 * dg) * AT_VS + key;
        vp[0 * AT_VS] = (bf16)(a.x & 0xffffu); vp[1 * AT_VS] = (bf16)(a.x >> 16); vp[2 * AT_VS] = (bf16)(a.y & 0xffffu); vp[3 * AT_VS] = (bf16)(a.y >> 16);
        vp[4 * AT_VS] = (bf16)(a.z & 0xffffu); vp[5 * AT_VS] = (bf16)(a.z >> 16); vp[6 * AT_VS] = (bf16)(a.w & 0xffffu); vp[7 * AT_VS] = (bf16)(a.w >> 16);
    }
    __syncthreads();
    const int w = F.wave, n = lane & 15, q4 = lane >> 4, r0 = 16 * w, T0 = w & ~1;
    const int posq = blk * 128 + r0 + n; const size_t tq = (size_t)b * SEQ + posq;
#pragma unroll 1
    for (int hh = 0; hh < 2; ++hh) {
        asm volatile("" ::: "memory");
        const int head = kvh * 4 + half * 2 + hh;
        bf16x8 qf[4];
        { const bf16* zq = P.z + tq * ZW + Z_AQ + head * 128 + 8 * q4;
          const v4u x0 = *(const GAS v4u*)zq, x1 = *(const GAS v4u*)(zq + 32), x2 = *(const GAS v4u*)(zq + 64), x3 = *(const GAS v4u*)(zq + 96);
          v4u o0, o1, o2, o3;
          rope8(x0, x2, P.rope_cos + posq * 64 + 8 * q4, P.rope_sin + posq * 64 + 8 * q4, 0.08838834764831845f, o0, o2);
          rope8(x1, x3, P.rope_cos + posq * 64 + 32 + 8 * q4, P.rope_sin + posq * 64 + 32 + 8 * q4, 0.08838834764831845f, o1, o3);
          qf[0] = __builtin_bit_cast(bf16x8, o0); qf[1] = __builtin_bit_cast(bf16x8, o1); qf[2] = __builtin_bit_cast(bf16x8, o2); qf[3] = __builtin_bit_cast(bf16x8, o3); }
        f32x4 sacc[10];
#pragma unroll
        for (int kt = 0; kt < 10; ++kt) { sacc[kt] = (f32x4){0.f, 0.f, 0.f, 0.f};
#pragma unroll
            for (int ks = 0; ks < 4; ++ks) { const bf16x8 kf = *(const LAS bf16x8*)(Kl + (16 * (T0 + kt) + n) * AT_KS + 32 * ks + 8 * q4);
                sacc[kt] = __builtin_amdgcn_mfma_f32_16x16x32_bf16(kf, qf[ks], sacc[kt], 0, 0, 0); } }
        const float sink = P.sinks[head];
        float mx = -INFINITY;
#pragma unroll
        for (int kt = 0; kt < 10; ++kt)
#pragma unroll
            for (int r = 0; r < 4; ++r) { const int kw = 16 * (T0 + kt) + 4 * q4 + r, rel = 128 + r0 + n - kw; const bool vis = (rel >= 0) && (rel < 128) && (blk > 0 || kw >= 128);
                const float sv = vis ? sacc[kt][r] : -INFINITY; sacc[kt][r] = sv; mx = fmaxf(mx, sv); }
        mx = fmaxf(mx, __shfl_xor(mx, 16)); mx = fmaxf(mx, __shfl_xor(mx, 32)); mx = fmaxf(mx, sink);
        float sum = 0.f;
#pragma unroll
        for (int kt = 0; kt < 10; ++kt)
#pragma unroll
            for (int r = 0; r < 4; ++r) { const float p = __expf(sacc[kt][r] - mx); sacc[kt][r] = p; sum += p; }
        sum += __shfl_xor(sum, 16); sum += __shfl_xor(sum, 32); sum += __expf(sink - mx);
        f32x4 oacc[8];
#pragma unroll
        for (int dt = 0; dt < 8; ++dt) oacc[dt] = (f32x4){0.f, 0.f, 0.f, 0.f};
#pragma unroll
        for (int kp = 0; kp < 5; ++kp) {
            v4u pw; pw.x = pk2(sacc[2 * kp][0], sacc[2 * kp][1]); pw.y = pk2(sacc[2 * kp][2], sacc[2 * kp][3]); pw.z = pk2(sacc[2 * kp + 1][0], sacc[2 * kp + 1][1]); pw.w = pk2(sacc[2 * kp + 1][2], sacc[2 * kp + 1][3]);
            const bf16x8 pf = __builtin_bit_cast(bf16x8, pw);
#pragma unroll
            for (int dt = 0; dt < 8; ++dt) { const LAS bf16* vp = Vt + (16 * dt + n) * AT_VS + 16 * (T0 + 2 * kp) + 4 * q4;
                const v2u lo = *(const LAS v2u*)vp, hi = *(const LAS v2u*)(vp + 16);
                const bf16x8 vf = __builtin_bit_cast(bf16x8, (v4u){lo.x, lo.y, hi.x, hi.y});
                oacc[dt] = __builtin_amdgcn_mfma_f32_16x16x32_bf16(vf, pf, oacc[dt], 0, 0, 0); } }
        const float inv = 1.0f / sum;
        bf16* op = P.mixed + tq * MIXW + head * 128 + 4 * q4;
#pragma unroll
        for (int dt = 0; dt < 8; ++dt) { v2u o; o.x = pk2(oacc[dt][0] * inv, oacc[dt][1] * inv); o.y = pk2(oacc[dt][2] * inv, oacc[dt][3] * inv); *(GAS v2u*)(op + 16 * dt) = o; }
    }
    __syncthreads();
}
constexpr size_t S5T_K = 0, S5T_P = 8704, S5T_Q = S5T_P + 65536, S5T_A16 = S5T_Q + 65536, S5T_STRIDE = S5T_A16 + 512;
static_assert(S5T_STRIDE % 256 == 0, "s5 table stride");
__device__ __forceinline__ void s5_tables(Frame& F, const float* a_re, const float* a_im, const float* log_dt, const float* b_re, const float* b_im, const float* c_re, const float* c_im, unsigned char* tb, int g) {
    PHASE_TID();
    LAS float* apow = (LAS float*)(F.lds + RING_OFF);
    LAS float* bbar = apow + 17 * 128;
    LAS float* cc = bbar + 2048;
    __syncthreads();
    const float dtf = expf(log_dt[g]);
    for (int e = tid; e < 17 * 64; e += NWAVES * 64) { const int nn = e >> 6, p = e & 63; const double dt = (double)dtf;
        double trev = (double)a_im[g * 64 + p] * dt * (double)nn * 0.15915494309189535; trev -= __builtin_rint(trev);
        float sn, cs; sincos_rev(trev, sn, cs); const float er = expf((float)((double)a_re[g * 64 + p] * dt * (double)nn));
        apow[e * 2] = er * cs; apow[e * 2 + 1] = er * sn; }
    __syncthreads();
    for (int e = tid; e < 1024; e += NWAVES * 64) { const int p = e >> 4;
        const float lr = a_re[g * 64 + p], li = a_im[g * 64 + p], den = lr * lr + li * li, nr = apow[(64 + p) * 2] - 1.0f, ni = apow[(64 + p) * 2 + 1];
        const float cfr = (nr * lr + ni * li) / den, cfi = (ni * lr - nr * li) / den; const float br = b_re[g * 1024 + e], bi = b_im[g * 1024 + e];
        bbar[e * 2] = cfr * br - cfi * bi; bbar[e * 2 + 1] = cfr * bi + cfi * br;
        cc[e * 2] = c_re[g * 1024 + e]; cc[e * 2 + 1] = c_im[g * 1024 + e]; }
    __syncthreads();
    bf16* Ktab = (bf16*)(tb + S5T_K); bf16* Pt = (bf16*)(tb + S5T_P); bf16* Qt = (bf16*)(tb + S5T_Q); float* A16 = (float*)(tb + S5T_A16);
    for (int e = tid; e < 17 * 256; e += NWAVES * 64) { const int lag1 = e >> 8, ho = (e >> 4) & 15, hi = e & 15; float acc = 0.f;
        if (lag1 > 0) { const LAS float* ap = apow + (lag1 - 1) * 128;
            for (int p = 0; p < 64; ++p) { const float ar = ap[2 * p], ai = ap[2 * p + 1], br = bbar[(p * 16 + hi) * 2], bi = bbar[(p * 16 + hi) * 2 + 1], cr = cc[(ho * 64 + p) * 2], ci = cc[(ho * 64 + p) * 2 + 1];
                const float tr = ar * br - ai * bi, ti = ar * bi + ai * br; acc += cr * tr - ci * ti; } }
        Ktab[e] = (bf16)f2bf(acc); }
    for (int e = tid; e < 128 * 256; e += NWAVES * 64) { const int qp = e >> 8, k = e & 255, s = k >> 4, hi = k & 15, p = qp & 63;
        const float ar = apow[((15 - s) * 64 + p) * 2], ai = apow[((15 - s) * 64 + p) * 2 + 1], br = bbar[(p * 16 + hi) * 2], bi = bbar[(p * 16 + hi) * 2 + 1];
        Pt[e] = (bf16)f2bf((qp < 64) ? (ar * br - ai * bi) : (ar * bi + ai * br)); }
    for (int e = tid; e < 256 * 128; e += NWAVES * 64) { const int row = e >> 7, slot = e & 127, i = row >> 4, ho = row & 15, kp = slot >> 5, q4 = (slot >> 3) & 3, j = slot & 7;
        const int qp = (j < 4) ? (32 * kp + 4 * q4 + j) : (32 * kp + 16 + 4 * q4 + (j - 4)), p = qp & 63;
        const float ar = apow[((i + 1) * 64 + p) * 2], ai = apow[((i + 1) * 64 + p) * 2 + 1], cr = cc[(ho * 64 + p) * 2], ci = cc[(ho * 64 + p) * 2 + 1];
        Qt[e] = (bf16)f2bf((qp < 64) ? (cr * ar - ci * ai) : -(cr * ai + ci * ar)); }
    if (tid < 128) A16[tid] = apow[16 * 128 + tid];
    __syncthreads();
}
constexpr int S5_UNITS = 128;
template <bool PHB>
__device__ __forceinline__ void s5_unit(Frame& F, const MixP& P, const unsigned char* tabs_l, float* E, int unit) {
    PHASE_TID();
    const int span = unit >> 2, goct = unit & 3, b = span >> 4, u = span & 15, n = lane & 15, q4 = lane >> 4; const size_t tok0 = (size_t)b * SEQ + u * 256;
    const int g = goct * 8 + F.wave;
    const unsigned char* tb = tabs_l + (size_t)g * S5T_STRIDE;
    const bf16* Ktab = (const bf16*)(tb + S5T_K); const bf16* Pt = (const bf16*)(tb + S5T_P); const bf16* Qt = (const bf16*)(tb + S5T_Q); const float* A16 = (const float*)(tb + S5T_A16);
    float* Eb = E + ((size_t)(b * 16) * 32 + g) * 128 + 4 * q4;
    float ar[16], ai[16], yre[16], yim[16], Xr[16], Xi[16];
#define S5_LOAD_A16() _Pragma("unroll") for (int T = 0; T < 4; ++T) { const f32x4 v0 = *(const GAS f32x4*)(A16 + (16 * T + 4 * q4) * 2), v1 = *(const GAS f32x4*)(A16 + (16 * T + 4 * q4) * 2 + 4); \
        ar[4 * T] = v0.x; ai[4 * T] = v0.y; ar[4 * T + 1] = v0.z; ai[4 * T + 1] = v0.w; ar[4 * T + 2] = v1.x; ai[4 * T + 2] = v1.y; ar[4 * T + 3] = v1.z; ai[4 * T + 3] = v1.w; }
    bf16x8 ub[8];
#define S5_LOAD_UB() _Pragma("unroll") for (int ks = 0; ks < 8; ++ks) ub[ks] = *(const GAS bf16x8*)(P.z + (tok0 + 16 * n + 2 * ks + (q4 >> 1)) * ZW + Z_S5 + g * 16 + (q4 & 1) * 8)
    S5_LOAD_UB();
#pragma unroll
    for (int k = 0; k < 16; ++k) { Xr[k] = 0.f; Xi[k] = 0.f; }
    if constexpr (PHB) {
        S5_LOAD_A16();
        f32x4 en[8];
        if (u > 0) {
#pragma unroll
            for (int T = 0; T < 8; ++T) en[T] = *(const GAS f32x4*)(Eb + 16 * T);
        }
#pragma unroll
        for (int sq = 0; sq < 4; ++sq)
#pragma unroll
            for (int k = 0; k < 16; ++k) { const float a2 = ar[k] * ar[k] - ai[k] * ai[k]; ai[k] = (ar[k] + ar[k]) * ai[k]; ar[k] = a2; }
        for (int up = 0; up < u; ++up) {
            f32x4 ec[8];
#pragma unroll
            for (int T = 0; T < 8; ++T) ec[T] = en[T];
            if (up + 1 < u) {
#pragma unroll
                for (int T = 0; T < 8; ++T) en[T] = *(const GAS f32x4*)(Eb + (size_t)(up + 1) * 4096 + 16 * T);
            }
#pragma unroll
            for (int k = 0; k < 16; ++k) { const float xr = Xr[k], xi = Xi[k]; Xr[k] = ar[k] * xr - ai[k] * xi + ec[k >> 2][k & 3]; Xi[k] = ar[k] * xi + ai[k] * xr + ec[4 + (k >> 2)][k & 3]; }
        }
    }
    {
        f32x4 xl[8];
        const bf16* pt = Pt + n * 256 + 8 * q4;
        if constexpr (!PHB) {
            bf16x8 fq[4][8];
#pragma unroll
            for (int hb = 0; hb < 2; ++hb) {
                asm volatile("" ::: "memory");
#pragma unroll
                for (int T = 0; T < 4; ++T)
#pragma unroll
                    for (int ks = 0; ks < 8; ++ks) fq[T][ks] = *(const GAS bf16x8*)(pt + (4 * hb + T) * 4096 + 32 * ks);
#pragma unroll
                for (int T = 0; T < 4; ++T) { xl[4 * hb + T] = (f32x4){0.f, 0.f, 0.f, 0.f};
#pragma unroll
                    for (int ks = 0; ks < 8; ++ks) xl[4 * hb + T] = __builtin_amdgcn_mfma_f32_16x16x32_bf16(fq[T][ks], ub[ks], xl[4 * hb + T], 0, 0, 0); }
            }
        } else {
        bf16x8 fa[8], fb[8];
#pragma unroll
        for (int ks = 0; ks < 8; ++ks) fa[ks] = *(const GAS bf16x8*)(pt + 32 * ks);
#pragma unroll
        for (int T = 0; T < 8; T += 2) {
            asm volatile("" ::: "memory");
#pragma unroll
            for (int ks = 0; ks < 8; ++ks) fb[ks] = *(const GAS bf16x8*)(pt + (T + 1) * 4096 + 32 * ks);
            asm volatile("" ::: "memory");
            xl[T] = (f32x4){0.f, 0.f, 0.f, 0.f};
#pragma unroll
            for (int ks = 0; ks < 8; ++ks) xl[T] = __builtin_amdgcn_mfma_f32_16x16x32_bf16(fa[ks], ub[ks], xl[T], 0, 0, 0);
            if (T + 2 < 8) {
#pragma unroll
                for (int ks = 0; ks < 8; ++ks) fa[ks] = *(const GAS bf16x8*)(pt + (T + 2) * 4096 + 32 * ks);
            }
            asm volatile("" ::: "memory");
            xl[T + 1] = (f32x4){0.f, 0.f, 0.f, 0.f};
#pragma unroll
            for (int ks = 0; ks < 8; ++ks) xl[T + 1] = __builtin_amdgcn_mfma_f32_16x16x32_bf16(fb[ks], ub[ks], xl[T + 1], 0, 0, 0);
        }
        }
#pragma unroll
        for (int k = 0; k < 16; ++k) { yre[k] = xl[k >> 2][k & 3]; yim[k] = xl[4 + (k >> 2)][k & 3]; }
    }
    asm volatile("" ::: "memory");
    S5_LOAD_A16();
    if constexpr (PHB) { if (n == 0) {
#pragma unroll
        for (int k = 0; k < 16; ++k) { yre[k] += ar[k] * Xr[k] - ai[k] * Xi[k]; yim[k] += ar[k] * Xi[k] + ai[k] * Xr[k]; } } }
#pragma unroll
    for (int d = 1; d < 16; d <<= 1) {
#pragma unroll
        for (int k = 0; k < 16; ++k) {
            const float pr = __shfl_up(yre[k], d, 16), pi = __shfl_up(yim[k], d, 16);
            if (n >= d) { yre[k] += ar[k] * pr - ai[k] * pi; yim[k] += ar[k] * pi + ai[k] * pr; }
            const float a2 = ar[k] * ar[k] - ai[k] * ai[k]; ai[k] = (ar[k] + ar[k]) * ai[k]; ar[k] = a2; }
    }
    if constexpr (!PHB) {
        if (n == 15) {
#pragma unroll
            for (int T = 0; T < 4; ++T) { *(GAS f32x4*)(Eb + (size_t)u * 4096 + 16 * T) = (f32x4){yre[4 * T], yre[4 * T + 1], yre[4 * T + 2], yre[4 * T + 3]};
                *(GAS f32x4*)(Eb + (size_t)u * 4096 + 64 + 16 * T) = (f32x4){yim[4 * T], yim[4 * T + 1], yim[4 * T + 2], yim[4 * T + 3]}; }
        }
    } else {
#pragma unroll
        for (int k = 0; k < 16; ++k) { const float pr = __shfl_up(yre[k], 1, 16), pi = __shfl_up(yim[k], 1, 16); yre[k] = (n == 0) ? Xr[k] : pr; yim[k] = (n == 0) ? Xi[k] : pi; }
        bf16x8 xb[4];
#pragma unroll
        for (int kp = 0; kp < 2; ++kp) { v4u w; w.x = pk2(yre[8 * kp], yre[8 * kp + 1]); w.y = pk2(yre[8 * kp + 2], yre[8 * kp + 3]); w.z = pk2(yre[8 * kp + 4], yre[8 * kp + 5]); w.w = pk2(yre[8 * kp + 6], yre[8 * kp + 7]);
            xb[kp] = __builtin_bit_cast(bf16x8, w);
            v4u w2; w2.x = pk2(yim[8 * kp], yim[8 * kp + 1]); w2.y = pk2(yim[8 * kp + 2], yim[8 * kp + 3]); w2.z = pk2(yim[8 * kp + 4], yim[8 * kp + 5]); w2.w = pk2(yim[8 * kp + 6], yim[8 * kp + 7]);
            xb[2 + kp] = __builtin_bit_cast(bf16x8, w2); }
        const f32x4 dsk = *(const GAS f32x4*)(P.s5_d + g * 16 + 4 * q4);
        const bf16* qp0 = Qt + n * 128 + q4 * 8;
        const bf16* kp00 = Ktab + (1 - (q4 >> 1)) * 256 + n * 16 + (q4 & 1) * 8;
        const bf16* zu = P.z + (tok0 + 16 * n) * ZW + Z_S5 + g * 16 + 4 * q4;
        float* yo = P.ys + (tok0 + 16 * n) * 512 + g * 16 + 4 * q4; bf16* yob = P.ysb + (tok0 + 16 * n) * 512 + g * 16 + 4 * q4;
        bf16x8 qa[4], ka[8], qb[4], kb[8]; v2u ua, ubw;
#define S5_REQ(i_, qf, kf, uw) do { _Pragma("unroll") for (int kp = 0; kp < 4; ++kp) qf[kp] = *(const GAS bf16x8*)(qp0 + (i_) * 2048 + kp * 32); \
            _Pragma("unroll") for (int ks = 0; ks < 8; ++ks) if (2 * ks <= (i_)) kf[ks] = *(const GAS bf16x8*)(kp00 + (i_) * 256 - ks * 512); \
            uw = *(const GAS v2u*)(zu + (size_t)(i_) * ZW); } while (0)
#define S5_OUT(i_, qf, kf, uw) do { f32x4 acc = (f32x4){0.f, 0.f, 0.f, 0.f}; \
            _Pragma("unroll") for (int kp = 0; kp < 4; ++kp) acc = __builtin_amdgcn_mfma_f32_16x16x32_bf16(qf[kp], xb[kp], acc, 0, 0, 0); \
            _Pragma("unroll") for (int ks = 0; ks < 8; ++ks) if (2 * ks <= (i_)) acc = __builtin_amdgcn_mfma_f32_16x16x32_bf16(kf[ks], ub[ks], acc, 0, 0, 0); \
            f32x4 yv; yv.x = gelu_tanh(acc.x + dsk.x * bflo(uw.x)); yv.y = gelu_tanh(acc.y + dsk.y * bfhi(uw.x)); yv.z = gelu_tanh(acc.z + dsk.z * bflo(uw.y)); yv.w = gelu_tanh(acc.w + dsk.w * bfhi(uw.y)); \
            *(GAS f32x4*)(yo + (size_t)(i_) * 512) = yv; v2u ob; ob.x = pk2(yv.x, yv.y); ob.y = pk2(yv.z, yv.w); *(GAS v2u*)(yob + (size_t)(i_) * 512) = ob; } while (0)
        S5_REQ(0, qa, ka, ua);
#pragma unroll 1
        for (int i = 0; i < 16; i += 2) {
            asm volatile("" ::: "memory");
            S5_REQ(i + 1, qb, kb, ubw);
            asm volatile("" ::: "memory");
            S5_OUT(i, qa, ka, ua);
            if (i + 2 < 16) S5_REQ(i + 2, qa, ka, ua);
            asm volatile("" ::: "memory");
            S5_OUT(i + 1, qb, kb, ubw);
        }
#undef S5_REQ
#undef S5_OUT
    }
}
#undef S5_LOAD_A16
#undef S5_LOAD_UB
constexpr int DN_LS = 132, DN_MS = 68, DN_TS = 20;
constexpr int DN_Q_OFF = 0, DN_K_OFF = 64 * DN_LS * 4, DN_V_OFF = 2 * DN_K_OFF, DN_L_OFF = 3 * DN_K_OFF, DN_A_OFF = DN_L_OFF + 64 * DN_MS * 4, DN_T_OFF = DN_A_OFF + 64 * DN_MS * 4, DN_G_OFF = DN_T_OFF + 64 * DN_TS * 4;
static_assert(DN_G_OFF + 1024 <= MISC_OFF, "deltanet chunk LDS");
constexpr size_t DNC_W = 0, DNC_QD = 16384, DNC_AT = 32768, DNC_KD = 40960, DNC_U = 57344, DNC_GATE = 90112, DNC_EGL = 106496, DNC_STRIDE = 106752;
constexpr int DNC_OPS = 57344;
__device__ __forceinline__ void dn_chunk_unit(Frame& F, const MixP& P, unsigned char* dnc, int unit) {
    PHASE_TID();
    const int h = unit & 3, cn = (unit >> 2) & 63, b = unit >> 8;
    const int t0 = b * SEQ + cn * 64, pos0 = cn * 64;
    unsigned char* cb = dnc + (size_t)((b * 4 + h) * 64 + cn) * DNC_STRIDE;
    LAS float* qs = (LAS float*)(F.lds + DN_Q_OFF); LAS float* ks = (LAS float*)(F.lds + DN_K_OFF); LAS float* vs = (LAS float*)(F.lds + DN_V_OFF);
    LAS float* Lm = (LAS float*)(F.lds + DN_L_OFF); LAS float* At = (LAS float*)(F.lds + DN_A_OFF); LAS float* Td = (LAS float*)(F.lds + DN_T_OFF);
    LAS float* gcs = (LAS float*)(F.lds + DN_G_OFF); LAS float* betas = gcs + 64; LAS float* egs = gcs + 128; LAS float* gsm = gcs + 192;
    __syncthreads();
    if (tid < 384) { const int oct = tid & 7, pc = tid >> 3, part = pc >> 4, cg = pc & 15, ch = part * 512 + h * 128 + 8 * cg, tk0 = 8 * oct;
        v4u zr[11]; f32x4 wv[4][2];
#pragma unroll
        for (int j = 0; j < 11; ++j) { zr[j] = (v4u){0u, 0u, 0u, 0u}; if (pos0 + tk0 - 3 + j >= 0) zr[j] = *(const GAS v4u*)(P.z + (size_t)(t0 + tk0 - 3 + j) * ZW + Z_DQKV + ch); }
#pragma unroll
        for (int k = 0; k < 4; ++k) { wv[k][0] = *(const GAS f32x4*)(P.convw + k * 1536 + ch); wv[k][1] = *(const GAS f32x4*)(P.convw + k * 1536 + ch + 4); }
        LAS float* dst = (LAS float*)(F.lds + part * DN_K_OFF) + tk0 * DN_LS + 8 * cg;
#pragma unroll
        for (int tt = 0; tt < 8; ++tt) { float acc[8];
#pragma unroll
            for (int e = 0; e < 8; ++e) acc[e] = 0.f;
#pragma unroll
            for (int k = 0; k < 4; ++k) { const v4u zw = zr[tt + k]; const f32x4 w0 = wv[k][0], w1 = wv[k][1];
                acc[0] += w0.x * bflo(zw.x); acc[1] += w0.y * bfhi(zw.x); acc[2] += w0.z * bflo(zw.y); acc[3] += w0.w * bfhi(zw.y);
                acc[4] += w1.x * bflo(zw.z); acc[5] += w1.y * bfhi(zw.z); acc[6] += w1.z * bflo(zw.w); acc[7] += w1.w * bfhi(zw.w); }
#pragma unroll
            for (int e = 0; e < 8; ++e) acc[e] = acc[e] * sigmoid_f(acc[e]);
            *(LAS f32x4*)(dst + tt * DN_LS) = (f32x4){acc[0], acc[1], acc[2], acc[3]}; *(LAS f32x4*)(dst + tt * DN_LS + 4) = (f32x4){acc[4], acc[5], acc[6], acc[7]}; } }
    if (tid < 64) { const float br = P.ab[(size_t)(t0 + tid) * 8 + h], ar = P.ab[(size_t)(t0 + tid) * 8 + 4 + h] + P.dt_bias[h];
        const float sp = fmaxf(ar, 0.f) + log1pf(__expf(-fabsf(ar)));
        betas[tid] = sigmoid_f(br); gsm[tid] = -__expf(P.a_log[h]) * sp; }
    __syncthreads();
    { const int w = F.wave;
#pragma unroll 1
      for (int rr = 0; rr < 8; ++rr) { const int row = 8 * w + rr;
          { LAS float* p = qs + row * DN_LS; const float a = p[lane], c = p[lane + 64]; const float r = 0.08838834764831845f / sqrtf(wave_sum(a * a + c * c) + NORM_EPS); p[lane] = a * r; p[lane + 64] = c * r; }
          { LAS float* p = ks + row * DN_LS; const float a = p[lane], c = p[lane + 64]; const float r = 1.0f / sqrtf(wave_sum(a * a + c * c) + NORM_EPS); p[lane] = a * r; p[lane + 64] = c * r; } }
      if (w == 0) { float g = gsm[lane];
#pragma unroll
          for (int d = 1; d < 64; d <<= 1) { const float pv = __shfl_up(g, d, 64); if (lane >= d) g += pv; }
          gcs[lane] = g; egs[lane] = __expf(g); } }
    __syncthreads();
    const int m = lane & 15, q = lane >> 4;
#pragma unroll 1
    for (int job = F.wave; job < 20; job += NWAVES) { const int kind = job >= 10, idx = job - 10 * kind; const int ti = (idx >= 6) ? 3 : (idx >= 3) ? 2 : (idx >= 1) ? 1 : 0, tj = idx - ((ti * (ti + 1)) >> 1);
        const LAS float* ap = (kind ? qs : ks) + (16 * ti + m) * DN_LS + 4 * q; const LAS float* bp = ks + (16 * tj + m) * DN_LS + 4 * q;
        f32x4 acc = (f32x4){0.f, 0.f, 0.f, 0.f};
#pragma unroll
        for (int kg = 0; kg < 8; ++kg) { const f32x4 a4 = *(const LAS f32x4*)(ap + 16 * kg), b4 = *(const LAS f32x4*)(bp + 16 * kg);
#pragma unroll
            for (int s = 0; s < 4; ++s) acc = __builtin_amdgcn_mfma_f32_16x16x4f32(a4[s], b4[s], acc, 0, 0, 0); }
        const int j = 16 * tj + m; const float gj = gcs[j];
#pragma unroll
        for (int r = 0; r < 4; ++r) { const int i = 16 * ti + 4 * q + r; const float dec = __expf(gcs[i] - gj);
            if (kind) At[i * DN_MS + j] = (i >= j) ? acc[r] * dec : 0.f; else Lm[i * DN_MS + j] = (i > j) ? acc[r] * dec * betas[i] : 0.f; } }
    __syncthreads();
    if (F.wave == 0) { float Tr[16];
#pragma unroll
        for (int r = 0; r < 16; ++r) { float acc = (m == r) ? 1.f : 0.f;
#pragma unroll
            for (int j = 0; j < 16; ++j) if (j < r) acc -= Lm[(16 * q + r) * DN_MS + 16 * q + j] * Tr[j];
            Tr[r] = acc; Td[(16 * q + r) * DN_TS + m] = acc; } }
    __syncthreads();
#pragma unroll 1
    for (int half = 0; half < 2; ++half) {
        const int ct = F.wave + 8 * half; const LAS float* rsrc = (half ? ks : vs) + 16 * F.wave + m;
        f32x4 X[4];
#pragma unroll
        for (int i = 0; i < 4; ++i) { f32x4 acc;
#pragma unroll
            for (int r = 0; r < 4; ++r) { const int row = 16 * i + 4 * q + r; const float sc = half ? betas[row] * egs[row] : betas[row]; acc[r] = rsrc[row * DN_LS] * sc; }
            f32x4 s = (f32x4){0.f, 0.f, 0.f, 0.f};
#pragma unroll
            for (int j = 0; j < 4; ++j) if (j < i) { const f32x4 a4 = *(const LAS f32x4*)(Lm + (16 * i + m) * DN_MS + 16 * j + 4 * q);
#pragma unroll
                for (int s4 = 0; s4 < 4; ++s4) s = __builtin_amdgcn_mfma_f32_16x16x4f32(a4[s4], X[j][s4], s, 0, 0, 0); }
            acc -= s;
            const f32x4 t4 = *(const LAS f32x4*)(Td + (16 * i + m) * DN_TS + 4 * q); f32x4 xi = (f32x4){0.f, 0.f, 0.f, 0.f};
#pragma unroll
            for (int s4 = 0; s4 < 4; ++s4) xi = __builtin_amdgcn_mfma_f32_16x16x4f32(t4[s4], acc[s4], xi, 0, 0, 0);
            X[i] = xi; }
        if (half == 0) {
#pragma unroll
            for (int i = 0; i < 4; ++i) *(GAS f32x4*)(cb + DNC_U + (size_t)((ct * 4 + i) * 64 + lane) * 16) = X[i];
            __syncthreads();
        } else {
#pragma unroll
            for (int i = 0; i < 4; ++i)
#pragma unroll
                for (int r = 0; r < 4; ++r) vs[(16 * i + 4 * q + r) * DN_LS + 16 * F.wave + m] = X[i][r];
        }
    }
    __syncthreads();
    const float gl = gcs[63];
#pragma unroll
    for (int rep = 0; rep < 7; ++rep) { const int e = tid + rep * (NWAVES * 64); v4u o;
        if (rep < 4) { const int e2 = e & 1023, tile = e2 >> 6, fl = e2 & 63, fm = fl & 15, fq = fl >> 4, it = tile >> 2, kss = tile & 3, tok = 16 * it + fm;
            const LAS float* src = ((rep < 2) ? vs : qs) + tok * DN_LS + 32 * kss + 4 * fq; const float sc = (rep < 2) ? 1.0f : egs[tok];
            const f32x4 lo = *(const LAS f32x4*)src, hi = *(const LAS f32x4*)(src + 16);
            o.x = pk2(lo.x * sc, lo.y * sc); o.y = pk2(lo.z * sc, lo.w * sc); o.z = pk2(hi.x * sc, hi.y * sc); o.w = pk2(hi.z * sc, hi.w * sc);
        } else if (rep == 4) { const int e2 = e - 2048, tile = e2 >> 6, fl = e2 & 63, fm = fl & 15, fq = fl >> 4, it = tile >> 1, ks2 = tile & 1, i = 16 * it + fm, j0 = 32 * ks2 + 4 * fq;
            const f32x4 lo = *(const LAS f32x4*)(At + i * DN_MS + j0), hi = *(const LAS f32x4*)(At + i * DN_MS + j0 + 16);
            float v[8] = {lo.x, lo.y, lo.z, lo.w, hi.x, hi.y, hi.z, hi.w};
#pragma unroll
            for (int jj = 0; jj < 8; ++jj) { const int j = j0 + (jj & 3) + 16 * (jj >> 2); if (j > i) v[jj] = 0.f; }
            o.x = pk2(v[0], v[1]); o.y = pk2(v[2], v[3]); o.z = pk2(v[4], v[5]); o.w = pk2(v[6], v[7]);
        } else { const int e2 = e - 2560, tile = e2 >> 6, fl = e2 & 63, fm = fl & 15, fq = fl >> 4, dt = tile >> 1, ks2 = tile & 1, dk = 16 * dt + fm, j0 = 32 * ks2 + 4 * fq; float v[8];
#pragma unroll
            for (int jj = 0; jj < 8; ++jj) { const int j = j0 + (jj & 3) + 16 * (jj >> 2); v[jj] = ks[j * DN_LS + dk] * __expf(gl - gcs[j]); }
            o.x = pk2(v[0], v[1]); o.y = pk2(v[2], v[3]); o.z = pk2(v[4], v[5]); o.w = pk2(v[6], v[7]); }
        *(GAS v4u*)(cb + (size_t)e * 16) = o; }
    if (tid == 0) *(GAS float*)(cb + DNC_EGL) = __expf(gl);
}
constexpr int DNX_BUF0 = 0, DNX_BUF1 = DNC_OPS, DNX_RED = 2 * DNC_OPS;
static_assert(DNX_RED + 2 * 8 * 64 * 4 <= MISC_OFF, "deltanet chain LDS");
#ifndef DN_DMA
#define DN_DMA 0
#endif
template <int CTRL> __device__ __forceinline__ float dppf(float x) { return __builtin_bit_cast(float, __builtin_amdgcn_mov_dpp(__builtin_bit_cast(int, x), CTRL, 0xf, 0xf, true)); }
__device__ __forceinline__ float row16_sum(float x) { x += dppf<0xB1>(x); x += dppf<0x4E>(x); x += dppf<0x141>(x); x += dppf<0x128>(x); return x; }
typedef float f32x2_t __attribute__((ext_vector_type(2))); typedef __bf16 bf16x2_t __attribute__((ext_vector_type(2)));
__device__ __forceinline__ unsigned cvtpk(float lo, float hi) { const f32x2_t v = {lo, hi}; const bf16x2_t b = __builtin_convertvector(v, bf16x2_t); return __builtin_bit_cast(unsigned, b); }
__device__ __forceinline__ bf16x8 pack8(const f32x4 a, const f32x4 b) { v4u w; w.x = cvtpk(a[0], a[1]); w.y = cvtpk(a[2], a[3]); w.z = cvtpk(b[0], b[1]); w.w = cvtpk(b[2], b[3]); return __builtin_bit_cast(bf16x8, w); }
__device__ __forceinline__ void dn_chain(Frame& F, const MixP& P, const unsigned char* dnc, int unit) {
    PHASE_TID();
    const int bh = unit >> 1, half = unit & 1, b = bh >> 2, h = bh & 3, w = F.wave, n = lane & 15, q4 = lane >> 4;
    const unsigned char* cb0 = dnc + (size_t)(bh * 64) * DNC_STRIDE;
    __syncthreads();
    if (w >= 4) {
        const unsigned so = (unsigned)((tid - 256) * 16);
        v4u s0[14], s1[14], s2[14];
#define DN_REQ(dst, chunk_) do { const unsigned char* src_ = cb0 + (size_t)((chunk_) < 64 ? (chunk_) : 63) * DNC_STRIDE + so; \
        _Pragma("unroll") for (int r = 0; r < 14; ++r) dst[r] = *(const GAS v4u*)(src_ + r * 4096); } while (0)
#define DN_PUT(bufoff, srcv) do { _Pragma("unroll") for (int r = 0; r < 14; ++r) *(LAS v4u*)(F.lds + (bufoff) + so + r * 4096) = srcv[r]; } while (0)
#define DN_SBAR() do { asm volatile("s_waitcnt lgkmcnt(0)" ::: "memory"); __builtin_amdgcn_s_barrier(); asm volatile("" ::: "memory"); } while (0)
        DN_REQ(s0, 0); DN_REQ(s1, 1); DN_REQ(s2, 2);
        DN_PUT(DNX_BUF0, s0); DN_REQ(s0, 3);
        __syncthreads();
#pragma unroll 1
        for (int c = 0; c < 60; c += 6) {
            DN_PUT(DNX_BUF1, s1); DN_REQ(s1, c + 4); DN_SBAR();
            DN_PUT(DNX_BUF0, s2); DN_REQ(s2, c + 5); DN_SBAR();
            DN_PUT(DNX_BUF1, s0); DN_REQ(s0, c + 6); DN_SBAR();
            DN_PUT(DNX_BUF0, s1); DN_REQ(s1, c + 7); DN_SBAR();
            DN_PUT(DNX_BUF1, s2); DN_REQ(s2, c + 8); DN_SBAR();
            DN_PUT(DNX_BUF0, s0); DN_REQ(s0, c + 9); DN_SBAR();
        }
        DN_PUT(DNX_BUF1, s1); DN_SBAR();
        DN_PUT(DNX_BUF0, s2); DN_SBAR();
        DN_PUT(DNX_BUF1, s0); DN_SBAR();
        DN_SBAR();
#undef DN_REQ
#undef DN_PUT
#undef DN_SBAR
    } else {
        const int sl = half * 4 + w;
        float* ob = P.oraw + ((size_t)b * SEQ + 4 * q4) * 512 + h * 128 + 16 * sl + n;
        const unsigned uoff = (unsigned)(DNC_U + ((sl * 4) * 64 + lane) * 16);
        f32x4 S[8]; bf16x8 Sb[4];
#pragma unroll
        for (int T = 0; T < 8; ++T) S[T] = (f32x4){0.f, 0.f, 0.f, 0.f};
#pragma unroll
        for (int k = 0; k < 4; ++k) Sb[k] = __builtin_bit_cast(bf16x8, (v4u){0u, 0u, 0u, 0u});
        f32x4 U0[4], U1[4]; float eg0, eg1;
#pragma unroll
        for (int it = 0; it < 4; ++it) { U0[it] = *(const GAS f32x4*)(cb0 + uoff + it * 1024); U1[it] = *(const GAS f32x4*)(cb0 + DNC_STRIDE + uoff + it * 1024); }
        eg0 = *(const GAS float*)(cb0 + DNC_EGL); eg1 = *(const GAS float*)(cb0 + DNC_STRIDE + DNC_EGL);
        __syncthreads();
#define DN_STEP(c_, BUFOFF, U_, eg_) do { \
        const LAS unsigned char* buf = F.lds + (BUFOFF); \
        bf16x8 fa[16], fb[16]; f32x4 ws[4], o[4]; \
        _Pragma("unroll") for (int t = 0; t < 16; ++t) fa[t] = *(const LAS bf16x8*)(buf + DNC_W + (t * 64 + lane) * 16); \
        _Pragma("unroll") for (int t = 0; t < 16; ++t) fb[t] = *(const LAS bf16x8*)(buf + DNC_QD + (t * 64 + lane) * 16); \
        asm volatile("" ::: "memory"); \
        _Pragma("unroll") for (int it = 0; it < 4; ++it) { ws[it] = (f32x4){0.f, 0.f, 0.f, 0.f}; o[it] = (f32x4){0.f, 0.f, 0.f, 0.f}; } \
        _Pragma("unroll") for (int ks = 0; ks < 4; ++ks) _Pragma("unroll") for (int it = 0; it < 4; ++it) ws[it] = __builtin_amdgcn_mfma_f32_16x16x32_bf16(fa[it * 4 + ks], Sb[ks], ws[it], 0, 0, 0); \
        _Pragma("unroll") for (int t = 0; t < 16; ++t) fa[t] = *(const LAS bf16x8*)(buf + DNC_KD + (t * 64 + lane) * 16); \
        asm volatile("" ::: "memory"); \
        _Pragma("unroll") for (int ks = 0; ks < 4; ++ks) _Pragma("unroll") for (int it = 0; it < 4; ++it) o[it] = __builtin_amdgcn_mfma_f32_16x16x32_bf16(fb[it * 4 + ks], Sb[ks], o[it], 0, 0, 0); \
        bf16x8 vb[2]; vb[0] = pack8(U_[0] - ws[0], U_[1] - ws[1]); vb[1] = pack8(U_[2] - ws[2], U_[3] - ws[3]); \
        _Pragma("unroll") for (int t = 0; t < 8; ++t) if (32 * (t & 1) <= 16 * (t >> 1) + 15) fb[t] = *(const LAS bf16x8*)(buf + DNC_AT + (t * 64 + lane) * 16); \
        asm volatile("" ::: "memory"); \
        _Pragma("unroll") for (int T = 0; T < 8; ++T) S[T] = S[T] * eg_; \
        _Pragma("unroll") for (int k2 = 0; k2 < 2; ++k2) _Pragma("unroll") for (int T = 0; T < 8; ++T) S[T] = __builtin_amdgcn_mfma_f32_16x16x32_bf16(fa[T * 2 + k2], vb[k2], S[T], 0, 0, 0); \
        _Pragma("unroll") for (int k2 = 0; k2 < 2; ++k2) _Pragma("unroll") for (int it = 0; it < 4; ++it) if (32 * k2 <= 16 * it + 15) o[it] = __builtin_amdgcn_mfma_f32_16x16x32_bf16(fb[it * 2 + k2], vb[k2], o[it], 0, 0, 0); \
        _Pragma("unroll") for (int k = 0; k < 4; ++k) Sb[k] = pack8(S[2 * k], S[2 * k + 1]); \
        { float* op = ob + (size_t)(c_) * (64 * 512); \
          _Pragma("unroll") for (int it = 0; it < 4; ++it) _Pragma("unroll") for (int r = 0; r < 4; ++r) op[(16 * it + r) * 512] = o[it][r]; } \
        { const unsigned char* src = cb0 + (size_t)((c_) + 2 < 64 ? (c_) + 2 : 63) * DNC_STRIDE; \
          _Pragma("unroll") for (int it = 0; it < 4; ++it) U_[it] = *(const GAS f32x4*)(src + uoff + it * 1024); \
          eg_ = *(const GAS float*)(src + DNC_EGL); } \
        asm volatile("s_waitcnt lgkmcnt(0)" ::: "memory"); __builtin_amdgcn_s_barrier(); asm volatile("" ::: "memory"); } while (0)
#pragma unroll 1
        for (int c = 0; c < 64; c += 2) {
            DN_STEP(c, DNX_BUF0, U0, eg0);
            DN_STEP(c + 1, DNX_BUF1, U1, eg1);
        }
#undef DN_STEP
    }
    asm volatile("s_waitcnt vmcnt(0)" ::: "memory");
    __syncthreads();
}
__device__ __forceinline__ void dn_chain_e(Frame& F, const MixP& P, const unsigned char* dnc, int unit) {
    PHASE_TID();
    const int bh = unit >> 1, half = unit & 1, b = bh >> 2, h = bh & 3, w = F.wave, n = lane & 15, q4 = lane >> 4;
    const unsigned char* cb0 = dnc + (size_t)(bh * 64) * DNC_STRIDE;
    __syncthreads();
    if (w >= 4) {
        const unsigned so = (unsigned)((tid - 256) * 16);
        v4u s0[14], s1[14], s2[14];
#define DN_REQ(dst, chunk_) do { const unsigned char* src_ = cb0 + (size_t)((chunk_) < 64 ? (chunk_) : 63) * DNC_STRIDE + so; \
        _Pragma("unroll") for (int r = 0; r < 14; ++r) dst[r] = *(const GAS v4u*)(src_ + r * 4096); } while (0)
#define DN_PUT(bufoff, srcv) do { _Pragma("unroll") for (int r = 0; r < 14; ++r) *(LAS v4u*)(F.lds + (bufoff) + so + r * 4096) = srcv[r]; } while (0)
#define DN_SBAR() do { asm volatile("s_waitcnt lgkmcnt(0)" ::: "memory"); __builtin_amdgcn_s_barrier(); asm volatile("" ::: "memory"); } while (0)
        DN_REQ(s0, 0); DN_REQ(s1, 1); DN_REQ(s2, 2);
        DN_PUT(DNX_BUF0, s0); DN_REQ(s0, 3);
        __syncthreads();
#pragma unroll 1
        for (int c = 0; c < 60; c += 6) {
            DN_PUT(DNX_BUF1, s1); DN_REQ(s1, c + 4); DN_SBAR();
            DN_PUT(DNX_BUF0, s2); DN_REQ(s2, c + 5); DN_SBAR();
            DN_PUT(DNX_BUF1, s0); DN_REQ(s0, c + 6); DN_SBAR();
            DN_PUT(DNX_BUF0, s1); DN_REQ(s1, c + 7); DN_SBAR();
            DN_PUT(DNX_BUF1, s2); DN_REQ(s2, c + 8); DN_SBAR();
            DN_PUT(DNX_BUF0, s0); DN_REQ(s0, c + 9); DN_SBAR();
        }
        DN_PUT(DNX_BUF1, s1); DN_SBAR();
        DN_PUT(DNX_BUF0, s2); DN_SBAR();
        DN_PUT(DNX_BUF1, s0); DN_SBAR();
        DN_SBAR();
#undef DN_REQ
#undef DN_PUT
#undef DN_SBAR
    } else {
        const int sl = half * 4 + w;
        float* ob = P.oraw + ((size_t)b * SEQ + 4 * q4) * 512 + h * 128 + 16 * sl + n;
        const unsigned uoff = (unsigned)(DNC_U + ((sl * 4) * 64 + lane) * 16);
        f32x4 S[8]; bf16x8 Sb[4];
#pragma unroll
        for (int T = 0; T < 8; ++T) S[T] = (f32x4){0.f, 0.f, 0.f, 0.f};
#pragma unroll
        for (int k = 0; k < 4; ++k) Sb[k] = __builtin_bit_cast(bf16x8, (v4u){0u, 0u, 0u, 0u});
        f32x4 U0[4], U1[4]; float eg0, eg1;
#pragma unroll
        for (int it = 0; it < 4; ++it) { U0[it] = *(const GAS f32x4*)(cb0 + uoff + it * 1024); U1[it] = *(const GAS f32x4*)(cb0 + DNC_STRIDE + uoff + it * 1024); }
        eg0 = *(const GAS float*)(cb0 + DNC_EGL); eg1 = *(const GAS float*)(cb0 + DNC_STRIDE + DNC_EGL);
        __syncthreads();
#define DN_STEP(c_, BUFOFF, U_, eg_) do { \
        const LAS unsigned char* buf = F.lds + (BUFOFF); \
        bf16x8 fa[16], fb[16]; f32x4 ws[4], o[4]; \
        _Pragma("unroll") for (int t = 0; t < 16; ++t) fa[t] = *(const LAS bf16x8*)(buf + DNC_W + (t * 64 + lane) * 16); \
        _Pragma("unroll") for (int t = 0; t < 16; ++t) fb[t] = *(const LAS bf16x8*)(buf + DNC_QD + (t * 64 + lane) * 16); \
        asm volatile("" ::: "memory"); \
        _Pragma("unroll") for (int it = 0; it < 4; ++it) { ws[it] = (f32x4){0.f, 0.f, 0.f, 0.f}; o[it] = (f32x4){0.f, 0.f, 0.f, 0.f}; } \
        _Pragma("unroll") for (int ks = 0; ks < 4; ++ks) _Pragma("unroll") for (int it = 0; it < 4; ++it) ws[it] = __builtin_amdgcn_mfma_f32_16x16x32_bf16(fa[it * 4 + ks], Sb[ks], ws[it], 0, 0, 0); \
        _Pragma("unroll") for (int t = 0; t < 16; ++t) fa[t] = *(const LAS bf16x8*)(buf + DNC_KD + (t * 64 + lane) * 16); \
        asm volatile("" ::: "memory"); \
        _Pragma("unroll") for (int ks = 0; ks < 4; ++ks) _Pragma("unroll") for (int it = 0; it < 4; ++it) o[it] = __builtin_amdgcn_mfma_f32_16x16x32_bf16(fb[it * 4 + ks], Sb[ks], o[it], 0, 0, 0); \
        bf16x8 vb[2]; vb[0] = pack8(U_[0] - ws[0], U_[1] - ws[1]); vb[1] = pack8(U_[2] - ws[2], U_[3] - ws[3]); \
        _Pragma("unroll") for (int t = 0; t < 8; ++t) if (32 * (t & 1) <= 16 * (t >> 1) + 15) fb[t] = *(const LAS bf16x8*)(buf + DNC_AT + (t * 64 + lane) * 16); \
        asm volatile("" ::: "memory"); \
        _Pragma("unroll") for (int T = 0; T < 8; ++T) S[T] = S[T] * eg_; \
        { const unsigned char* src = cb0 + (size_t)((c_) + 2 < 64 ? (c_) + 2 : 63) * DNC_STRIDE;        \
          _Pragma("unroll") for (int it = 0; it < 4; ++it) U_[it] = *(const GAS f32x4*)(src + uoff + it * 1024); \
          eg_ = *(const GAS float*)(src + DNC_EGL); } \
        asm volatile("" ::: "memory"); \
        _Pragma("unroll") for (int k2 = 0; k2 < 2; ++k2) _Pragma("unroll") for (int T = 0; T < 8; ++T) S[T] = __builtin_amdgcn_mfma_f32_16x16x32_bf16(fa[T * 2 + k2], vb[k2], S[T], 0, 0, 0); \
        _Pragma("unroll") for (int k2 = 0; k2 < 2; ++k2) _Pragma("unroll") for (int it = 0; it < 4; ++it) if (32 * k2 <= 16 * it + 15) o[it] = __builtin_amdgcn_mfma_f32_16x16x32_bf16(fb[it * 2 + k2], vb[k2], o[it], 0, 0, 0); \
        _Pragma("unroll") for (int k = 0; k < 4; ++k) Sb[k] = pack8(S[2 * k], S[2 * k + 1]); \
        { float* op = ob + (size_t)(c_) * (64 * 512); \
          _Pragma("unroll") for (int it = 0; it < 4; ++it) _Pragma("unroll") for (int r = 0; r < 4; ++r) op[(16 * it + r) * 512] = o[it][r]; } \
        asm volatile("s_waitcnt lgkmcnt(0)" ::: "memory"); __builtin_amdgcn_s_barrier(); asm volatile("" ::: "memory"); } while (0)
#pragma unroll 1
        for (int c = 0; c < 64; c += 2) {
            DN_STEP(c, DNX_BUF0, U0, eg0);
            DN_STEP(c + 1, DNX_BUF1, U1, eg1);
        }
#undef DN_STEP
    }
    asm volatile("s_waitcnt vmcnt(0)" ::: "memory");
    __syncthreads();
}
__device__ __forceinline__ void dn_chain_p(Frame& F, const MixP& P, const unsigned char* dnc, int unit) {
    PHASE_TID();
    const int bh = unit >> 1, half = unit & 1, b = bh >> 2, h = bh & 3, w = F.wave, n = lane & 15, q4 = lane >> 4;
    const unsigned char* cb0 = dnc + (size_t)(bh * 64) * DNC_STRIDE;
    __syncthreads();
    if (w >= 4) {
        const unsigned so = (unsigned)((tid - 256) * 16);
        v4u s0[14], s1[14], s2[14]; unsigned s0p, s1p, s2p;
        const unsigned po = (unsigned)(DNC_U + half * 16384 + ((tid - 256) & 127) * 128);
#define DN_REQ(dst, chunk_) do { const unsigned char* src_ = cb0 + (size_t)((chunk_) < 64 ? (chunk_) : 63) * DNC_STRIDE + so; \
        _Pragma("unroll") for (int r = 0; r < 14; ++r) dst[r] = *(const GAS v4u*)(src_ + r * 4096); \
        dst##p = *(const GAS unsigned*)(cb0 + (size_t)((chunk_) + 1 < 64 ? (chunk_) + 1 : 63) * DNC_STRIDE + po); } while (0)
#define DN_PUT(bufoff, srcv) do { _Pragma("unroll") for (int r = 0; r < 14; ++r) *(LAS v4u*)(F.lds + (bufoff) + so + r * 4096) = srcv[r]; *(LAS unsigned*)(F.lds + DNX_RED + (tid - 256) * 4) = srcv##p; } while (0)
#define DN_SBAR() do { asm volatile("s_waitcnt lgkmcnt(0)" ::: "memory"); __builtin_amdgcn_s_barrier(); asm volatile("" ::: "memory"); } while (0)
        DN_REQ(s0, 0); DN_REQ(s1, 1); DN_REQ(s2, 2);
        DN_PUT(DNX_BUF0, s0); DN_REQ(s0, 3);
        __syncthreads();
#pragma unroll 1
        for (int c = 0; c < 60; c += 6) {
            DN_PUT(DNX_BUF1, s1); DN_REQ(s1, c + 4); DN_SBAR();
            DN_PUT(DNX_BUF0, s2); DN_REQ(s2, c + 5); DN_SBAR();
            DN_PUT(DNX_BUF1, s0); DN_REQ(s0, c + 6); DN_SBAR();
            DN_PUT(DNX_BUF0, s1); DN_REQ(s1, c + 7); DN_SBAR();
            DN_PUT(DNX_BUF1, s2); DN_REQ(s2, c + 8); DN_SBAR();
            DN_PUT(DNX_BUF0, s0); DN_REQ(s0, c + 9); DN_SBAR();
        }
        DN_PUT(DNX_BUF1, s1); DN_SBAR();
        DN_PUT(DNX_BUF0, s2); DN_SBAR();
        DN_PUT(DNX_BUF1, s0); DN_SBAR();
        DN_SBAR();
#undef DN_REQ
#undef DN_PUT
#undef DN_SBAR
    } else {
        const int sl = half * 4 + w;
        float* ob = P.oraw + ((size_t)b * SEQ + 4 * q4) * 512 + h * 128 + 16 * sl + n;
        const unsigned uoff = (unsigned)(DNC_U + ((sl * 4) * 64 + lane) * 16);
        f32x4 S[8]; bf16x8 Sb[4];
#pragma unroll
        for (int T = 0; T < 8; ++T) S[T] = (f32x4){0.f, 0.f, 0.f, 0.f};
#pragma unroll
        for (int k = 0; k < 4; ++k) Sb[k] = __builtin_bit_cast(bf16x8, (v4u){0u, 0u, 0u, 0u});
        f32x4 U0[4], U1[4]; float eg0, eg1;
#pragma unroll
        for (int it = 0; it < 4; ++it) { U0[it] = *(const GAS f32x4*)(cb0 + uoff + it * 1024); U1[it] = *(const GAS f32x4*)(cb0 + DNC_STRIDE + uoff + it * 1024); }
        eg0 = 0.f; eg1 = 0.f;
        LAS float* egl = (LAS float*)(F.lds + DNX_RED + 1024);
        if (w == 0) egl[lane] = *(const GAS float*)(cb0 + (size_t)lane * DNC_STRIDE + DNC_EGL);
        asm volatile("s_waitcnt vmcnt(0) lgkmcnt(0)" ::: "memory");
        __syncthreads();
#define DN_STEP(c_, BUFOFF, U_, eg_) do { \
        const LAS unsigned char* buf = F.lds + (BUFOFF); \
        bf16x8 fa[16], fb[16]; f32x4 ws[4], o[4]; \
        _Pragma("unroll") for (int t = 0; t < 16; ++t) fa[t] = *(const LAS bf16x8*)(buf + DNC_W + (t * 64 + lane) * 16); \
        _Pragma("unroll") for (int t = 0; t < 16; ++t) fb[t] = *(const LAS bf16x8*)(buf + DNC_QD + (t * 64 + lane) * 16); \
        asm volatile("" ::: "memory"); \
        _Pragma("unroll") for (int it = 0; it < 4; ++it) { ws[it] = (f32x4){0.f, 0.f, 0.f, 0.f}; o[it] = (f32x4){0.f, 0.f, 0.f, 0.f}; } \
        _Pragma("unroll") for (int ks = 0; ks < 4; ++ks) _Pragma("unroll") for (int it = 0; it < 4; ++it) ws[it] = __builtin_amdgcn_mfma_f32_16x16x32_bf16(fa[it * 4 + ks], Sb[ks], ws[it], 0, 0, 0); \
        _Pragma("unroll") for (int t = 0; t < 16; ++t) fa[t] = *(const LAS bf16x8*)(buf + DNC_KD + (t * 64 + lane) * 16); \
        asm volatile("" ::: "memory"); \
        _Pragma("unroll") for (int ks = 0; ks < 4; ++ks) _Pragma("unroll") for (int it = 0; it < 4; ++it) o[it] = __builtin_amdgcn_mfma_f32_16x16x32_bf16(fb[it * 4 + ks], Sb[ks], o[it], 0, 0, 0); \
        bf16x8 vb[2]; vb[0] = pack8(U_[0] - ws[0], U_[1] - ws[1]); vb[1] = pack8(U_[2] - ws[2], U_[3] - ws[3]); \
        _Pragma("unroll") for (int t = 0; t < 8; ++t) if (32 * (t & 1) <= 16 * (t >> 1) + 15) fb[t] = *(const LAS bf16x8*)(buf + DNC_AT + (t * 64 + lane) * 16); \
        asm volatile("" ::: "memory"); \
        eg_ = egl[c_]; \
        _Pragma("unroll") for (int T = 0; T < 8; ++T) S[T] = S[T] * eg_; \
        _Pragma("unroll") for (int k2 = 0; k2 < 2; ++k2) _Pragma("unroll") for (int T = 0; T < 8; ++T) S[T] = __builtin_amdgcn_mfma_f32_16x16x32_bf16(fa[T * 2 + k2], vb[k2], S[T], 0, 0, 0); \
        _Pragma("unroll") for (int k2 = 0; k2 < 2; ++k2) _Pragma("unroll") for (int it = 0; it < 4; ++it) if (32 * k2 <= 16 * it + 15) o[it] = __builtin_amdgcn_mfma_f32_16x16x32_bf16(fb[it * 2 + k2], vb[k2], o[it], 0, 0, 0); \
        _Pragma("unroll") for (int k = 0; k < 4; ++k) Sb[k] = pack8(S[2 * k], S[2 * k + 1]); \
        { float* op = ob + (size_t)(c_) * (64 * 512); \
          _Pragma("unroll") for (int it = 0; it < 4; ++it) _Pragma("unroll") for (int r = 0; r < 4; ++r) op[(16 * it + r) * 512] = o[it][r]; } \
        { const unsigned char* src = cb0 + (size_t)((c_) + 2 < 64 ? (c_) + 2 : 63) * DNC_STRIDE; \
          _Pragma("unroll") for (int it = 0; it < 4; ++it) U_[it] = *(const GAS f32x4*)(src + uoff + it * 1024); \
          } \
        asm volatile("s_waitcnt lgkmcnt(0)" ::: "memory"); __builtin_amdgcn_s_barrier(); asm volatile("" ::: "memory"); } while (0)
#pragma unroll 1
        for (int c = 0; c < 64; c += 2) {
            DN_STEP(c, DNX_BUF0, U0, eg0);
            DN_STEP(c + 1, DNX_BUF1, U1, eg1);
        }
#undef DN_STEP
    }
    asm volatile("s_waitcnt vmcnt(0)" ::: "memory");
    __syncthreads();
}
#ifndef DN_PFD
#define DN_PFD 2
#endif
__device__ __forceinline__ void dn_chain_q(Frame& F, const MixP& P, const unsigned char* dnc, int unit) {
    PHASE_TID();
    const int bh = unit >> 1, half = unit & 1, b = bh >> 2, h = bh & 3, w = F.wave, n = lane & 15, q4 = lane >> 4;
    const unsigned char* cb0 = dnc + (size_t)(bh * 64) * DNC_STRIDE;
    __syncthreads();
    if (w >= 4) {
        const unsigned so = (unsigned)((tid - 256) * 16);
        v4u s0[14], s1[14], s2[14]; unsigned s0p, s1p, s2p, s0q, s1q, s2q, s0r, s1r, s2r;
        const unsigned po = (unsigned)(DNC_U + half * 16384 + ((tid - 256) & 127) * 128);
#define DN_REQ(dst, chunk_) do { const unsigned char* src_ = cb0 + (size_t)((chunk_) < 64 ? (chunk_) : 63) * DNC_STRIDE + so; \
        _Pragma("unroll") for (int r = 0; r < 14; ++r) dst[r] = *(const GAS v4u*)(src_ + r * 4096); \
        { const unsigned char* pf_ = cb0 + (size_t)((chunk_) + DN_PFD < 64 ? (chunk_) + DN_PFD : 63) * DNC_STRIDE;        \
          dst##p = *(const GAS unsigned*)(pf_ + po); dst##q = *(const GAS unsigned*)(pf_ + (tid - 256) * 128); dst##r = *(const GAS unsigned*)(pf_ + ((tid - 256) < 192 ? (tid - 256) + 256 : (tid - 256)) * 128); } } while (0)
#define DN_PUT(bufoff, srcv) do { _Pragma("unroll") for (int r = 0; r < 14; ++r) *(LAS v4u*)(F.lds + (bufoff) + so + r * 4096) = srcv[r]; *(LAS unsigned*)(F.lds + DNX_RED + (tid - 256) * 4) = srcv##p ^ srcv##q ^ srcv##r; } while (0)
#define DN_SBAR() do { asm volatile("s_waitcnt lgkmcnt(0)" ::: "memory"); __builtin_amdgcn_s_barrier(); asm volatile("" ::: "memory"); } while (0)
        DN_REQ(s0, 0); DN_REQ(s1, 1); DN_REQ(s2, 2);
        DN_PUT(DNX_BUF0, s0); DN_REQ(s0, 3);
        __syncthreads();
#pragma unroll 1
        for (int c = 0; c < 60; c += 6) {
            DN_PUT(DNX_BUF1, s1); DN_REQ(s1, c + 4); DN_SBAR();
            DN_PUT(DNX_BUF0, s2); DN_REQ(s2, c + 5); DN_SBAR();
            DN_PUT(DNX_BUF1, s0); DN_REQ(s0, c + 6); DN_SBAR();
            DN_PUT(DNX_BUF0, s1); DN_REQ(s1, c + 7); DN_SBAR();
            DN_PUT(DNX_BUF1, s2); DN_REQ(s2, c + 8); DN_SBAR();
            DN_PUT(DNX_BUF0, s0); DN_REQ(s0, c + 9); DN_SBAR();
        }
        DN_PUT(DNX_BUF1, s1); DN_SBAR();
        DN_PUT(DNX_BUF0, s2); DN_SBAR();
        DN_PUT(DNX_BUF1, s0); DN_SBAR();
        DN_SBAR();
#undef DN_REQ
#undef DN_PUT
#undef DN_SBAR
    } else {
        const int sl = half * 4 + w;
        float* ob = P.oraw + ((size_t)b * SEQ + 4 * q4) * 512 + h * 128 + 16 * sl + n;
        const unsigned uoff = (unsigned)(DNC_U + ((sl * 4) * 64 + lane) * 16);
        f32x4 S[8]; bf16x8 Sb[4];
#pragma unroll
        for (int T = 0; T < 8; ++T) S[T] = (f32x4){0.f, 0.f, 0.f, 0.f};
#pragma unroll
        for (int k = 0; k < 4; ++k) Sb[k] = __builtin_bit_cast(bf16x8, (v4u){0u, 0u, 0u, 0u});
        f32x4 U0[4], U1[4]; float eg0, eg1;
#pragma unroll
        for (int it = 0; it < 4; ++it) { U0[it] = *(const GAS f32x4*)(cb0 + uoff + it * 1024); U1[it] = *(const GAS f32x4*)(cb0 + DNC_STRIDE + uoff + it * 1024); }
        eg0 = 0.f; eg1 = 0.f;
        LAS float* egl = (LAS float*)(F.lds + DNX_RED + 1024);
        if (w == 0) egl[lane] = *(const GAS float*)(cb0 + (size_t)lane * DNC_STRIDE + DNC_EGL);
        asm volatile("s_waitcnt vmcnt(0) lgkmcnt(0)" ::: "memory");
        __syncthreads();
#define DN_STEP(c_, BUFOFF, U_, eg_) do { \
        const LAS unsigned char* buf = F.lds + (BUFOFF); \
        bf16x8 fa[16], fb[16]; f32x4 ws[4], o[4]; \
        _Pragma("unroll") for (int t = 0; t < 16; ++t) fa[t] = *(const LAS bf16x8*)(buf + DNC_W + (t * 64 + lane) * 16); \
        _Pragma("unroll") for (int t = 0; t < 16; ++t) fb[t] = *(const LAS bf16x8*)(buf + DNC_QD + (t * 64 + lane) * 16); \
        asm volatile("" ::: "memory"); \
        _Pragma("unroll") for (int it = 0; it < 4; ++it) { ws[it] = (f32x4){0.f, 0.f, 0.f, 0.f}; o[it] = (f32x4){0.f, 0.f, 0.f, 0.f}; } \
        _Pragma("unroll") for (int ks = 0; ks < 4; ++ks) _Pragma("unroll") for (int it = 0; it < 4; ++it) ws[it] = __builtin_amdgcn_mfma_f32_16x16x32_bf16(fa[it * 4 + ks], Sb[ks], ws[it], 0, 0, 0); \
        _Pragma("unroll") for (int t = 0; t < 16; ++t) fa[t] = *(const LAS bf16x8*)(buf + DNC_KD + (t * 64 + lane) * 16); \
        asm volatile("" ::: "memory"); \
        _Pragma("unroll") for (int ks = 0; ks < 4; ++ks) _Pragma("unroll") for (int it = 0; it < 4; ++it) o[it] = __builtin_amdgcn_mfma_f32_16x16x32_bf16(fb[it * 4 + ks], Sb[ks], o[it], 0, 0, 0); \
        bf16x8 vb[2]; vb[0] = pack8(U_[0] - ws[0], U_[1] - ws[1]); vb[1] = pack8(U_[2] - ws[2], U_[3] - ws[3]); \
        _Pragma("unroll") for (int t = 0; t < 8; ++t) if (32 * (t & 1) <= 16 * (t >> 1) + 15) fb[t] = *(const LAS bf16x8*)(buf + DNC_AT + (t * 64 + lane) * 16); \
        asm volatile("" ::: "memory"); \
        eg_ = egl[c_]; \
        _Pragma("unroll") for (int T = 0; T < 8; ++T) S[T] = S[T] * eg_; \
        _Pragma("unroll") for (int k2 = 0; k2 < 2; ++k2) _Pragma("unroll") for (int T = 0; T < 8; ++T) S[T] = __builtin_amdgcn_mfma_f32_16x16x32_bf16(fa[T * 2 + k2], vb[k2], S[T], 0, 0, 0); \
        _Pragma("unroll") for (int k2 = 0; k2 < 2; ++k2) _Pragma("unroll") for (int it = 0; it < 4; ++it) if (32 * k2 <= 16 * it + 15) o[it] = __builtin_amdgcn_mfma_f32_16x16x32_bf16(fb[it * 2 + k2], vb[k2], o[it], 0, 0, 0); \
        _Pragma("unroll") for (int k = 0; k < 4; ++k) Sb[k] = pack8(S[2 * k], S[2 * k + 1]); \
        { float* op = ob + (size_t)(c_) * (64 * 512); \
          _Pragma("unroll") for (int it = 0; it < 4; ++it) _Pragma("unroll") for (int r = 0; r < 4; ++r) op[(16 * it + r) * 512] = o[it][r]; } \
        { const unsigned char* src = cb0 + (size_t)((c_) + 2 < 64 ? (c_) + 2 : 63) * DNC_STRIDE; \
          _Pragma("unroll") for (int it = 0; it < 4; ++it) U_[it] = *(const GAS f32x4*)(src + uoff + it * 1024); \
          } \
        asm volatile("s_waitcnt lgkmcnt(0)" ::: "memory"); __builtin_amdgcn_s_barrier(); asm volatile("" ::: "memory"); } while (0)
#pragma unroll 1
        for (int c = 0; c < 64; c += 2) {
            DN_STEP(c, DNX_BUF0, U0, eg0);
            DN_STEP(c + 1, DNX_BUF1, U1, eg1);
        }
#undef DN_STEP
    }
    asm volatile("s_waitcnt vmcnt(0)" ::: "memory");
    __syncthreads();
}
constexpr int DNU_BUF0 = 0, DNU_BUF1 = DNC_OPS + 16384, DNU_EG = 2 * (DNC_OPS + 16384);
static_assert(DNU_EG + 256 <= MISC_OFF, "deltanet chain LDS (U staged)");
__device__ __forceinline__ void dn_chain_u(Frame& F, const MixP& P, const unsigned char* dnc, int unit) {
    PHASE_TID();
    const int bh = unit >> 1, half = unit & 1, b = bh >> 2, h = bh & 3, w = F.wave, n = lane & 15, q4 = lane >> 4;
    const unsigned char* cb0 = dnc + (size_t)(bh * 64) * DNC_STRIDE;
    __syncthreads();
    if (w >= 4) {
        const unsigned so = (unsigned)((tid - 256) * 16);
        v4u s0[18], s1[18], s2[18];
        const __amdgpu_buffer_rsrc_t rs = __builtin_amdgcn_make_buffer_rsrc((void*)cb0, (short)0, 0x7ffffff0, 0x00020000);
        const unsigned uo = (unsigned)(DNC_U + half * 16384 - 14 * 4096);
#define DN_REQ(dst, chunk_) do { const unsigned cbase_ = (unsigned)((chunk_) < 64 ? (chunk_) : 63) * (unsigned)DNC_STRIDE;         \
        _Pragma("unroll") for (int r = 0; r < 14; ++r) dst[r] = __builtin_bit_cast(v4u, __builtin_amdgcn_raw_buffer_load_b128(rs, so, cbase_ + r * 4096, 0)); \
        _Pragma("unroll") for (int r = 14; r < 18; ++r) dst[r] = __builtin_bit_cast(v4u, __builtin_amdgcn_raw_buffer_load_b128(rs, so, cbase_ + uo + r * 4096, 0)); } while (0)
#define DN_PUT(bufoff, srcv) do { _Pragma("unroll") for (int r = 0; r < 18; ++r) *(LAS v4u*)(F.lds + (bufoff) + so + r * 4096) = srcv[r]; } while (0)
#define DN_SBAR() do { asm volatile("s_waitcnt lgkmcnt(0)" ::: "memory"); __builtin_amdgcn_s_barrier(); asm volatile("" ::: "memory"); } while (0)
        DN_REQ(s0, 0); DN_REQ(s1, 1); DN_REQ(s2, 2);
        DN_PUT(DNU_BUF0, s0); DN_REQ(s0, 3);
        __syncthreads();
#pragma unroll 1
        for (int c = 0; c < 60; c += 6) {
            DN_PUT(DNU_BUF1, s1); DN_REQ(s1, c + 4); DN_SBAR();
            DN_PUT(DNU_BUF0, s2); DN_REQ(s2, c + 5); DN_SBAR();
            DN_PUT(DNU_BUF1, s0); DN_REQ(s0, c + 6); DN_SBAR();
            DN_PUT(DNU_BUF0, s1); DN_REQ(s1, c + 7); DN_SBAR();
            DN_PUT(DNU_BUF1, s2); DN_REQ(s2, c + 8); DN_SBAR();
            DN_PUT(DNU_BUF0, s0); DN_REQ(s0, c + 9); DN_SBAR();
        }
        DN_PUT(DNU_BUF1, s1); DN_SBAR();
        DN_PUT(DNU_BUF0, s2); DN_SBAR();
        DN_PUT(DNU_BUF1, s0); DN_SBAR();
        DN_SBAR();
#undef DN_REQ
#undef DN_PUT
#undef DN_SBAR
    } else {
        const int sl = half * 4 + w;
        float* ob = P.oraw + ((size_t)b * SEQ + 4 * q4) * 512 + h * 128 + 16 * sl + n;
        f32x4 S[8]; bf16x8 Sb[4];
#pragma unroll
        for (int T = 0; T < 8; ++T) S[T] = (f32x4){0.f, 0.f, 0.f, 0.f};
#pragma unroll
        for (int k = 0; k < 4; ++k) Sb[k] = __builtin_bit_cast(bf16x8, (v4u){0u, 0u, 0u, 0u});
        LAS float* egl = (LAS float*)(F.lds + DNU_EG);
        if (w == 0) egl[lane] = *(const GAS float*)(cb0 + (size_t)lane * DNC_STRIDE + DNC_EGL);
        asm volatile("s_waitcnt vmcnt(0) lgkmcnt(0)" ::: "memory");
        __syncthreads();
#define DN_STEP(c_, BUFOFF) do { \
        const LAS unsigned char* buf = F.lds + (BUFOFF); \
        bf16x8 fa[16], fb[16]; f32x4 ws[4], o[4]; \
        _Pragma("unroll") for (int t = 0; t < 16; ++t) fa[t] = *(const LAS bf16x8*)(buf + DNC_W + (t * 64 + lane) * 16); \
        _Pragma("unroll") for (int t = 0; t < 16; ++t) fb[t] = *(const LAS bf16x8*)(buf + DNC_QD + (t * 64 + lane) * 16); \
        _Pragma("unroll") for (int it = 0; it < 4; ++it) ws[it] = *(const LAS f32x4*)(buf + DNC_OPS + ((w * 4 + it) * 64 + lane) * 16);        \
        const float eg_ = egl[c_]; \
        asm volatile("" ::: "memory"); \
        _Pragma("unroll") for (int it = 0; it < 4; ++it) { ws[it] = -ws[it]; o[it] = (f32x4){0.f, 0.f, 0.f, 0.f}; } \
        _Pragma("unroll") for (int ks = 0; ks < 4; ++ks) _Pragma("unroll") for (int it = 0; it < 4; ++it) ws[it] = __builtin_amdgcn_mfma_f32_16x16x32_bf16(fa[it * 4 + ks], Sb[ks], ws[it], 0, 0, 0); \
        _Pragma("unroll") for (int t = 0; t < 16; ++t) fa[t] = *(const LAS bf16x8*)(buf + DNC_KD + (t * 64 + lane) * 16); \
        asm volatile("" ::: "memory"); \
        _Pragma("unroll") for (int ks = 0; ks < 4; ++ks) _Pragma("unroll") for (int it = 0; it < 4; ++it) o[it] = __builtin_amdgcn_mfma_f32_16x16x32_bf16(fb[it * 4 + ks], Sb[ks], o[it], 0, 0, 0); \
        bf16x8 vb[2]; vb[0] = pack8(-ws[0], -ws[1]); vb[1] = pack8(-ws[2], -ws[3]); \
        _Pragma("unroll") for (int t = 0; t < 8; ++t) if (32 * (t & 1) <= 16 * (t >> 1) + 15) fb[t] = *(const LAS bf16x8*)(buf + DNC_AT + (t * 64 + lane) * 16); \
        asm volatile("" ::: "memory"); \
        _Pragma("unroll") for (int T = 0; T < 8; ++T) S[T] = S[T] * eg_; \
        _Pragma("unroll") for (int k2 = 0; k2 < 2; ++k2) _Pragma("unroll") for (int T = 0; T < 8; ++T) S[T] = __builtin_amdgcn_mfma_f32_16x16x32_bf16(fa[T * 2 + k2], vb[k2], S[T], 0, 0, 0); \
        _Pragma("unroll") for (int k2 = 0; k2 < 2; ++k2) _Pragma("unroll") for (int it = 0; it < 4; ++it) if (32 * k2 <= 16 * it + 15) o[it] = __builtin_amdgcn_mfma_f32_16x16x32_bf16(fb[it * 2 + k2], vb[k2], o[it], 0, 0, 0); \
        _Pragma("unroll") for (int k = 0; k < 4; ++k) Sb[k] = pack8(S[2 * k], S[2 * k + 1]); \
        { float* op = ob + (size_t)(c_) * (64 * 512); \
          _Pragma("unroll") for (int it = 0; it < 4; ++it) _Pragma("unroll") for (int r = 0; r < 4; ++r) op[(16 * it + r) * 512] = o[it][r]; } \
        asm volatile("s_waitcnt lgkmcnt(0)" ::: "memory"); __builtin_amdgcn_s_barrier(); asm volatile("" ::: "memory"); } while (0)
#pragma unroll 1
        for (int c = 0; c < 64; c += 2) {
            DN_STEP(c, DNU_BUF0);
            DN_STEP(c + 1, DNU_BUF1);
        }
#undef DN_STEP
    }
    asm volatile("s_waitcnt vmcnt(0)" ::: "memory");
    __syncthreads();
}
__device__ __forceinline__ void glu_unit(Frame& F, const bf16* ysb, const bf16* wt, const float* bias, bf16* mixed, int u) {
    PHASE_TID();
    const int rp = u >> 1, ch = u & 1, l15 = lane & 15, q = lane >> 4;
    const bf16* yrow = ysb + (size_t)(rp * 64 + l15) * 512 + 8 * q;
    const bf16* wrow = wt + (size_t)(ch * 256 + F.wave * 32 + l15) * 512 + 8 * q;
    f32x4 acc[2][4];
#pragma unroll
    for (int mt = 0; mt < 2; ++mt)
#pragma unroll
        for (int nt = 0; nt < 4; ++nt) acc[mt][nt] = (f32x4){0.f, 0.f, 0.f, 0.f};
    bf16x8 fa[2][2][4], fb[2][4][4];
#define GLU_LOAD(bu, kb) do { _Pragma("unroll") for (int ks = 0; ks < 4; ++ks) { \
        _Pragma("unroll") for (int mt = 0; mt < 2; ++mt) fa[bu][mt][ks] = *(const GAS bf16x8*)(wrow + mt * 16 * 512 + ((kb) * 4 + ks) * 32); \
        _Pragma("unroll") for (int nt = 0; nt < 4; ++nt) fb[bu][nt][ks] = *(const GAS bf16x8*)(yrow + nt * 16 * 512 + ((kb) * 4 + ks) * 32); } } while (0)
#define GLU_MMA(bu) do { _Pragma("unroll") for (int ks = 0; ks < 4; ++ks) _Pragma("unroll") for (int mt = 0; mt < 2; ++mt) _Pragma("unroll") for (int nt = 0; nt < 4; ++nt) \
        acc[mt][nt] = __builtin_amdgcn_mfma_f32_16x16x32_bf16(fa[bu][mt][ks], fb[bu][nt][ks], acc[mt][nt], 0, 0, 0); } while (0)
    GLU_LOAD(0, 0);
    GLU_LOAD(1, 1); asm volatile("" ::: "memory"); GLU_MMA(0);
    GLU_LOAD(0, 2); asm volatile("" ::: "memory"); GLU_MMA(1);
    GLU_LOAD(1, 3); asm volatile("" ::: "memory"); GLU_MMA(0);
    v2u yv[2][4]; f32x4 bb[2];
#pragma unroll
    for (int mt = 0; mt < 2; ++mt) { bb[mt] = *(const GAS f32x4*)(bias + ch * 256 + F.wave * 32 + mt * 16 + 4 * q);
#pragma unroll
        for (int nt = 0; nt < 4; ++nt) yv[mt][nt] = *(const GAS v2u*)(ysb + (size_t)(rp * 64 + nt * 16 + l15) * 512 + ch * 256 + F.wave * 32 + mt * 16 + 4 * q); }
    asm volatile("" ::: "memory");
    GLU_MMA(1);
#undef GLU_LOAD
#undef GLU_MMA
#pragma unroll
    for (int mt = 0; mt < 2; ++mt)
#pragma unroll
        for (int nt = 0; nt < 4; ++nt) { const v2u y = yv[mt][nt]; const f32x4 a = acc[mt][nt];
            const float o0 = bflo(y.x) * sigmoid_f(a[0] + bb[mt][0]), o1 = bfhi(y.x) * sigmoid_f(a[1] + bb[mt][1]), o2 = bflo(y.y) * sigmoid_f(a[2] + bb[mt][2]), o3 = bfhi(y.y) * sigmoid_f(a[3] + bb[mt][3]);
            v2u o; o.x = pk2(o0, o1); o.y = pk2(o2, o3);
            *(GAS v2u*)(mixed + (size_t)(rp * 64 + nt * 16 + l15) * MIXW + 1536 + ch * 256 + F.wave * 32 + mt * 16 + 4 * q) = o; }
}
__device__ __forceinline__ void dn_post_rows4(Frame& F, const MixP& P) {
    PHASE_TID();
    for (int t0 = F.gw; t0 < M; t0 += 4 * F.NGW) {
        float a[4][4], b2[4][4], z0[4][4], z1[4][4];
#pragma unroll
        for (int i = 0; i < 4; ++i) { const int t = (t0 + i * F.NGW < M) ? t0 + i * F.NGW : t0;
#pragma unroll
            for (int h = 0; h < 4; ++h) { a[i][h] = P.oraw[(size_t)t * 512 + h * 128 + lane]; b2[i][h] = P.oraw[(size_t)t * 512 + h * 128 + 64 + lane];
                z0[i][h] = bf2f(P.z[(size_t)t * ZW + Z_DZ + h * 128 + lane]); z1[i][h] = bf2f(P.z[(size_t)t * ZW + Z_DZ + h * 128 + 64 + lane]); } }
        const float w0 = P.dn_norm_w[lane], w1 = P.dn_norm_w[64 + lane];
#pragma unroll
        for (int i = 0; i < 4; ++i) { const int t = t0 + i * F.NGW; if (t < M) {
#pragma unroll
            for (int h = 0; h < 4; ++h) { const float r = 1.0f / sqrtf(wave_sum(a[i][h] * a[i][h] + b2[i][h] * b2[i][h]) * (1.f / 128.f) + NORM_EPS);
                P.mixed[(size_t)t * MIXW + 1024 + h * 128 + lane] = (bf16)f2bf(a[i][h] * r * w0 * z0[i][h] * sigmoid_f(z0[i][h]));
                P.mixed[(size_t)t * MIXW + 1024 + h * 128 + 64 + lane] = (bf16)f2bf(b2[i][h] * r * w1 * z1[i][h] * sigmoid_f(z1[i][h])); } } }
    }
}
constexpr int NPH = 12;
constexpr int NSTEPS = 1 + DEPTH * NPH;
struct Args { const float* in[30]; float* out; unsigned char* ws; int s_lo, s_hi; };
enum { I_X = 0, I_FF1_PRE, I_FF1_G, I_FF1_U, I_FF1_D, I_FF1_POST, I_MIX_PRE, I_WIN, I_SINKS, I_CONVW, I_ALOG, I_DTB, I_DNNW, I_S5ARE, I_S5AIM, I_S5LDT, I_S5BRE, I_S5BIM, I_S5CRE, I_S5CIM, I_S5D,
       I_GLUW, I_GLUB, I_WOUT, I_MIX_POST, I_FF2_PRE, I_FF2_G, I_FF2_U, I_FF2_D, I_FF2_POST };
typedef const __attribute__((address_space(4))) Args* CArgsP;
__device__ __forceinline__ CArgsP kargs() { CArgsP p = (CArgsP)__builtin_amdgcn_kernarg_segment_ptr(); asm volatile("" : "+s"(p)); return p; }
__device__ __forceinline__ MixP make_mixp(CArgsP A, unsigned char* ws, int l) {
    MixP P;
    P.sinks = A->in[I_SINKS] + l * 8; P.convw = A->in[I_CONVW] + l * 4 * 1536; P.a_log = A->in[I_ALOG] + l * 4; P.dt_bias = A->in[I_DTB] + l * 4; P.dn_norm_w = A->in[I_DNNW] + l * 128;
    P.s5_a_re = A->in[I_S5ARE] + l * 2048; P.s5_a_im = A->in[I_S5AIM] + l * 2048; P.s5_log_dt = A->in[I_S5LDT] + l * 32;
    P.s5_b_re = A->in[I_S5BRE] + l * 32768; P.s5_b_im = A->in[I_S5BIM] + l * 32768; P.s5_c_re = A->in[I_S5CRE] + l * 32768; P.s5_c_im = A->in[I_S5CIM] + l * 32768; P.s5_d = A->in[I_S5D] + l * 512;
    P.rope_cos = (float*)(ws + WS_ROPE); P.rope_sin = P.rope_cos + SEQ * 64; P.z = (bf16*)(ws + WS_Z); P.ab = (float*)(ws + WS_AB); P.bg = (float*)(ws + WS_BG); P.kr = (float*)(ws + WS_KR);
    P.qn = (float*)(ws + WS_QN); P.kn = (float*)(ws + WS_KN); P.vc = (float*)(ws + WS_VC); P.oraw = (float*)(ws + WS_ORAW); P.ys = (float*)(ws + WS_YS); P.ysb = (bf16*)(ws + WS_YSB); P.mixed = (bf16*)(ws + WS_MIXED);
    return P;
}
constexpr int CV_G1 = 0, CV_U1 = 5632, CV_D1 = 11264, CV_WA = 16896, CV_WB = 20480, CV_GL = 20992, CV_WO = 21120, CV_G2 = 23168, CV_U2 = 28800, CV_D2 = 34432, CV_END = 40064;
#ifndef CONV_ALL5
#define CONV_ALL5 0
#endif
constexpr int CV_TOTAL = DEPTH * CV_END, CV_PRO = CONV_ALL5 ? CV_G2 : CV_WA;
#ifndef GU_ALIGN
#define GU_ALIGN true
#endif
#ifndef GU_SP2
#define GU_SP2 true
#endif
__device__ __forceinline__ void convert_items_fs(Frame& F, CArgsP A, unsigned char* ws, int gbeg, int gend, int first, int nw) {
    PHASE_TID();
    LAS float* scr = (LAS float*)(F.lds + RING_OFF + F.wave * 16384);
    if (gend > CV_TOTAL) gend = CV_TOTAL;
    for (int gi = gbeg + first; gi < gend; gi += nw) {
        const int tl = gi / CV_END, it = gi - tl * CV_END; const LayerW w = layer_w(ws, tl);
        if (it < CV_U1)      transpose_item(A->in[I_FF1_G] + (size_t)tl * D * FF, D, FF, 0, FF, (bf16*)w.wgu1, 0, 1, scr, it - CV_G1, lane);
        else if (it < CV_D1) transpose_item(A->in[I_FF1_U] + (size_t)tl * D * FF, D, FF, 0, FF, (bf16*)w.wgu1, 128, 1, scr, it - CV_U1, lane);
        else if (it < CV_WA) transpose_item(A->in[I_FF1_D] + (size_t)tl * FF * D, FF, D, 0, D, (bf16*)w.wd1, 0, 0, scr, it - CV_D1, lane);
        else if (it < CV_WB) transpose_item(A->in[I_WIN] + (size_t)tl * D * INW, D, INW, 0, SRC_AB, (bf16*)w.win, 0, 0, scr, it - CV_WA, lane);
        else if (it < CV_GL) transpose_item(A->in[I_WIN] + (size_t)tl * D * INW, D, INW, SRC_S5, 512, (bf16*)w.win, Z_S5, 0, scr, it - CV_WB, lane);
        else if (it < CV_WO) transpose_item(A->in[I_GLUW] + (size_t)tl * 512 * 512, 512, 512, 0, 512, (bf16*)w.wglu, 0, 0, scr, it - CV_GL, lane);
        else if (it < CV_G2) transpose_item(A->in[I_WOUT] + (size_t)tl * MIXW * D, MIXW, D, 0, D, (bf16*)w.wout, 0, 0, scr, it - CV_WO, lane);
        else if (it < CV_U2) transpose_item(A->in[I_FF2_G] + (size_t)tl * D * FF, D, FF, 0, FF, (bf16*)w.wgu2, 0, 1, scr, it - CV_G2, lane);
        else if (it < CV_D2) transpose_item(A->in[I_FF2_U] + (size_t)tl * D * FF, D, FF, 0, FF, (bf16*)w.wgu2, 128, 1, scr, it - CV_U2, lane);
        else                 transpose_item(A->in[I_FF2_D] + (size_t)tl * FF * D, FF, D, 0, D, (bf16*)w.wd2, 0, 0, scr, it - CV_D2, lane);
    }
}
__device__ __forceinline__ void convert_items(Frame& F, CArgsP A, unsigned char* ws, int gbeg, int gend, int w0, int nw) { convert_items_fs(F, A, ws, gbeg, gend, F.gw - w0, nw); }
#ifndef CVS_A_N
#define CVS_A_N 8000
#endif
#ifndef CVS_C_N
#define CVS_C_N 8000
#endif
constexpr int CVS_A = CONV_ALL5 ? 0 : CVS_A_N, CVS_C = CONV_ALL5 ? 0 : CVS_C_N, CVS_B = CV_END - CVS_A - CVS_C;
static_assert(CVS_A + CVS_B + CVS_C == CV_END && CV_PRO + CVS_A >= CV_G2 - 0 + 0 - 1728 - 0 && CV_PRO + CVS_A >= CV_WO + 2048, "slot A covers w_in, glu_w, w_out of its layer");
static_assert(CV_PRO + CVS_A + CVS_B >= CV_END, "slot B covers the rest of its layer (FFN2 weights)");
#ifndef STAGGER_SLEEP
#define STAGGER_SLEEP 19
#endif
__device__ __forceinline__ void xcd_stagger() {
    const unsigned x = xb_xcc_id() & 7u;
    for (unsigned i = 0; i < x; ++i) __builtin_amdgcn_s_sleep(STAGGER_SLEEP);
}
#ifndef NO_FILLER
#define NO_FILLER 0
#endif
#ifndef FILLER_FIRST
#define FILLER_FIRST 0
#endif
#ifndef CONV_SPLIT
#define CONV_SPLIT 0
#endif
#ifndef WAIT_PROBE
#define WAIT_PROBE 0
#endif
#ifndef WAIT_MODE
#define WAIT_MODE 0
#endif
#ifndef WAIT_REGION
#define WAIT_REGION 0
#endif
#ifndef WAIT_SEL
#define WAIT_SEL 0
#endif
#ifndef WAIT_AMP
#define WAIT_AMP 1
#endif
#ifndef WAIT_PROBE_MAX
#define WAIT_PROBE_MAX 0
#endif
#ifndef WAIT_PROBE_MIN
#define WAIT_PROBE_MIN 0
#endif
#ifndef GLU_DIRECT
#define GLU_DIRECT 0
#endif
#ifndef CONV_NCW
#define CONV_NCW 0
#endif
#ifndef DN_USTAGE
#define DN_USTAGE 0
#endif
#if DN_USTAGE == 4
#define DN_CHAIN_FN dn_chain_q
#elif DN_USTAGE == 3
#define DN_CHAIN_FN dn_chain_e
#elif DN_USTAGE == 2
#define DN_CHAIN_FN dn_chain_p
#elif DN_USTAGE
#define DN_CHAIN_FN dn_chain_u
#else
#define DN_CHAIN_FN dn_chain
#endif
#ifndef STEP5_SPLIT
#define STEP5_SPLIT 0
#endif
#ifndef S5_IN5
#define S5_IN5 0
#endif
#ifndef S5_IN5_SPLIT
#define S5_IN5_SPLIT 18000
#endif
#ifndef NORM2ROW
#define NORM2ROW 0
#endif
#if NORM2ROW && Y_BF16
#define NORM_FN norm_phase2
#else
#define NORM_FN norm_phase
#endif
#ifndef PRO_SPLIT
#define PRO_SPLIT 0
#endif
#ifndef GLU_IN5
#define GLU_IN5 0
#endif
struct OneUnit { int pm, pn; __device__ bool next(int i, pg8::Unit& u) const { if (i) return false; u.pm = pm; u.pn = pn; return true; }
    __device__ __forceinline__ void a_ready(const pg8::Unit&) const {} __device__ __forceinline__ void done(const pg8::Unit&) const {} };
#ifndef GU_SPLIT
#define GU_SPLIT 0
#endif
struct RangeOrder : pg8::StaticOrder { int base, limit;
    __device__ bool next(int i, pg8::Unit& u) const { const long L = (long)i * G + c + base; if (L >= limit) return false;
        int wgid = (int)L; { const int q = nwg / pg8::NXCD, r = nwg % pg8::NXCD, xcd = wgid % pg8::NXCD, off = wgid / pg8::NXCD; wgid = (xcd < r ? xcd * (q + 1) : r * (q + 1) + (xcd - r) * q) + off; }
        const int nig = pg8::WGM * nN, gid = wgid / nig, fm = gid * pg8::WGM, gsz = (nM - fm) < pg8::WGM ? (nM - fm) : pg8::WGM;
        u.pm = fm + ((wgid % nig) % gsz); u.pn = (wgid % nig) / gsz; return true; } };
#define PHASE_BEGIN() Frame F; F.lds = (LAS unsigned char*)lds; { int bx_ = blockIdx.x, gx_ = gridDim.x, tw_ = threadIdx.x; asm volatile("" : "+s"(bx_), "+s"(gx_), "+v"(tw_)); \
        F.bid = bx_; F.G = gx_; F.wave = __builtin_amdgcn_readfirstlane(tw_ >> 6); F.gw = bx_ * NWAVES + F.wave; F.NGW = gx_ * NWAVES; } \
    const CArgsP A = kargs(); unsigned char* const ws = A->ws; (void)ws; \
    bf16* const Hb = (bf16*)(ws + WS_H); bf16* const ACT = (bf16*)(ws + WS_ACT); float* const Yb = (float*)(ws + WS_Y); bf16* const Zb = (bf16*)(ws + WS_Z); bf16* const MIXED = (bf16*)(ws + WS_MIXED); \
    float* const xout = A->out; (void)Hb; (void)ACT; (void)Yb; (void)Zb; (void)MIXED; (void)xout

__global__ void __launch_bounds__(NWAVES * 64, 2) mk_fwd(Args args) {
    extern __shared__ __attribute__((aligned(16))) unsigned char lds[];
    if (threadIdx.x < 128) ((LAS unsigned*)((LAS unsigned char*)lds + MISC_OFF))[threadIdx.x] = 0u;
    __syncthreads();
    XcdBarrier bar; bar.bar = (unsigned*)(kargs()->ws + WS_CTL) + CW_BAR; bar.x = 0; bar.st = nullptr; bar.expect = 0u;
    if (!MK_MULTI) bar = xcd_barrier_post((unsigned*)(kargs()->ws + WS_CTL) + CW_BAR, (volatile LAS unsigned*)((LAS unsigned char*)lds + MISC_OFF) + 8);
#if S5_IN5
    if (blockIdx.x >= 16) (void)xcd_barrier_post((unsigned*)(kargs()->ws + WS_CTL) + 8192, (volatile LAS unsigned*)((LAS unsigned char*)lds + MISC_OFF) + 12);
#endif
    const int lo = kargs()->s_lo, hi = kargs()->s_hi;
#define IN(s) (lo <= (s) && (s) < hi)
#if WAIT_PROBE
    unsigned long long wacc = 0, tprev_ = __builtin_amdgcn_s_memrealtime();
    __builtin_amdgcn_s_waitcnt(0xC07F);
#define SEAM(s) do { if (IN(s) && IN((s) + 1)) { const unsigned long long t0_ = __builtin_amdgcn_s_memrealtime(); __builtin_amdgcn_s_waitcnt(0xC07F); xcd_barrier(bar); const unsigned long long t1_ = __builtin_amdgcn_s_memrealtime(); __builtin_amdgcn_s_waitcnt(0xC07F); \
        const int kind_ = (s) == 0 ? 12 : ((s) - 1) % NPH; if ((WAIT_PROBE >> kind_) & 1) wacc += WAIT_MODE ? t1_ - tprev_ : t1_ - t0_; tprev_ = t1_; } } while (0)
#else
#define SEAM(s) do { if (!MK_MULTI) { if (IN(s) && IN((s) + 1)) xcd_barrier(bar); } } while (0)
#endif

    if (IN(0)) for (int rp_ = 0; rp_ < 1 + ((PROBE_DBL_MASK >> 12) & 1); ++rp_) {
        PHASE_BEGIN();
#if PRO_SPLIT
        const bool tabwg = F.bid >= F.G - 32;
        if (!tabwg) convert_items_fs(F, A, ws, 0, CV_PRO, F.gw, (F.G - 32) * NWAVES);
        else { const int tg = F.bid - (F.G - 32);
            s5_tables(F, A->in[I_S5ARE], A->in[I_S5AIM], A->in[I_S5LDT], A->in[I_S5BRE], A->in[I_S5BIM], A->in[I_S5CRE], A->in[I_S5CIM], ws + WS_S5T + (size_t)tg * S5T_STRIDE, tg); }
#else
        convert_items(F, A, ws, 0, NO_FILLER ? CV_TOTAL : CV_PRO, 0, F.NGW);
        for (int c = F.bid; c < DEPTH * 32; c += F.G) { const int tl = c >> 5, tg = c & 31;
            s5_tables(F, A->in[I_S5ARE] + tl * 2048, A->in[I_S5AIM] + tl * 2048, A->in[I_S5LDT] + tl * 32, A->in[I_S5BRE] + tl * 32768, A->in[I_S5BIM] + tl * 32768, A->in[I_S5CRE] + tl * 32768, A->in[I_S5CIM] + tl * 32768,
                      ws + WS_S5T + (size_t)c * S5T_STRIDE, tg); }
#endif
        { PHASE_TID(); float* rope_cos = (float*)(ws + WS_ROPE); float* rope_sin = rope_cos + SEQ * 64;
          for (int i = F.bid * (NWAVES * 64) + tid; i < SEQ * 64; i += F.G * NWAVES * 64) {
            const int pos = i >> 6, d = i & 63;
            const float invf = exp2f(-(float)d * (13.287712379549449f / 64.0f));
            const float ang = (float)pos * invf;
            double t = (double)ang * 0.15915494309189535; t -= __builtin_rint(t);
            float s, c; sincos_rev(t, s, c); rope_cos[i] = c; rope_sin[i] = s;
          } }
#if PRO_SPLIT
        if (!tabwg) { PHASE_TID(); const int st = (F.G - 32) * NWAVES;
            for (int m0 = F.gw; m0 < M; m0 += 2 * st) { const bool two = m0 + st < M; const int m1 = two ? m0 + st : m0;
                const float* xin = A->in[I_X]; const float* gain = A->in[I_FF1_PRE]; f32x4 v[2][8]; float rstd[2];
#pragma unroll
                for (int r = 0; r < 2; ++r) { const GAS f32x4* xr = (const GAS f32x4*)(xin + (size_t)(r ? m1 : m0) * D) + lane;
#pragma unroll
                    for (int j = 0; j < 8; ++j) v[r][j] = xr[64 * j]; }
#pragma unroll
                for (int r = 0; r < 2; ++r) { float s = 0.f;
#pragma unroll
                    for (int j = 0; j < 8; ++j) s += (v[r][j].x * v[r][j].x + v[r][j].y * v[r][j].y) + (v[r][j].z * v[r][j].z + v[r][j].w * v[r][j].w);
                    rstd[r] = 1.0f / sqrtf(wave_sum(s) * (1.f / D) + NORM_EPS); }
                const GAS f32x4* gr = (const GAS f32x4*)gain + lane;
#pragma unroll
                for (int j = 0; j < 8; ++j) { const f32x4 g = gr[64 * j];
#pragma unroll
                    for (int r = 0; r < 2; ++r) { v2u o; o.x = pk2(v[r][j].x * rstd[r] * g.x, v[r][j].y * rstd[r] * g.y); o.y = pk2(v[r][j].z * rstd[r] * g.z, v[r][j].w * rstd[r] * g.w);
                        if (r == 0 || two) ((GAS v2u*)(Hb + (size_t)(r ? m1 : m0) * D) + lane)[64 * j] = o; } } } }
#else
        { PHASE_TID(); for (int m = F.gw; m < M; m += F.NGW) rms_row_to_bf16(lane, A->in[I_X] + (size_t)m * D, A->in[I_FF1_PRE], Hb + (size_t)m * D); }
#endif
    }
    SEAM(0);

#pragma unroll 1
    for (int l = 0; l < DEPTH; ++l) {
        const int sb = 1 + l * NPH;
        if (IN(sb + 0)) for (int rp_ = 0; rp_ < 1 + ((PROBE_DBL_MASK >> 0) & 1); ++rp_) { PHASE_BEGIN(); const LayerW w = layer_w(ws, l); pg8::Gemm g{Hb, w.wgu1, M, 2 * FF, D}; pg8::EpiSwiGLU E{ACT, FF};
#if GU_SPLIT
            { RangeOrder S; S.init(M, 2 * FF, F.G, F.bid); S.base = 0; S.limit = 704; pg8::gemm_phase<pg8::EpiSwiGLU, RangeOrder, GU_ALIGN, GU_SP2>(F.lds + RING_OFF, g, S, E); }
            xcd_barrier(bar);
            { RangeOrder S; S.init(M, 2 * FF, F.G, F.bid); S.base = 704; S.limit = 1408; pg8::gemm_phase<pg8::EpiSwiGLU, RangeOrder, GU_ALIGN, GU_SP2>(F.lds + RING_OFF, g, S, E); }
#else
#if FILLER_FIRST
            if (!NO_FILLER && F.bid >= 128) { convert_items(F, A, ws, l * CV_END + CV_PRO, l * CV_END + CV_PRO + CVS_A, 128 * NWAVES, (F.G - 128) * NWAVES); __syncthreads(); }
#endif
            pg8::StaticOrder S; S.init(M, 2 * FF, F.G, F.bid);
            pg8::gemm_phase<pg8::EpiSwiGLU, pg8::StaticOrder, GU_ALIGN, GU_SP2>(F.lds + RING_OFF, g, S, E);
#endif
            if (!FILLER_FIRST && !NO_FILLER && F.bid >= 128) convert_items(F, A, ws, l * CV_END + CV_PRO, l * CV_END + CV_PRO + CVS_A, 128 * NWAVES, (F.G - 128) * NWAVES); }
        SEAM(sb + 0);
        if (IN(sb + 1)) for (int rp_ = 0; rp_ < 1 + ((PROBE_DBL_MASK >> 1) & 1); ++rp_) { PHASE_BEGIN(); const LayerW w = layer_w(ws, l); pg8::Gemm g{ACT, w.wd1, M, D, FF}; pg8::StaticOrder S; S.init(M, D, F.G, F.bid);
#if FUSED_NORM
            pg8::EpiRmsRes E{l == 0 ? A->in[I_X] : xout, xout, Hb, A->in[I_FF1_POST] + l * D, A->in[I_MIX_PRE] + l * D, 0.5f, (unsigned long long*)(ws + WS_XS), (unsigned*)(ws + WS_CTL) + CW_CNT, 64u * (unsigned)(3 * l + 1), (unsigned*)(ws + WS_CTL) + CW_TMO};
            pg8::gemm_phase<pg8::EpiRmsRes, pg8::StaticOrder, false, true>(F.lds + RING_OFF, g, S, E); }
#else
#if Y_BF16
            pg8::EpiBf16P E{(bf16*)Yb, D};
            pg8::gemm_phase<pg8::EpiBf16P, pg8::StaticOrder, true, true>(F.lds + RING_OFF, g, S, E); }
#else
            pg8::EpiF32 E{Yb, D};
            pg8::gemm_phase<pg8::EpiF32, pg8::StaticOrder, true, true>(F.lds + RING_OFF, g, S, E); }
#endif
#endif
        SEAM(sb + 1);
#if !FUSED_NORM
        if (IN(sb + 2)) { PHASE_BEGIN(); norm_phase<true, true>(F, Yb, l == 0 ? A->in[I_X] : xout, xout, A->in[I_FF1_POST] + l * D, 0.5f, A->in[I_MIX_PRE] + l * D, Hb, A->in[I_WIN] + (size_t)l * D * INW, (float*)(ws + WS_AB));
            if ((PROBE_DBL_MASK >> 18) & 1) norm_phase<true, true>(F, Yb, xout, (float*)ACT, A->in[I_FF1_POST] + l * D, 0.5f, A->in[I_MIX_PRE] + l * D, Zb, A->in[I_WIN] + (size_t)l * D * INW, (float*)(ws + WS_BG)); }
        SEAM(sb + 2);
#endif
        if (IN(sb + 3)) for (int rp_ = 0; rp_ < 1 + ((PROBE_DBL_MASK >> 3) & 1); ++rp_) { PHASE_BEGIN(); const LayerW w = layer_w(ws, l); pg8::Gemm g{Hb, w.win, M, ZW, D}; pg8::StaticOrder S; S.init(M, ZW, F.G, F.bid); pg8::EpiBf16P E{Zb, ZW};
            pg8::gemm_phase<pg8::EpiBf16P, pg8::StaticOrder, true, true>(F.lds + RING_OFF, g, S, E);
#if FUSED_NORM
            ab_rows_phase(F, xout, A->in[I_MIX_PRE] + l * D, A->in[I_WIN] + (size_t)l * D * INW, (float*)(ws + WS_AB));
#endif
            }
        SEAM(sb + 3);
        if (IN(sb + 4)) for (int rp_ = 0; rp_ < 1 + ((PROBE_DBL_MASK >> 4) & 1); ++rp_) { PHASE_BEGIN(); const MixP P = make_mixp(A, ws, l);
#if FAST_S5 && !S5_IN5
            if (F.bid < S5_UNITS) for (int r2_ = 0; r2_ < 1 + ((PROBE_DBL_MASK >> 17) & 1); ++r2_) s5_unit<false>(F, P, ws + WS_S5T + (size_t)l * 32 * S5T_STRIDE, (float*)(ws + WS_S5E), F.bid);
#endif
#if FAST_DN
            for (int r2_ = 0; r2_ < 1 + ((PROBE_DBL_MASK >> 16) & 1); ++r2_) for (int u = F.bid; u < 512; u += F.G) dn_chunk_unit(F, P, ws + WS_DNC, u);
#else
            prep_phase(F, P);
#endif
            }
        SEAM(sb + 4);
        if (IN(sb + 5)) for (int rp_ = 0; rp_ < 1 + ((PROBE_DBL_MASK >> 5) & 1); ++rp_) {
            PHASE_BEGIN(); const MixP P = make_mixp(A, ws, l); const int bid = F.bid;
#if FAST_DN
#if WAIT_PROBE && WAIT_REGION == 3
            if (bid < 16) { const unsigned long long ra_ = __builtin_amdgcn_s_memrealtime(); __builtin_amdgcn_s_waitcnt(0xC07F); DN_CHAIN_FN(F, P, ws + WS_DNC, bid);
                const unsigned long long rb_ = __builtin_amdgcn_s_memrealtime(); __builtin_amdgcn_s_waitcnt(0xC07F); wacc += rb_ - ra_; }
#elif WAIT_PROBE && WAIT_REGION == 4
            if (bid < 16) { const unsigned long long ra_ = __builtin_amdgcn_s_memtime(); __builtin_amdgcn_s_waitcnt(0xC07F); DN_CHAIN_FN(F, P, ws + WS_DNC, bid);
                const unsigned long long rb_ = __builtin_amdgcn_s_memtime(); __builtin_amdgcn_s_waitcnt(0xC07F); wacc += (rb_ - ra_) >> 3; }
#else
            if (bid < 16) { for (int r2_ = 0; r2_ < 1 + ((PROBE_DBL_MASK >> 13) & 1); ++r2_) DN_CHAIN_FN(F, P, ws + WS_DNC, bid); }
#endif
#if STEP5_SPLIT
            xcd_barrier(bar);
            if (bid < 16) { }
#endif
#else
            if (bid < 8) slow_deltanet(F, P, bid);
#endif
#if FAST_S5 && S5_IN5
            else { const int rel = bid - 16; const unsigned char* tabs = ws + WS_S5T + (size_t)l * 32 * S5T_STRIDE;
                if (rel >= S5_UNITS) s5_unit<false>(F, P, tabs, (float*)(ws + WS_S5E), rel - S5_UNITS);
                else if (rel < 16) s5_unit<false>(F, P, tabs, (float*)(ws + WS_S5E), 112 + rel);
                else { attn_unit(F, P, 2 * (rel - 16)); attn_unit(F, P, 2 * (rel - 16) + 1); }
                { XcdBarrier barP; barP.bar = (unsigned*)(ws + WS_CTL) + 8192; barP.x = xb_xcc_id(); barP.st = (volatile LAS unsigned*)(F.lds + MISC_OFF) + 12; barP.expect = (unsigned)F.G - 16u;
                  xcd_barrier(barP); }
                if (rel < S5_UNITS) { s5_unit<true>(F, P, tabs, (float*)(ws + WS_S5E), rel); if (rel < 16) { attn_unit(F, P, 224 + 2 * rel); attn_unit(F, P, 224 + 2 * rel + 1); } }
#if PRO_SPLIT
                if (l + 1 < DEPTH && bid >= F.G - 32) { const int tl = l + 1, tg = bid - (F.G - 32);
                    s5_tables(F, A->in[I_S5ARE] + tl * 2048, A->in[I_S5AIM] + tl * 2048, A->in[I_S5LDT] + tl * 32, A->in[I_S5BRE] + tl * 32768, A->in[I_S5BIM] + tl * 32768, A->in[I_S5CRE] + tl * 32768, A->in[I_S5CIM] + tl * 32768,
                              ws + WS_S5T + (size_t)(tl * 32 + tg) * S5T_STRIDE, tg); }
#endif
                if (!NO_FILLER) { const int g0 = l * CV_END + CV_PRO + CVS_A;
#pragma unroll 1
                    for (int ps = (rel >= S5_UNITS ? 0 : 1); ps < 2; ++ps)
                        convert_items(F, A, ws, ps == 0 ? g0 : g0 + S5_IN5_SPLIT, ps == 0 ? g0 + S5_IN5_SPLIT : g0 + CVS_B, (ps == 0 ? 144 : 16) * NWAVES, (F.G - (ps == 0 ? 144 : 16)) * NWAVES); } }
#elif FAST_S5
            else { for (int u = bid - 16; u < S5_UNITS + ATT_UNITS; u += F.G - 16) { if (u < S5_UNITS) { for (int r2_ = 0; r2_ < 1 + ((PROBE_DBL_MASK >> 14) & 1); ++r2_) s5_unit<true>(F, P, ws + WS_S5T + (size_t)l * 32 * S5T_STRIDE, (float*)(ws + WS_S5E), u);
#if GLU_IN5
                    asm volatile("s_waitcnt vmcnt(0)" ::: "memory"); __syncthreads();
                    if (threadIdx.x == 0) { __builtin_amdgcn_fence(__ATOMIC_RELEASE, "agent"); asm volatile("s_waitcnt vmcnt(0)" ::: "memory"); (void)xb_add((unsigned*)(ws + WS_CTL) + 12288 + l * 64, 1u); }
#endif
                    }
                else { for (int r2_ = 0; r2_ < 1 + ((PROBE_DBL_MASK >> 15) & 1); ++r2_) attn_unit(F, P, u - S5_UNITS); } }
#if PRO_SPLIT
                if (l + 1 < DEPTH && bid >= F.G - 32) { const int tl = l + 1, tg = bid - (F.G - 32);
                    s5_tables(F, A->in[I_S5ARE] + tl * 2048, A->in[I_S5AIM] + tl * 2048, A->in[I_S5LDT] + tl * 32, A->in[I_S5BRE] + tl * 32768, A->in[I_S5BIM] + tl * 32768, A->in[I_S5CRE] + tl * 32768, A->in[I_S5CIM] + tl * 32768,
                              ws + WS_S5T + (size_t)(tl * 32 + tg) * S5T_STRIDE, tg); }
#endif
#if CONV_SPLIT > 0
                if (!NO_FILLER) {
                    const int g0 = l * CV_END + CV_PRO + CVS_A;
#pragma unroll 1
                    for (int ps = (bid >= 144 ? 0 : 1); ps < 2; ++ps)
                        convert_items(F, A, ws, ps == 0 ? g0 : g0 + CONV_SPLIT, ps == 0 ? g0 + CONV_SPLIT : g0 + CVS_B, (ps == 0 ? 144 : 16) * NWAVES, (F.G - (ps == 0 ? 144 : 16)) * NWAVES); } }
#elif CONV_NCW > 0
                if (!NO_FILLER) convert_items_fs(F, A, ws, l * CV_END + CV_PRO + CVS_A, l * CV_END + CV_PRO + CVS_A + CVS_B, F.wave < CONV_NCW ? (bid - 16) * CONV_NCW + F.wave : (1 << 29), (F.G - 16) * CONV_NCW); }
#else
                if (!NO_FILLER) convert_items(F, A, ws, l * CV_END + CV_PRO + CVS_A, l * CV_END + CV_PRO + CVS_A + CVS_B, 16 * NWAVES, (F.G - 16) * NWAVES);
#if GLU_IN5
                if (bid >= 144 && bid < 208) {
                    __syncthreads();
                    if (threadIdx.x == 0) { unsigned* cnt_ = (unsigned*)(ws + WS_CTL) + 12288 + l * 64; unsigned* bar_ = (unsigned*)(ws + WS_CTL) + CW_BAR;
                        XB_SPIN(xb_ld(cnt_) < (unsigned)S5_UNITS, bar_);
                        __builtin_amdgcn_fence(__ATOMIC_ACQUIRE, "agent"); asm volatile("s_waitcnt vmcnt(0)" ::: "memory"); }
                    __syncthreads();
                    const LayerW w = layer_w(ws, l); pg8::Gemm g{P.ysb, w.wglu, M, 512, 512}; OneUnit S; S.pm = (bid - 144) >> 1; S.pn = (bid - 144) & 1;
                    pg8::EpiGlu E{(const pg8::bf16_t*)P.ysb, 512, A->in[I_GLUB] + l * 512, (pg8::bf16_t*)MIXED, MIXW, 1536};
                    pg8::gemm_phase<pg8::EpiGlu, OneUnit, true, true>(F.lds + RING_OFF, g, S, E); }
#endif
                }
#endif
#else
            else if (bid < 16) slow_s5(F, P, (bid - 8) * NWAVES + F.wave);
            else { for (int u = bid - 16; u < ATT_UNITS; u += F.G - 16) attn_unit(F, P, u); }
#endif
        }
        SEAM(sb + 5);
#if GLU_IN5
        if (IN(sb + 6)) { PHASE_BEGIN(); const MixP P = make_mixp(A, ws, l); dn_post_rows4(F, P); }
#elif GLU_DIRECT
        if (IN(sb + 6)) for (int rp_ = 0; rp_ < 1 + ((PROBE_DBL_MASK >> 6) & 1); ++rp_) { PHASE_BEGIN(); const LayerW w = layer_w(ws, l); const MixP P = make_mixp(A, ws, l);
#if WAIT_PROBE && WAIT_REGION
            unsigned long long ra_ = __builtin_amdgcn_s_memrealtime(); __builtin_amdgcn_s_waitcnt(0xC07F);
#endif
            for (int u = F.bid; u < 256; u += F.G) glu_unit(F, P.ysb, (const bf16*)w.wglu, A->in[I_GLUB] + l * 512, MIXED, u);
#if WAIT_PROBE && WAIT_REGION
            { asm volatile("s_waitcnt vmcnt(0)" ::: "memory"); const unsigned long long rb_ = __builtin_amdgcn_s_memrealtime(); __builtin_amdgcn_s_waitcnt(0xC07F); if (WAIT_REGION == 1) wacc += rb_ - ra_; ra_ = rb_; }
#endif
            dn_post_rows4(F, P);
#if WAIT_PROBE && WAIT_REGION
            { asm volatile("s_waitcnt vmcnt(0)" ::: "memory"); const unsigned long long rb_ = __builtin_amdgcn_s_memrealtime(); __builtin_amdgcn_s_waitcnt(0xC07F); if (WAIT_REGION == 2) wacc += rb_ - ra_; }
#endif
            }
#else
        if (IN(sb + 6)) for (int rp_ = 0; rp_ < 1 + ((PROBE_DBL_MASK >> 6) & 1); ++rp_) { PHASE_BEGIN(); const LayerW w = layer_w(ws, l); const MixP P = make_mixp(A, ws, l); pg8::Gemm g{P.ysb, w.wglu, M, 512, 512}; pg8::StaticOrder S; S.init(M, 512, F.G, F.bid);
            #if GLU_BF16Y
            pg8::EpiGlu E{(const pg8::bf16_t*)P.ysb, 512, A->in[I_GLUB] + l * 512, (pg8::bf16_t*)MIXED, MIXW, 1536};
#else
            pg8::EpiGlu E{P.ys, 512, A->in[I_GLUB] + l * 512, MIXED, MIXW, 1536};
#endif
            pg8::gemm_phase<pg8::EpiGlu, pg8::StaticOrder, true, true>(F.lds + RING_OFF, g, S, E);
            dn_post_rows(F, P);
            }
#endif
        SEAM(sb + 6);
        if (IN(sb + 7)) for (int rp_ = 0; rp_ < 1 + ((PROBE_DBL_MASK >> 7) & 1); ++rp_) { PHASE_BEGIN(); const LayerW w = layer_w(ws, l); pg8::Gemm g{MIXED, w.wout, M, D, MIXW}; pg8::StaticOrder S; S.init(M, D, F.G, F.bid);
#if FUSED_NORM
            pg8::EpiRmsRes E{xout, xout, Hb, A->in[I_MIX_POST] + l * D, A->in[I_FF2_PRE] + l * D, 1.0f, (unsigned long long*)(ws + WS_XS), (unsigned*)(ws + WS_CTL) + CW_CNT, 64u * (unsigned)(3 * l + 2), (unsigned*)(ws + WS_CTL) + CW_TMO};
            pg8::gemm_phase<pg8::EpiRmsRes, pg8::StaticOrder, false, true>(F.lds + RING_OFF, g, S, E); }
#else
#if Y_BF16
            pg8::EpiBf16P E{(bf16*)Yb, D};
            pg8::gemm_phase<pg8::EpiBf16P, pg8::StaticOrder, true, true>(F.lds + RING_OFF, g, S, E); }
#else
            pg8::EpiF32 E{Yb, D};
            pg8::gemm_phase<pg8::EpiF32, pg8::StaticOrder, true, true>(F.lds + RING_OFF, g, S, E); }
#endif
#endif
        SEAM(sb + 7);
#if !FUSED_NORM
        if (IN(sb + 8)) { PHASE_BEGIN(); NORM_FN<true, false>(F, Yb, xout, xout, A->in[I_MIX_POST] + l * D, 1.0f, A->in[I_FF2_PRE] + l * D, Hb, nullptr, nullptr);
            if ((PROBE_DBL_MASK >> 18) & 1) NORM_FN<true, false>(F, Yb, xout, (float*)ACT, A->in[I_MIX_POST] + l * D, 1.0f, A->in[I_FF2_PRE] + l * D, Zb, nullptr, nullptr); }
        SEAM(sb + 8);
#endif
        if (IN(sb + 9)) for (int rp_ = 0; rp_ < 1 + ((PROBE_DBL_MASK >> 9) & 1); ++rp_) { PHASE_BEGIN(); const LayerW w = layer_w(ws, l); pg8::Gemm g{Hb, w.wgu2, M, 2 * FF, D}; pg8::EpiSwiGLU E{ACT, FF};
#if GU_SPLIT
            { RangeOrder S; S.init(M, 2 * FF, F.G, F.bid); S.base = 0; S.limit = 704; pg8::gemm_phase<pg8::EpiSwiGLU, RangeOrder, GU_ALIGN, GU_SP2>(F.lds + RING_OFF, g, S, E); }
            xcd_barrier(bar);
            { RangeOrder S; S.init(M, 2 * FF, F.G, F.bid); S.base = 704; S.limit = 1408; pg8::gemm_phase<pg8::EpiSwiGLU, RangeOrder, GU_ALIGN, GU_SP2>(F.lds + RING_OFF, g, S, E); }
#else
#if FILLER_FIRST
            if (!NO_FILLER && F.bid >= 128) { convert_items(F, A, ws, l * CV_END + CV_PRO + CVS_A + CVS_B, l * CV_END + CV_PRO + CVS_A + CVS_B + CVS_C, 128 * NWAVES, (F.G - 128) * NWAVES); __syncthreads(); }
#endif
            pg8::StaticOrder S; S.init(M, 2 * FF, F.G, F.bid);
            pg8::gemm_phase<pg8::EpiSwiGLU, pg8::StaticOrder, GU_ALIGN, GU_SP2>(F.lds + RING_OFF, g, S, E);
#endif
            if (!FILLER_FIRST && !NO_FILLER && F.bid >= 128) convert_items(F, A, ws, l * CV_END + CV_PRO + CVS_A + CVS_B, l * CV_END + CV_PRO + CVS_A + CVS_B + CVS_C, 128 * NWAVES, (F.G - 128) * NWAVES); }
        SEAM(sb + 9);
        if (IN(sb + 10)) for (int rp_ = 0; rp_ < 1 + ((PROBE_DBL_MASK >> 10) & 1); ++rp_) { PHASE_BEGIN(); const LayerW w = layer_w(ws, l); pg8::Gemm g{ACT, w.wd2, M, D, FF}; pg8::StaticOrder S; S.init(M, D, F.G, F.bid);
#if FUSED_NORM
            pg8::EpiRmsRes E{xout, xout, (l + 1 < DEPTH) ? Hb : (bf16*)nullptr, A->in[I_FF2_POST] + l * D, A->in[I_FF1_PRE] + (l + 1 < DEPTH ? l + 1 : l) * D, 0.5f, (unsigned long long*)(ws + WS_XS), (unsigned*)(ws + WS_CTL) + CW_CNT, 64u * (unsigned)(3 * l + 3), (unsigned*)(ws + WS_CTL) + CW_TMO};
            pg8::gemm_phase<pg8::EpiRmsRes, pg8::StaticOrder, false, true>(F.lds + RING_OFF, g, S, E); }
#else
#if Y_BF16
            pg8::EpiBf16P E{(bf16*)Yb, D};
            pg8::gemm_phase<pg8::EpiBf16P, pg8::StaticOrder, true, true>(F.lds + RING_OFF, g, S, E); }
#else
            pg8::EpiF32 E{Yb, D};
            pg8::gemm_phase<pg8::EpiF32, pg8::StaticOrder, true, true>(F.lds + RING_OFF, g, S, E); }
#endif
#endif
        SEAM(sb + 10);
#if !FUSED_NORM
        if (IN(sb + 11)) { PHASE_BEGIN();
            if (l + 1 < DEPTH) NORM_FN<true, false>(F, Yb, xout, xout, A->in[I_FF2_POST] + l * D, 0.5f, A->in[I_FF1_PRE] + (l + 1) * D, Hb, nullptr, nullptr);
            else NORM_FN<false, false>(F, Yb, xout, xout, A->in[I_FF2_POST] + l * D, 0.5f, nullptr, nullptr, nullptr, nullptr);
            if ((PROBE_DBL_MASK >> 18) & 1) NORM_FN<true, false>(F, Yb, xout, (float*)ACT, A->in[I_FF2_POST] + l * D, 0.5f, A->in[I_FF1_PRE] + l * D, Zb, nullptr, nullptr);
        }
        SEAM(sb + 11);
#endif
    }
#if WAIT_PROBE
    {
        unsigned* const pw = (unsigned*)(kargs()->ws + WS_CTL) + 64;
#if WAIT_PROBE_MAX
        if (threadIdx.x == 0) atomicMax(pw, (unsigned)wacc);
#elif WAIT_PROBE_MIN
        if (threadIdx.x == 0) atomicMax(pw, 0x7fffffffu - (unsigned)wacc);
#else
        { const int b_ = blockIdx.x; const bool sel_ = WAIT_SEL == 0 || (WAIT_SEL == 1 && b_ < 16) || (WAIT_SEL == 2 && b_ >= 16 && b_ < 144) || (WAIT_SEL == 3 && b_ >= 144);
          if (threadIdx.x == 0 && sel_) atomicAdd(pw, (unsigned)wacc); }
#endif
        xcd_barrier(bar);
        unsigned sum = __hip_atomic_load(pw, __ATOMIC_RELAXED, __HIP_MEMORY_SCOPE_AGENT);
#if WAIT_PROBE_MAX
        const unsigned long long dly = (unsigned long long)sum * WAIT_AMP;
#elif WAIT_PROBE_MIN
        const unsigned long long dly = (unsigned long long)(0x7fffffffu - sum) * WAIT_AMP;
#else
        const unsigned long long dly = (unsigned long long)(sum / (WAIT_SEL == 0 ? gridDim.x : WAIT_SEL == 1 ? 16u : WAIT_SEL == 2 ? 128u : 112u)) * WAIT_AMP;
#endif
        const unsigned long long t0 = __builtin_amdgcn_s_memrealtime(); __builtin_amdgcn_s_waitcnt(0xC07F);
        while (true) { const unsigned long long t1 = __builtin_amdgcn_s_memrealtime(); __builtin_amdgcn_s_waitcnt(0xC07F); if (t1 - t0 >= dly) break; __builtin_amdgcn_s_sleep(8); }
    }
#endif
#undef IN
#undef SEAM
}

extern "C" void kernel_launch(void* const* d_in, const int* in_sizes, int n_in, void* d_out, int out_size, void* d_ws, size_t ws_size, hipStream_t stream) {
    static int grid = 0;
    if (grid == 0) {
        if (n_in != 30 || in_sizes[0] != M * D || out_size != M * D || ws_size < WS_END) { fprintf(stderr, "kernel_launch: unexpected shapes (n_in %d, in0 %d, out %d, ws %zu need %zu)\n", n_in, n_in > 0 ? in_sizes[0] : -1, out_size, ws_size, (size_t)WS_END); grid = -1; return; }
        int dev = 0, cus = 0, per_cu = 0;
        if (hipGetDevice(&dev) != hipSuccess || hipDeviceGetAttribute(&cus, hipDeviceAttributeMultiprocessorCount, dev) != hipSuccess) { grid = -1; return; }
        if (hipFuncSetAttribute((const void*)mk_fwd, hipFuncAttributeMaxDynamicSharedMemorySize, LDS_BYTES) != hipSuccess) { fprintf(stderr, "kernel_launch: hipFuncSetAttribute failed\n"); grid = -1; return; }
        if (hipOccupancyMaxActiveBlocksPerMultiprocessor(&per_cu, (const void*)mk_fwd, NWAVES * 64, LDS_BYTES) != hipSuccess || per_cu < 1) fprintf(stderr, "kernel_launch: occupancy query says %d\n", per_cu);
        (void)hipGetLastError();
        grid = cus;
    }
    if (grid < 0) return;
    if (hipMemsetAsync((char*)d_ws + WS_CTL, 0, CTL_ZERO_BYTES, stream) != hipSuccess) return;
    Args a{};
    for (int i = 0; i < 30; ++i) a.in[i] = (const float*)d_in[i];
    a.out = (float*)d_out; a.ws = (unsigned char*)d_ws;
#if MK_MULTI
    for (int s = 0; s < NSTEPS; ++s) { a.s_lo = s; a.s_hi = s + 1; hipLaunchKernelGGL(mk_fwd, dim3(grid), dim3(NWAVES * 64), LDS_BYTES, stream, a); }
#else
    a.s_lo = 0; a.s_hi = NSTEPS;
    hipLaunchKernelGGL(mk_fwd, dim3(grid), dim3(NWAVES * 64), LDS_BYTES, stream, a);
#endif
}
```

```cpp
#define NORM2ROW 1
#define PRO_SPLIT 1
#define GLU_IN5 1
#include <hip/hip_runtime.h>
#include <cstdio>
#include <cstdint>
#ifndef EPI_WT
#define EPI_WT 0
#endif
#ifndef FILLER_FIRST
#define FILLER_FIRST 0
#endif
#ifndef CONV_SPLIT
#define CONV_SPLIT 6000
#endif
#ifndef GLU_BF16Y
#define GLU_BF16Y 1
#endif
#ifndef GLU_DIRECT
#define GLU_DIRECT 0
#endif
#ifndef Y_BF16
#define Y_BF16 1
#endif
#ifndef FUSED_NORM
#define FUSED_NORM 0
#endif
#ifndef PROBE_DBL_MASK
#define PROBE_DBL_MASK 0
#endif
#ifndef FAST_DN
#define FAST_DN 1
#endif
#ifndef FAST_S5
#define FAST_S5 1
#endif
#ifndef FAST_ATTN
#define FAST_ATTN 1
#endif
namespace pg8 {
#define PG8_LAS __attribute__((address_space(3)))
typedef unsigned short bf16_t;
typedef short bf16x8 __attribute__((ext_vector_type(8)));
typedef float f32x4 __attribute__((ext_vector_type(4)));
typedef unsigned u32x4 __attribute__((ext_vector_type(4)));
constexpr int BM = 256, BK = 64, HALF = 128, HTB = HALF * BK * 2  , STAGE_BYTES = 8 * HTB, NXCD = 8, WGM = 8;

__host__ __device__ __forceinline__ int lds_byte(int r, int c) { const int st = (r >> 4) * 2 + (c >> 5), rr = r & 15, cc = c & 31, ob = rr * 64 + cc * 2; return st * 1024 + (ob ^ (((ob >> 9) & 1) << 5)); }
__host__ __device__ __forceinline__ void stage_rc(int b, int& R, int& C) { const int st = b / 1024, sb = b % 1024, swz = sb ^ (((sb >> 9) & 1) << 5); R = (st >> 1) * 16 + swz / 64; C = (st & 1) * 32 + (swz % 64) / 2; }
__host__ __device__ __forceinline__ int perm32(int rho) { const int n = rho >> 4, i = rho & 15; return 8 * (i >> 2) + 4 * n + (i & 3); }

struct Unit { int pm, pn; };
struct Gemm { const bf16_t* A; const bf16_t* Bt; int M, N, K; };

struct StaticOrder {
    int nM, nN, nwg, G, c;
    __host__ __device__ void init(int M, int N, int G_, int c_) { nM = M / BM; nN = N / BM; nwg = nM * nN; G = G_; c = c_; }
    __host__ __device__ bool next(int i, Unit& u) const {
        const long L = (long)i * G + c; if (L >= nwg) return false;
        int wgid = (int)L; { const int q = nwg / NXCD, r = nwg % NXCD, xcd = wgid % NXCD, off = wgid / NXCD; wgid = (xcd < r ? xcd * (q + 1) : r * (q + 1) + (xcd - r) * q) + off; }
        const int nig = WGM * nN, gid = wgid / nig, fm = gid * WGM, gsz = (nM - fm) < WGM ? (nM - fm) : WGM;
        u.pm = fm + ((wgid % nig) % gsz); u.pn = (wgid % nig) / gsz; return true;
    }
    __device__ __forceinline__ void a_ready(const Unit&) const {}
    __device__ __forceinline__ void done(const Unit&) const {}
};
typedef float f32x2 __attribute__((ext_vector_type(2)));
typedef __bf16 pg8_bf16x2 __attribute__((ext_vector_type(2)));
__device__ __forceinline__ unsigned cvt_pk_bf16(float lo, float hi) { const f32x2 v = {lo, hi}; const pg8_bf16x2 b = __builtin_convertvector(v, pg8_bf16x2); return __builtin_bit_cast(unsigned, b); }
__device__ __forceinline__ float fast_sigmoid(float x) { return __builtin_amdgcn_rcpf(1.0f + __expf(-x)); }
__device__ __forceinline__ float silu_f(float x) { return x * fast_sigmoid(x); }
struct EpiF32 {
    static constexpr bool PERM = false, AFTER_DRAIN = false;
    float* C; int ldc;
    __device__ __forceinline__ void operator()(const f32x4 (&acc)[2][2][4][2], const Unit& u, int wr, int wc, int fr, int fq) const {
        const int row0 = u.pm * BM + wr * 64 + fr, col0 = u.pn * BM + wc * 32 + 4 * fq;
#pragma unroll
        for (int ai = 0; ai < 2; ++ai)
#pragma unroll
            for (int m = 0; m < 4; ++m) { float* rowp = C + (size_t)(row0 + ai * HALF + m * 16) * ldc + col0;
#pragma unroll
                for (int bj = 0; bj < 2; ++bj)
#pragma unroll
                    for (int n = 0; n < 2; ++n) *(f32x4*)(rowp + bj * HALF + n * 16) = acc[ai][bj][m][n]; }
    }
};
struct EpiBf16P {
    static constexpr bool PERM = true, AFTER_DRAIN = false;
    bf16_t* O; int ldc;
    __device__ __forceinline__ void operator()(const f32x4 (&acc)[2][2][4][2], const Unit& u, int wr, int wc, int fr, int fq) const {
#if EPI_WT
        const __amdgpu_buffer_rsrc_t rs = __builtin_amdgcn_make_buffer_rsrc((void*)O, (short)0, 0x7ffffff0, 0x00020000);
#endif
        const int row0 = u.pm * BM + wr * 64 + fr, col0 = u.pn * BM + wc * 32 + 8 * fq;
#pragma unroll
        for (int ai = 0; ai < 2; ++ai)
#pragma unroll
            for (int m = 0; m < 4; ++m) { bf16_t* rowp = O + (size_t)(row0 + ai * HALF + m * 16) * ldc + col0;
#pragma unroll
                for (int bj = 0; bj < 2; ++bj) { const f32x4 v0 = acc[ai][bj][m][0], v1 = acc[ai][bj][m][1];
                    u32x4 w; w.x = cvt_pk_bf16(v0[0], v0[1]); w.y = cvt_pk_bf16(v0[2], v0[3]); w.z = cvt_pk_bf16(v1[0], v1[1]); w.w = cvt_pk_bf16(v1[2], v1[3]);
#if EPI_WT
                    __builtin_amdgcn_raw_buffer_store_b128(w, rs, (int)((size_t)((rowp + bj * HALF) - O) * 2), 0, 16);
#else
                    *(u32x4*)(rowp + bj * HALF) = w;
#endif
                    } }
    }
};
struct EpiSwiGLU {
    static constexpr bool PERM = true, AFTER_DRAIN = false;
    bf16_t* O; int ldc;
    __device__ __forceinline__ void operator()(const f32x4 (&acc)[2][2][4][2], const Unit& u, int wr, int wc, int fr, int fq) const {
        const int row0 = u.pm * BM + wr * 64 + fr, col0 = u.pn * HALF + wc * 32 + 8 * fq;
#if EPI_WT
        const __amdgpu_buffer_rsrc_t rs = __builtin_amdgcn_make_buffer_rsrc((void*)O, (short)0, 0x7ffffff0, 0x00020000);
#endif
#pragma unroll
        for (int ai = 0; ai < 2; ++ai)
#pragma unroll
            for (int m = 0; m < 4; ++m) { bf16_t* rowp = O + (size_t)(row0 + ai * HALF + m * 16) * ldc + col0;
                const f32x4 g0 = acc[ai][0][m][0], g1 = acc[ai][0][m][1], u0 = acc[ai][1][m][0], u1 = acc[ai][1][m][1];
                f32x4 v0, v1;
#pragma unroll
                for (int j = 0; j < 4; ++j) { v0[j] = silu_f(g0[j]) * u0[j]; v1[j] = silu_f(g1[j]) * u1[j]; }
                u32x4 w; w.x = cvt_pk_bf16(v0[0], v0[1]); w.y = cvt_pk_bf16(v0[2], v0[3]); w.z = cvt_pk_bf16(v1[0], v1[1]); w.w = cvt_pk_bf16(v1[2], v1[3]);
#if EPI_WT
                __builtin_amdgcn_raw_buffer_store_b128(w, rs, (int)((size_t)(rowp - O) * 2), 0, 16);
#else
                *(u32x4*)rowp = w;
#endif
                }
    }
};
#if GLU_BF16Y
struct EpiGlu {
    static constexpr bool PERM = true, AFTER_DRAIN = false;
    const bf16_t* Y; int ldy; const float* bias; bf16_t* O; int ldo; int ocol0;
    __device__ __forceinline__ void operator()(const f32x4 (&acc)[2][2][4][2], const Unit& u, int wr, int wc, int fr, int fq) const {
        const int row0 = u.pm * BM + wr * 64 + fr, col0 = u.pn * BM + wc * 32 + 8 * fq;
        f32x4 bb[2][2];
#pragma unroll
        for (int bj = 0; bj < 2; ++bj) { bb[bj][0] = *(const f32x4*)(bias + col0 + bj * HALF); bb[bj][1] = *(const f32x4*)(bias + col0 + bj * HALF + 4); }
#pragma unroll
        for (int ai = 0; ai < 2; ++ai) {
            u32x4 yv[4][2];
#pragma unroll
            for (int m = 0; m < 4; ++m)
#pragma unroll
                for (int bj = 0; bj < 2; ++bj) yv[m][bj] = *(const u32x4*)(Y + (size_t)(row0 + ai * HALF + m * 16) * ldy + col0 + bj * HALF);
            asm volatile("" ::: "memory");
#pragma unroll
            for (int m = 0; m < 4; ++m) { const int row = row0 + ai * HALF + m * 16;
#pragma unroll
                for (int bj = 0; bj < 2; ++bj) { const int c = col0 + bj * HALF; const u32x4 y = yv[m][bj];
                    const f32x4 y0 = {__builtin_bit_cast(float, y.x << 16), __builtin_bit_cast(float, y.x & 0xffff0000u), __builtin_bit_cast(float, y.y << 16), __builtin_bit_cast(float, y.y & 0xffff0000u)};
                    const f32x4 y1 = {__builtin_bit_cast(float, y.z << 16), __builtin_bit_cast(float, y.z & 0xffff0000u), __builtin_bit_cast(float, y.w << 16), __builtin_bit_cast(float, y.w & 0xffff0000u)};
                    f32x4 v0, v1;
#pragma unroll
                    for (int j = 0; j < 4; ++j) { v0[j] = y0[j] * fast_sigmoid(acc[ai][bj][m][0][j] + bb[bj][0][j]); v1[j] = y1[j] * fast_sigmoid(acc[ai][bj][m][1][j] + bb[bj][1][j]); }
                    u32x4 w; w.x = cvt_pk_bf16(v0[0], v0[1]); w.y = cvt_pk_bf16(v0[2], v0[3]); w.z = cvt_pk_bf16(v1[0], v1[1]); w.w = cvt_pk_bf16(v1[2], v1[3]);
                    *(u32x4*)(O + (size_t)row * ldo + ocol0 + c) = w; } }
            asm volatile("" ::: "memory");
        }
    }
};
#else
struct EpiGlu {
    static constexpr bool PERM = true, AFTER_DRAIN = false;
    const float* Y; int ldy; const float* bias; bf16_t* O; int ldo; int ocol0;
    __device__ __forceinline__ void operator()(const f32x4 (&acc)[2][2][4][2], const Unit& u, int wr, int wc, int fr, int fq) const {
        const int row0 = u.pm * BM + wr * 64 + fr, col0 = u.pn * BM + wc * 32 + 8 * fq;
#pragma unroll
        for (int ai = 0; ai < 2; ++ai)
#pragma unroll
            for (int m = 0; m < 4; ++m) { const int row = row0 + ai * HALF + m * 16;
#pragma unroll
                for (int bj = 0; bj < 2; ++bj) { const int c = col0 + bj * HALF;
                    const f32x4 y0 = *(const f32x4*)(Y + (size_t)row * ldy + c), y1 = *(const f32x4*)(Y + (size_t)row * ldy + c + 4);
                    const f32x4 b0 = *(const f32x4*)(bias + c), b1 = *(const f32x4*)(bias + c + 4);
                    f32x4 v0, v1;
#pragma unroll
                    for (int j = 0; j < 4; ++j) { v0[j] = y0[j] * fast_sigmoid(acc[ai][bj][m][0][j] + b0[j]); v1[j] = y1[j] * fast_sigmoid(acc[ai][bj][m][1][j] + b1[j]); }
                    u32x4 w; w.x = cvt_pk_bf16(v0[0], v0[1]); w.y = cvt_pk_bf16(v0[2], v0[3]); w.z = cvt_pk_bf16(v1[0], v1[1]); w.w = cvt_pk_bf16(v1[2], v1[3]);
                    *(u32x4*)(O + (size_t)row * ldo + ocol0 + c) = w; } }
    }
};
#endif
struct EpiRmsRes {
    static constexpr bool PERM = false, AFTER_DRAIN = true;
    const float* xsrc; float* xdst; bf16_t* h; const float* g1; const float* g2; float rw;
    unsigned long long* slots;
    unsigned* cnt; unsigned target; unsigned* tmo;
    __device__ __forceinline__ void refuse(size_t, size_t, int, int) const {}
    __device__ __forceinline__ void fused(f32x4 (&acc)[2][2][4][2], const Unit& u, int wr, int wc, int fr, int fq, PG8_LAS unsigned char* lds, int wid, int lane) const {
        typedef unsigned u32x2v __attribute__((ext_vector_type(2)));
        constexpr int DD = 2048; constexpr float EPS = 1e-6f;
#pragma unroll
        for (int ai = 0; ai < 2; ++ai)
#pragma unroll
            for (int m = 0; m < 4; ++m) { const int r = ai * HALF + wr * 64 + m * 16 + fr;
#pragma unroll
                for (int bj = 0; bj < 2; ++bj)
#pragma unroll
                    for (int n = 0; n < 2; ++n) { const int c = bj * HALF + wc * 32 + n * 16 + 4 * fq; const f32x4 y = acc[ai][bj][m][n];
                        u32x2v w; w.x = cvt_pk_bf16(y[0], y[1]); w.y = cvt_pk_bf16(y[2], y[3]);
                        *(PG8_LAS u32x2v*)(lds + r * 512 + ((2 * c) ^ ((r & 15) << 3))) = w; } }
        asm volatile("s_waitcnt lgkmcnt(0)" ::: "memory"); __builtin_amdgcn_s_barrier(); asm volatile("" ::: "memory");
        const int cb = u.pn * BM + 4 * lane;
        const f32x4 g1v = *(const f32x4*)(g1 + cb);
        float* slf = (float*)slots + (size_t)(u.pm * BM) * 32 + u.pn * 4;
        f32x4 xa[32];
#pragma unroll
        for (int rr = 0; rr < 32; ++rr) xa[rr] = *(const f32x4*)(xsrc + (size_t)(u.pm * BM + wid * 32 + rr) * DD + cb);
#pragma unroll
        for (int qd = 0; qd < 4; ++qd) { const int rb = wid * 32 + qd * 8;
            float v[32];
#pragma unroll
            for (int rr = 0; rr < 8; ++rr) { const int r = rb + rr; const u32x2v yw = *(const PG8_LAS u32x2v*)(lds + r * 512 + ((8 * lane) ^ ((r & 15) << 3)));
                const f32x4 y = (f32x4){__uint_as_float(yw.x << 16), __uint_as_float(yw.x & 0xffff0000u), __uint_as_float(yw.y << 16), __uint_as_float(yw.y & 0xffff0000u)};
                const f32x4 gy = g1v * y, xx = xa[8 * qd + rr];
                v[4 * rr + 0] = (y[0] * y[0] + y[1] * y[1]) + (y[2] * y[2] + y[3] * y[3]); v[4 * rr + 1] = (xx[0] * xx[0] + xx[1] * xx[1]) + (xx[2] * xx[2] + xx[3] * xx[3]);
                v[4 * rr + 2] = (xx[0] * gy[0] + xx[1] * gy[1]) + (xx[2] * gy[2] + xx[3] * gy[3]); v[4 * rr + 3] = (gy[0] * gy[0] + gy[1] * gy[1]) + (gy[2] * gy[2] + gy[3] * gy[3]); }
#pragma unroll
            for (int B = 4; B >= 0; --B) { const int half = 1 << B; const bool up = (lane >> B) & 1;
#pragma unroll
                for (int k = 0; k < 16; ++k) if (k < half) { const float lo = v[k], hi = v[k + half]; const float snd = up ? lo : hi, kp = up ? hi : lo; v[k] = kp + __shfl_xor(snd, half); } }
            v[0] += __shfl_xor(v[0], 32);
            if (lane < 32) __hip_atomic_store(slf + (size_t)(rb + (lane >> 2)) * 32 + (lane & 3), v[0], __ATOMIC_RELAXED, __HIP_MEMORY_SCOPE_AGENT);
        }
        asm volatile("s_waitcnt vmcnt(0)" ::: "memory");
        if (lane == 0) __hip_atomic_fetch_add(cnt + 64 * u.pm, 1u, __ATOMIC_RELAXED, __HIP_MEMORY_SCOPE_AGENT);
        if (wid == 0) { const unsigned long long t0 = __builtin_amdgcn_s_memrealtime();
            for (;;) { if ((unsigned)__builtin_amdgcn_readfirstlane(__hip_atomic_load(cnt + 64 * u.pm, __ATOMIC_RELAXED, __HIP_MEMORY_SCOPE_AGENT)) >= target) break;
                if (__builtin_amdgcn_s_memrealtime() - t0 > 2000000ull) { if (lane == 0) __hip_atomic_store(tmo, 1u, __ATOMIC_RELAXED, __HIP_MEMORY_SCOPE_AGENT); break; }
                __builtin_amdgcn_s_sleep(2); }
            __builtin_amdgcn_fence(__ATOMIC_ACQUIRE, "agent"); }
        asm volatile("s_waitcnt vmcnt(0) lgkmcnt(0)" ::: "memory"); __builtin_amdgcn_s_barrier(); asm volatile("" ::: "memory");
        const f32x4 g2v = h ? *(const f32x4*)(g2 + cb) : (f32x4){0.f, 0.f, 0.f, 0.f};
#pragma unroll
        for (int qd = 0; qd < 4; ++qd) { const int rb = wid * 32 + qd * 8; const int l5 = lane & 31;
            const float* sl = (const float*)slots + (size_t)(u.pm * BM + rb + (l5 >> 2)) * 32 + (l5 & 3); float tot = 0.f;
#pragma unroll
            for (int t = 0; t < 8; ++t) tot += __hip_atomic_load(sl + 4 * t, __ATOMIC_RELAXED, __HIP_MEMORY_SCOPE_AGENT);
            const float syy = __shfl(tot, lane & ~3), sxx = __shfl(tot, (lane & ~3) + 1), sxy = __shfl(tot, (lane & ~3) + 2), sgg = __shfl(tot, (lane & ~3) + 3);
            const float alpha = rw / sqrtf(syy * (1.0f / DD) + EPS); const float q = sxx + 2.0f * alpha * sxy + alpha * alpha * sgg;
            const float r2 = 1.0f / sqrtf(q * (1.0f / DD) + EPS);
#pragma unroll
            for (int rr = 0; rr < 8; ++rr) { const int r = rb + rr; const float a = __shfl(alpha, 4 * rr), b2 = __shfl(r2, 4 * rr);
                const u32x2v yw = *(const PG8_LAS u32x2v*)(lds + r * 512 + ((8 * lane) ^ ((r & 15) << 3)));
                const f32x4 y = (f32x4){__uint_as_float(yw.x << 16), __uint_as_float(yw.x & 0xffff0000u), __uint_as_float(yw.y << 16), __uint_as_float(yw.y & 0xffff0000u)};
                const f32x4 xn = xa[8 * qd + rr] + (g1v * y) * a; const size_t off = (size_t)(u.pm * BM + r) * DD + cb;
                *(f32x4*)(xdst + off) = xn;
                if (h) { const f32x4 hv = (xn * g2v) * b2; u32x2v w; w.x = cvt_pk_bf16(hv[0], hv[1]); w.y = cvt_pk_bf16(hv[2], hv[3]); *(u32x2v*)(h + off) = w; } }
        }
    }
};
template <class Epi, class Sched, bool ALIGN_EPI = false, bool SP2 = false>
__device__ __forceinline__ void gemm_phase(PG8_LAS unsigned char* lds, const Gemm g, const Sched& S, const Epi& E) {
    int tid_ = threadIdx.x; asm volatile("" : "+v"(tid_));
    const int tid = tid_, wid = __builtin_amdgcn_readfirstlane(tid >> 6), lane = tid & 63, wr = wid >> 2, wc = wid & 3, fr = lane & 15, fq = lane >> 4;
    const int K = g.K, nt = K / BK;
    unsigned voffA[2], voffB[2];
#pragma unroll
    for (int i = 0; i < 2; ++i) { int R, C; stage_rc(tid * 16 + i * 8192, R, C); const int Rb = Epi::PERM ? ((R & ~31) + perm32(R & 31)) : R;
        voffA[i] = (unsigned)(R * K + C) * 2u; voffB[i] = (unsigned)(Rb * K + C) * 2u; }
    const size_t kstep = (size_t)(BK * 2);
    const size_t hstep = (size_t)HALF * K * 2;
    const size_t tstep = 2 * hstep;
    const unsigned ldsw = (unsigned)wid * 1024u;
    const int aoff = lds_byte(wr * 64 + fr, fq * 8), boff = lds_byte(wc * 32 + fr, fq * 8);
#define PG8_SA(b, h) (((b) * 2 + (h)) * HTB)
#define PG8_SB(b, h) ((4 + (b) * 2 + (h)) * HTB)
#define PG8_STAGE(bufoff, gbase, voff) do { _Pragma("unroll") for (int _i = 0; _i < 2; ++_i) \
        __builtin_amdgcn_global_load_lds((const unsigned*)((const char*)(gbase) + (voff)[_i]), (PG8_LAS unsigned*)(lds + (bufoff) + ldsw + _i * 8192), 16, 0, 0); } while (0)
#define PG8_LDA(dst, b, h) do { _Pragma("unroll") for (int m = 0; m < 4; ++m) _Pragma("unroll") for (int k = 0; k < 2; ++k) dst[m][k] = *(const PG8_LAS bf16x8*)(lds + PG8_SA(b, h) + aoff + m * 2048 + k * 1024); } while (0)
#define PG8_LDB(dst, b, h) do { _Pragma("unroll") for (int n = 0; n < 2; ++n) _Pragma("unroll") for (int k = 0; k < 2; ++k) dst[n][k] = *(const PG8_LAS bf16x8*)(lds + PG8_SB(b, h) + boff + n * 2048 + k * 1024); } while (0)
#define PG8_MMA(ai, bj, At, Bt) do { __builtin_amdgcn_s_setprio(1); _Pragma("unroll") for (int m = 0; m < 4; ++m) _Pragma("unroll") for (int n = 0; n < 2; ++n) _Pragma("unroll") for (int k = 0; k < 2; ++k) \
        acc[ai][bj][m][n] = __builtin_amdgcn_mfma_f32_16x16x32_bf16(Bt[n][k], At[m][k], acc[ai][bj][m][n], 0, 0, 0); __builtin_amdgcn_s_setprio(0); } while (0)
#define PG8_WAIT_V(n) asm volatile("s_waitcnt vmcnt(" #n ")" ::: "memory")
#define PG8_WAIT_L(n) asm volatile("s_waitcnt lgkmcnt(" #n ")" ::: "memory")
#define PG8_BAR __builtin_amdgcn_s_barrier()
#define PG8_SCHED __builtin_amdgcn_sched_barrier(0)
    Unit cur, nxt; int ui = 0;
    if (!S.next(0, cur)) return;
    f32x4 acc[2][2][4][2];
#pragma unroll
    for (int a = 0; a < 2; ++a)
#pragma unroll
        for (int b = 0; b < 2; ++b)
#pragma unroll
            for (int m = 0; m < 4; ++m)
#pragma unroll
                for (int n = 0; n < 2; ++n) acc[a][b][m][n] = (f32x4){0.f, 0.f, 0.f, 0.f};
    bf16x8 At[4][2], B0[2][2], B1[2][2];
    const char* cA = (const char*)g.A + (size_t)cur.pm * tstep; const char* cB = (const char*)g.Bt + (size_t)cur.pn * tstep;
    S.a_ready(cur);
    if constexpr (SP2) {
        PG8_STAGE(PG8_SB(0, 0), cB, voffB); PG8_STAGE(PG8_SB(0, 1), cB + hstep, voffB); PG8_STAGE(PG8_SA(0, 0), cA, voffA); PG8_STAGE(PG8_SA(0, 1), cA + hstep, voffA);
        if (wr == 1) PG8_BAR;
        PG8_WAIT_V(2); PG8_BAR;
        PG8_STAGE(PG8_SB(1, 0), cB + kstep, voffB); PG8_STAGE(PG8_SA(1, 0), cA + kstep, voffA); PG8_STAGE(PG8_SB(1, 1), cB + hstep + kstep, voffB);
        PG8_WAIT_V(6); PG8_BAR;
    } else {
        PG8_STAGE(PG8_SB(0, 0), cB, voffB); PG8_STAGE(PG8_SA(0, 0), cA, voffA); PG8_STAGE(PG8_SB(0, 1), cB + hstep, voffB); PG8_STAGE(PG8_SA(0, 1), cA + hstep, voffA);
        if (wr == 1) PG8_BAR;
        PG8_WAIT_V(4); PG8_BAR;
        PG8_STAGE(PG8_SB(1, 0), cB + kstep, voffB); PG8_STAGE(PG8_SA(1, 0), cA + kstep, voffA); PG8_STAGE(PG8_SB(1, 1), cB + hstep + kstep, voffB);
        PG8_WAIT_V(6); PG8_BAR;
    }
    for (;;) {
        const bool has_next = S.next(ui + 1, nxt);
        const char* nA = has_next ? (const char*)g.A + (size_t)nxt.pm * tstep : cA; const char* nB = has_next ? (const char*)g.Bt + (size_t)nxt.pn * tstep : cB;
        for (int t = 0; t < nt; t += 2) {
            const bool last = (t == nt - 2);
            const char* a1 = cA + (size_t)(t + 1) * kstep;
            const char* a2 = last ? nA : cA + (size_t)(t + 2) * kstep; const char* b2 = last ? nB : cB + (size_t)(t + 2) * kstep;
            const char* a3 = a2 + kstep; const char* b3 = b2 + kstep;
            if (last && has_next) S.a_ready(nxt);
            if constexpr (SP2) {
            PG8_LDB(B0, 0, 0); PG8_LDB(B1, 0, 1); PG8_SCHED; PG8_LDA(At, 0, 0); PG8_STAGE(PG8_SA(1, 1), a1 + hstep, voffA);
            PG8_WAIT_V(8); PG8_WAIT_L(0); PG8_BAR; PG8_MMA(0, 0, At, B0); PG8_MMA(0, 1, At, B1); PG8_BAR; PG8_SCHED;
            PG8_LDA(At, 0, 1); PG8_STAGE(PG8_SB(0, 0), b2, voffB); PG8_STAGE(PG8_SB(0, 1), b2 + hstep, voffB); PG8_STAGE(PG8_SA(0, 0), a2, voffA);
            PG8_WAIT_V(8); PG8_WAIT_L(0); PG8_BAR; PG8_MMA(1, 0, At, B0); PG8_MMA(1, 1, At, B1); PG8_BAR; PG8_SCHED;
            PG8_LDB(B0, 1, 0); PG8_LDB(B1, 1, 1); PG8_SCHED; PG8_LDA(At, 1, 0); PG8_STAGE(PG8_SA(0, 1), a2 + hstep, voffA);
            PG8_WAIT_V(8); PG8_WAIT_L(0); PG8_BAR; PG8_MMA(0, 0, At, B0); PG8_MMA(0, 1, At, B1); PG8_BAR; PG8_SCHED;
            PG8_LDA(At, 1, 1); PG8_STAGE(PG8_SB(1, 0), b3, voffB); PG8_STAGE(PG8_SB(1, 1), b3 + hstep, voffB); PG8_STAGE(PG8_SA(1, 0), a3, voffA);
            PG8_WAIT_V(8); PG8_WAIT_L(0); PG8_BAR; PG8_MMA(1, 0, At, B0); PG8_MMA(1, 1, At, B1); PG8_BAR; PG8_SCHED;
            } else {
            PG8_LDB(B0, 0, 0); PG8_SCHED; PG8_LDA(At, 0, 0); PG8_STAGE(PG8_SA(1, 1), a1 + hstep, voffA);
            PG8_WAIT_L(8); PG8_BAR; PG8_WAIT_L(0); PG8_MMA(0, 0, At, B0); PG8_BAR; PG8_SCHED;
            PG8_LDB(B1, 0, 1); PG8_STAGE(PG8_SB(0, 0), b2, voffB);
            PG8_BAR; PG8_WAIT_L(0); PG8_MMA(0, 1, At, B1); PG8_BAR;
            PG8_LDA(At, 0, 1); PG8_STAGE(PG8_SA(0, 0), a2, voffA);
            PG8_BAR; PG8_WAIT_L(0); PG8_MMA(1, 0, At, B0); PG8_BAR; PG8_SCHED;
            PG8_STAGE(PG8_SB(0, 1), b2 + hstep, voffB);
            PG8_WAIT_V(6); PG8_BAR; PG8_MMA(1, 1, At, B1); PG8_BAR;
            PG8_LDB(B0, 1, 0); PG8_SCHED; PG8_LDA(At, 1, 0); PG8_STAGE(PG8_SA(0, 1), a2 + hstep, voffA);
            PG8_WAIT_L(8); PG8_BAR; PG8_WAIT_L(0); PG8_MMA(0, 0, At, B0); PG8_BAR; PG8_SCHED;
            PG8_LDB(B1, 1, 1); PG8_STAGE(PG8_SB(1, 0), b3, voffB);
            PG8_BAR; PG8_WAIT_L(0); PG8_MMA(0, 1, At, B1); PG8_BAR;
            PG8_LDA(At, 1, 1); PG8_STAGE(PG8_SA(1, 0), a3, voffA);
            PG8_BAR; PG8_WAIT_L(0); PG8_MMA(1, 0, At, B0); PG8_BAR; PG8_SCHED;
            PG8_STAGE(PG8_SB(1, 1), b3 + hstep, voffB);
            PG8_WAIT_V(6); PG8_BAR; PG8_MMA(1, 1, At, B1); PG8_BAR;
            }
        }
        if constexpr (ALIGN_EPI) { if (wr == 0) PG8_BAR; }
        if constexpr (!Epi::AFTER_DRAIN) { E(acc, cur, wr, wc, fr, fq); S.done(cur); }
        if (!has_next) break;
#pragma unroll
        for (int a = 0; a < 2; ++a)
#pragma unroll
            for (int b = 0; b < 2; ++b)
#pragma unroll
                for (int m = 0; m < 4; ++m)
#pragma unroll
                    for (int n = 0; n < 2; ++n) acc[a][b][m][n] = (f32x4){0.f, 0.f, 0.f, 0.f};
        cur = nxt; cA = nA; cB = nB; ++ui;
        if constexpr (ALIGN_EPI) { if (wr == 1) PG8_BAR; }
    }
    PG8_WAIT_V(0);
    if constexpr (!ALIGN_EPI) { if (wr == 0) PG8_BAR; }
    PG8_BAR;
    if constexpr (Epi::AFTER_DRAIN) { E.fused(acc, cur, wr, wc, fr, fq, lds, wid, lane); S.done(cur); }
#undef PG8_SA
#undef PG8_SB
#undef PG8_STAGE
#undef PG8_LDA
#undef PG8_LDB
#undef PG8_MMA
#undef PG8_WAIT_V
#undef PG8_WAIT_L
#undef PG8_BAR
#undef PG8_SCHED
}
}
#ifndef MK_MULTI
#define MK_MULTI 0
#endif
constexpr int NWAVES = 8;
constexpr int BATCH = 2, SEQ = 4096, M = BATCH * SEQ, D = 2048, FF = 5632, DEPTH = 4;
constexpr int ZW = 4096, INW = 4104, MIXW = 2048;
constexpr int Z_AQ = 0, Z_AK = 1024, Z_AV = 1280, Z_DQKV = 1536, Z_DZ = 3072, Z_S5 = 3584;
constexpr int SRC_AB = 3584, SRC_S5 = 3592;
constexpr float NORM_EPS = 1e-6f;
constexpr size_t al256(size_t x) { return (x + 255) & ~(size_t)255; }
constexpr size_t MiB = 1u << 20;
constexpr size_t WS_CTL = 0, CTL_ZERO_BYTES = 1 * MiB;
constexpr size_t SZ_WGU = (size_t)2 * FF * D * 2, SZ_WD = (size_t)D * FF * 2, SZ_WIN = (size_t)ZW * D * 2, SZ_WOUT = (size_t)D * MIXW * 2, SZ_WGLU = (size_t)512 * 512 * 2;
constexpr size_t SZ_LAYER_W = 2 * SZ_WGU + 2 * SZ_WD + SZ_WIN + SZ_WOUT + SZ_WGLU;
constexpr size_t OFF_WGU1 = 0, OFF_WD1 = OFF_WGU1 + SZ_WGU, OFF_WIN = OFF_WD1 + SZ_WD, OFF_WOUT = OFF_WIN + SZ_WIN, OFF_WGU2 = OFF_WOUT + SZ_WOUT, OFF_WD2 = OFF_WGU2 + SZ_WGU, OFF_WGLU = OFF_WD2 + SZ_WD;
constexpr size_t WS_ROPE = WS_CTL + CTL_ZERO_BYTES;
constexpr size_t WS_W = WS_ROPE + 2 * MiB;
constexpr size_t WS_H = al256(WS_W + DEPTH * SZ_LAYER_W);
constexpr size_t WS_ACT = WS_H + (size_t)M * D * 2;
constexpr size_t WS_Y = WS_ACT + (size_t)M * FF * 2;
constexpr size_t WS_Z = WS_Y + (size_t)M * D * 4;
constexpr size_t WS_MIXED = WS_Z + (size_t)M * ZW * 2;
constexpr size_t WS_AB = WS_MIXED + (size_t)M * MIXW * 2;
constexpr size_t WS_BG = WS_AB + (size_t)M * 8 * 4;
constexpr size_t WS_KR = WS_BG + (size_t)M * 8 * 4;
constexpr size_t WS_QN = WS_KR + (size_t)M * 256 * 4;
constexpr size_t WS_KN = WS_QN + (size_t)M * 512 * 4;
constexpr size_t WS_VC = WS_KN + (size_t)M * 512 * 4;
constexpr size_t WS_ORAW = WS_VC + (size_t)M * 512 * 4;
constexpr size_t WS_YS = WS_ORAW + (size_t)M * 512 * 4;
constexpr size_t WS_YSB = WS_YS + (size_t)M * 512 * 4;
constexpr size_t WS_S5T = WS_YSB + (size_t)M * 512 * 2;
constexpr size_t WS_S5E = WS_S5T + (size_t)DEPTH * 32 * 140288;
constexpr size_t WS_DNC = WS_S5E + (size_t)2 * 16 * 32 * 128 * 4;
constexpr size_t WS_XS = WS_DNC + (size_t)512 * 106752;
constexpr size_t WS_END = WS_XS + (size_t)32 * 256 * 8 * 16;
static_assert(WS_KN == WS_QN + (size_t)M * 512 * 4 && WS_VC == WS_KN + (size_t)M * 512 * 4, "qn | kn | vc consecutive");
constexpr int CW_TMO = 0, CW_CODE = 1, CW_BAR = 4096, CW_CNT = 16384;
constexpr int RING_OFF = 0, RING_BYTES = 131072;
constexpr int LDS_BYTES = 155648;
constexpr int MISC_OFF = LDS_BYTES - 512;

#define GAS __attribute__((address_space(1)))
#define LAS __attribute__((address_space(3)))
typedef unsigned short bf16;
typedef unsigned v4u __attribute__((ext_vector_type(4)));
typedef unsigned v2u __attribute__((ext_vector_type(2)));
typedef float f32x4 __attribute__((ext_vector_type(4)));
typedef short bf16x8 __attribute__((ext_vector_type(8)));
#define LDS_WAIT() asm volatile("s_waitcnt lgkmcnt(0)" ::: "memory")
#define VM_WAIT() asm volatile("s_waitcnt vmcnt(0)" ::: "memory")
__device__ __forceinline__ unsigned f2bf(float f) { unsigned u = __builtin_bit_cast(unsigned, f); return (u + 0x7fffu + ((u >> 16) & 1u)) >> 16; }
__device__ __forceinline__ unsigned pk2(float lo, float hi) { return f2bf(lo) | (f2bf(hi) << 16); }
__device__ __forceinline__ float bf2f(bf16 b) { return __builtin_bit_cast(float, (unsigned)b << 16); }
__device__ __forceinline__ float bflo(unsigned w) { return __builtin_bit_cast(float, w << 16); }
__device__ __forceinline__ float bfhi(unsigned w) { return __builtin_bit_cast(float, w & 0xffff0000u); }
__device__ __forceinline__ float wave_sum(float v) {
#pragma unroll
    for (int o = 1; o < 64; o <<= 1) v += __shfl_xor(v, o);
    return v;
}
__device__ __forceinline__ float wave_max(float v) {
#pragma unroll
    for (int o = 1; o < 64; o <<= 1) v = fmaxf(v, __shfl_xor(v, o));
    return v;
}
__device__ __forceinline__ float sigmoid_f(float x) { return 1.0f / (1.0f + __expf(-x)); }
__device__ __forceinline__ float gelu_tanh(float x) { const float u = 0.7978845608028654f * (x + 0.044715f * x * x * x); const float e = __expf(2.0f * u); const float th = 1.0f - 2.0f / (e + 1.0f); return 0.5f * x * (1.0f + th); }
#define XB_TMO      128
#define XB_XCNT(j)  (256  + 64 * (j))
#define XB_XSUB(j)  (1280 + 64 * (j))
#define XB_XGEN(j)  (2304 + 64 * (j))
#define XB_TOP      3328
#define XB_TOPGEN   3392
#define XCD_BAR_WORDS 3456
#define XB_SPIN_CAP (1u << 24)
#ifndef XB_EARLY_WB
#define XB_EARLY_WB 0
#endif

__device__ __forceinline__ unsigned xb_ld(unsigned* p)              { return __hip_atomic_load(p, __ATOMIC_RELAXED, __HIP_MEMORY_SCOPE_AGENT); }
__device__ __forceinline__ unsigned xb_add(unsigned* p, unsigned v) { return __hip_atomic_fetch_add(p, v, __ATOMIC_RELAXED, __HIP_MEMORY_SCOPE_AGENT); }
__device__ __forceinline__ unsigned xb_xcc_id() { return (unsigned)__builtin_amdgcn_s_getreg((3 << 11) | 20) & 0xFu; }
#define XB_SPIN(cond, bar) do { unsigned _sp = 0; while (cond) { __builtin_amdgcn_s_sleep(1); \
    if ((++_sp & 255u) == 0u) { if (xb_ld(&(bar)[XB_TMO])) break; if (_sp > XB_SPIN_CAP) { atomicAdd(&(bar)[XB_TMO], 1u); break; } } } } while (0)

struct XcdBarrier {
    unsigned* bar; unsigned x;
    volatile LAS unsigned* st;
    unsigned expect;
};

__device__ __forceinline__ XcdBarrier xcd_barrier_post(unsigned* bar, volatile LAS unsigned* st) {
    XcdBarrier b; b.bar = bar; b.x = xb_xcc_id(); b.st = st; b.expect = 0u;
    if (threadIdx.x == 0) (void)xb_add(&bar[XB_XCNT(b.x)], 1u);
    return b;
}
__device__ __forceinline__ void xcd_barrier_complete(unsigned* bar, unsigned x, unsigned& nloc, unsigned& nx, unsigned expect) {
    const unsigned G = expect ? expect : gridDim.x * gridDim.y * gridDim.z;
    unsigned sum, cnt, mine, sp = 0u;
    for (;;) {
        sum = 0u; cnt = 0u; mine = 0u;
#pragma unroll
        for (unsigned j = 0; j < 16; ++j) { const unsigned c = xb_ld(&bar[XB_XCNT(j)]); sum += c; cnt += (c > 0u) ? 1u : 0u; mine = (j == x) ? c : mine; }
        if (sum == G) break;
        __builtin_amdgcn_s_sleep(1);
        if ((++sp & 255u) == 0u) { if (xb_ld(&bar[XB_TMO])) break; if (sp > XB_SPIN_CAP) { atomicAdd(&bar[XB_TMO], 1u); break; } }
    }
    nloc = mine > 0u ? mine : 1u; nx = cnt > 0u ? cnt : 1u;
}

__device__ __forceinline__ void xcd_barrier(const XcdBarrier& b) {
    asm volatile("s_waitcnt vmcnt(0)" ::: "memory");
    __syncthreads();
    if (threadIdx.x == 0) {
        unsigned* bar = b.bar; unsigned bx = b.x;
        asm volatile("" : "+s"(bar), "+s"(bx));
        __builtin_amdgcn_s_waitcnt(0);
        unsigned nloc = b.st[0], nx = b.st[1];
        if (nloc == 0u) { xcd_barrier_complete(bar, bx, nloc, nx, b.expect); b.st[0] = nloc; b.st[1] = nx; }
        const unsigned old = xb_add(&bar[XB_XSUB(bx)], 1u);
        const unsigned gen = old / nloc;
        if (old + 1u == (gen + 1u) * nloc) {
            __builtin_amdgcn_fence(__ATOMIC_RELEASE, "agent");
            asm volatile("s_waitcnt vmcnt(0)" ::: "memory");
            const unsigned og = xb_add(&bar[XB_TOP], 1u);
            const unsigned tg = og / nx;
            if (og + 1u == (tg + 1u) * nx) xb_add(&bar[XB_TOPGEN], 1u);
            else XB_SPIN(xb_ld(&bar[XB_TOPGEN]) == tg, bar);
            __builtin_amdgcn_fence(__ATOMIC_ACQUIRE, "agent");
            xb_add(&bar[XB_XGEN(bx)], 1u);
            asm volatile("s_waitcnt vmcnt(0)" ::: "memory");
        } else {
#if XB_EARLY_WB
            { const unsigned pos = old - gen * nloc;
              if (pos == 0u || (XB_EARLY_WB > 1 && pos == nloc / 2u)) { __builtin_amdgcn_fence(__ATOMIC_RELEASE, "agent"); asm volatile("s_waitcnt vmcnt(0)" ::: "memory"); } }
#endif
            XB_SPIN(xb_ld(&bar[XB_XGEN(bx)]) == gen, bar);
            __builtin_amdgcn_fence(__ATOMIC_ACQUIRE, "agent");
            asm volatile("s_waitcnt vmcnt(0)" ::: "memory");
        }
    }
    __syncthreads();
}
struct Frame {
    LAS unsigned char* lds;
    int bid, wave, G, gw, NGW;
};
#define PHASE_TID() int tid = threadIdx.x; asm volatile("" : "+v"(tid)); const int lane = tid & 63; (void)lane
struct LayerW { const bf16 *wgu1, *wd1, *win, *wout, *wgu2, *wd2, *wglu; };
__device__ __forceinline__ LayerW layer_w(unsigned char* ws, int l) {
    unsigned char* b = ws + WS_W + (size_t)l * SZ_LAYER_W; LayerW w;
    w.wgu1 = (const bf16*)(b + OFF_WGU1); w.wd1 = (const bf16*)(b + OFF_WD1); w.win = (const bf16*)(b + OFF_WIN); w.wout = (const bf16*)(b + OFF_WOUT);
    w.wgu2 = (const bf16*)(b + OFF_WGU2); w.wd2 = (const bf16*)(b + OFF_WD2); w.wglu = (const bf16*)(b + OFF_WGLU); return w;
}
#ifndef CONV_WIDE
#define CONV_WIDE 0
#endif
__device__ __forceinline__ void transpose_item(const float* W, int K, int ldw, int sc0, int ncols, bf16* WT, int dr0, int mode, LAS float* scr, int item, int lane) {
    const int nblk = ncols / 32, kb = item / nblk, nb = item % nblk, k0 = 64 * kb, n0 = 32 * nb;
    const float* src = W + (size_t)k0 * ldw + sc0 + n0 + (lane & 31);
#if CONV_WIDE
    { f32x4 tv[8]; const int rr = lane >> 3, cq = lane & 7;
      const float* srow = W + (size_t)(k0 + rr) * ldw + sc0 + n0 + 4 * cq;
#pragma unroll
      for (int i = 0; i < 8; ++i) tv[i] = *(const GAS f32x4*)(srow + (size_t)(8 * i) * ldw);
#pragma unroll
      for (int i = 0; i < 8; ++i) { LAS float* d = scr + (8 * i + rr) * 33 + 4 * cq; d[0] = tv[i].x; d[1] = tv[i].y; d[2] = tv[i].z; d[3] = tv[i].w; } }
#else
#pragma unroll 1
    for (int hf = 0; hf < 2; ++hf) { float tv[16];
#pragma unroll
        for (int i = 0; i < 16; ++i) tv[i] = src[(size_t)(32 * hf + 2 * i + (lane >> 5)) * ldw];
#pragma unroll
        for (int i = 0; i < 16; ++i) scr[(32 * hf + 2 * i + (lane >> 5)) * 33 + (lane & 31)] = tv[i]; }
#endif
    LDS_WAIT(); asm volatile("" ::: "memory");
    const int c = lane & 7;
    const int drow0 = (mode == 0) ? (dr0 + n0) : (256 * (n0 >> 7) + dr0 + (n0 & 127));
#pragma unroll
    for (int j = 0; j < 4; ++j) { const int n = (lane >> 3) + 8 * j; const LAS float* s = scr + (8 * c) * 33 + n;
        v4u o; o.x = pk2(s[0 * 33], s[1 * 33]); o.y = pk2(s[2 * 33], s[3 * 33]); o.z = pk2(s[4 * 33], s[5 * 33]); o.w = pk2(s[6 * 33], s[7 * 33]);
        *(GAS v4u*)(WT + (size_t)(drow0 + n) * K + k0 + 8 * c) = o; }
    LDS_WAIT(); asm volatile("" ::: "memory");
}
__device__ __forceinline__ void convert_matrix(Frame& F, const float* W, int K, int ldw, int sc0, int ncols, bf16* WT, int dr0, int mode, int rot) {
    PHASE_TID();
    LAS float* scr = (LAS float*)(F.lds + RING_OFF + F.wave * 16384);
    const int nitems = (K / 64) * (ncols / 32);
    int g = F.gw + rot; if (g >= F.NGW) g -= F.NGW;
    for (int it = g; it < nitems; it += F.NGW) transpose_item(W, K, ldw, sc0, ncols, WT, dr0, mode, scr, it, lane);
}
__device__ __forceinline__ void sincos_rev(double t, float& s, float& c) {
    const double t4 = t * 4.0; const double kd = __builtin_rint(t4); const int k = (int)kd & 3;
    const float y = (float)((t4 - kd) * 1.5707963267948966);
    const float z = y * y;
    const float sp = ((-1.9515295891e-4f * z + 8.3321608736e-3f) * z - 1.6666654611e-1f) * z * y + y;
    float one = 1.0f; asm volatile("" : "+v"(one));
    const float cp = ((2.443315711809948e-5f * z - 1.388731625493765e-3f) * z + 4.166664568298827e-2f) * z * z - 0.5f * z + one;
    s = (k == 0) ? sp : (k == 1) ? cp : (k == 2) ? -sp : -cp;
    c = (k == 0) ? cp : (k == 1) ? -sp : (k == 2) ? -cp : sp;
}
__device__ __forceinline__ void rms_row_to_bf16(int lane, const float* xrow, const float* gain, bf16* orow) {
    const GAS f32x4* xr = (const GAS f32x4*)xrow + lane; const GAS f32x4* gr = (const GAS f32x4*)gain + lane;
    f32x4 v[8]; float s = 0.f;
#pragma unroll
    for (int j = 0; j < 8; ++j) { v[j] = xr[64 * j]; s += (v[j].x * v[j].x + v[j].y * v[j].y) + (v[j].z * v[j].z + v[j].w * v[j].w); }
    const float rstd = 1.0f / sqrtf(wave_sum(s) * (1.f / D) + NORM_EPS);
    GAS v2u* o8 = (GAS v2u*)orow + lane;
#pragma unroll
    for (int j = 0; j < 8; ++j) { const f32x4 g = gr[64 * j]; v2u o; o.x = pk2(v[j].x * rstd * g.x, v[j].y * rstd * g.y); o.y = pk2(v[j].z * rstd * g.z, v[j].w * rstd * g.w); o8[64 * j] = o; }
}
template <bool HOUT, bool AB>
__device__ __forceinline__ void norm_phase(Frame& F, const void* yv_, const float* xsrc, float* xdst, const float* gpost, float rw, const float* gnext, bf16* h, const float* win_l, float* ab) {
    PHASE_TID();
    LAS float* w8 = (LAS float*)(F.lds + RING_OFF);
    if constexpr (AB) {
        for (int i = tid; i < D * 8; i += NWAVES * 64) { const int k = i >> 3, c = i & 7; w8[i] = win_l[(size_t)k * INW + SRC_AB + c]; }
        __syncthreads();
    }
    for (int m = F.gw; m < M; m += F.NGW) {
        asm volatile("" ::: "memory");
#if Y_BF16
        const GAS v2u* yr = (const GAS v2u*)((const bf16*)yv_ + (size_t)m * D) + lane; const GAS f32x4* xr = (const GAS f32x4*)(xsrc + (size_t)m * D) + lane;
        const GAS f32x4* gp = (const GAS f32x4*)gpost + lane;
        f32x4 v[8]; float s = 0.f;
#pragma unroll
        for (int j = 0; j < 8; ++j) { const v2u yw = yr[64 * j]; v[j] = (f32x4){bflo(yw.x), bfhi(yw.x), bflo(yw.y), bfhi(yw.y)}; s += (v[j].x * v[j].x + v[j].y * v[j].y) + (v[j].z * v[j].z + v[j].w * v[j].w); }
#else
        const GAS f32x4* yr = (const GAS f32x4*)((const float*)yv_ + (size_t)m * D) + lane; const GAS f32x4* xr = (const GAS f32x4*)(xsrc + (size_t)m * D) + lane;
        const GAS f32x4* gp = (const GAS f32x4*)gpost + lane;
        f32x4 v[8]; float s = 0.f;
#pragma unroll
        for (int j = 0; j < 8; ++j) { v[j] = yr[64 * j]; s += (v[j].x * v[j].x + v[j].y * v[j].y) + (v[j].z * v[j].z + v[j].w * v[j].w); }
#endif
        const float rstd = rw / sqrtf(wave_sum(s) * (1.f / D) + NORM_EPS);
        float s2 = 0.f;
        GAS f32x4* xo = (GAS f32x4*)(xdst + (size_t)m * D) + lane;
#pragma unroll
        for (int j = 0; j < 8; ++j) { const f32x4 g = gp[64 * j]; const f32x4 xv = xr[64 * j]; f32x4 o;
            o.x = xv.x + v[j].x * rstd * g.x; o.y = xv.y + v[j].y * rstd * g.y; o.z = xv.z + v[j].z * rstd * g.z; o.w = xv.w + v[j].w * rstd * g.w;
            xo[64 * j] = o; v[j] = o; s2 += (o.x * o.x + o.y * o.y) + (o.z * o.z + o.w * o.w); }
        if constexpr (HOUT) {
            const float r2 = 1.0f / sqrtf(wave_sum(s2) * (1.f / D) + NORM_EPS);
            const GAS f32x4* gn = (const GAS f32x4*)gnext + lane;
            GAS v2u* o8 = (GAS v2u*)(h + (size_t)m * D) + lane;
            float dot[8];
#pragma unroll
            for (int c = 0; c < 8; ++c) dot[c] = 0.f;
#pragma unroll
            for (int j = 0; j < 8; ++j) { const f32x4 g = gn[64 * j]; f32x4 hv; hv.x = v[j].x * r2 * g.x; hv.y = v[j].y * r2 * g.y; hv.z = v[j].z * r2 * g.z; hv.w = v[j].w * r2 * g.w;
                v2u o; o.x = pk2(hv.x, hv.y); o.y = pk2(hv.z, hv.w); o8[64 * j] = o;
                if constexpr (AB) {
                    const LAS f32x4* wp = (const LAS f32x4*)(w8 + (size_t)(j * 256 + lane * 4) * 8);
#pragma unroll
                    for (int e = 0; e < 4; ++e) { const f32x4 wa = wp[2 * e], wb = wp[2 * e + 1]; const float hh = hv[e];
                        dot[0] += hh * wa.x; dot[1] += hh * wa.y; dot[2] += hh * wa.z; dot[3] += hh * wa.w; dot[4] += hh * wb.x; dot[5] += hh * wb.y; dot[6] += hh * wb.z; dot[7] += hh * wb.w; }
                } }
            if constexpr (AB) {
#pragma unroll
                for (int c = 0; c < 8; ++c) dot[c] = wave_sum(dot[c]);
                if (lane == 0) { GAS f32x4* ao = (GAS f32x4*)(ab + (size_t)m * 8); ao[0] = (f32x4){dot[0], dot[1], dot[2], dot[3]}; ao[1] = (f32x4){dot[4], dot[5], dot[6], dot[7]}; }
            }
        }
    }
    if constexpr (AB) __syncthreads();
}

template <bool HOUT, bool AB>
__device__ __forceinline__ void norm_phase2(Frame& F, const void* yv_, const float* xsrc, float* xdst, const float* gpost, float rw, const float* gnext, bf16* h, const float* win_l, float* ab) {
    PHASE_TID();
    LAS float* w8 = (LAS float*)(F.lds + RING_OFF);
    if constexpr (AB) {
        for (int i = tid; i < D * 8; i += NWAVES * 64) { const int k = i >> 3, c = i & 7; w8[i] = win_l[(size_t)k * INW + SRC_AB + c]; }
        __syncthreads();
    }
    for (int m0 = F.gw; m0 < M; m0 += 2 * F.NGW) {
        asm volatile("" ::: "memory");
        asm volatile("" : "+s"(yv_), "+s"(xsrc), "+s"(xdst), "+s"(gpost), "+s"(gnext), "+s"(h));
        const bool two = m0 + F.NGW < M; const int m1 = two ? m0 + F.NGW : m0;
        v2u yw[2][8]; f32x4 xv[2][8];
#pragma unroll
        for (int r = 0; r < 2; ++r) { const int m = r ? m1 : m0;
            const GAS v2u* yr = (const GAS v2u*)((const bf16*)yv_ + (size_t)m * D) + lane; const GAS f32x4* xr = (const GAS f32x4*)(xsrc + (size_t)m * D) + lane;
#pragma unroll
            for (int j = 0; j < 8; ++j) { yw[r][j] = yr[64 * j]; xv[r][j] = xr[64 * j]; } }
        const GAS f32x4* gp = (const GAS f32x4*)gpost + lane;
        float rstd[2], s2[2];
#pragma unroll
        for (int r = 0; r < 2; ++r) { float s = 0.f;
#pragma unroll
            for (int j = 0; j < 8; ++j) { const v2u w = yw[r][j]; const float a = bflo(w.x), b = bfhi(w.x), c = bflo(w.y), d = bfhi(w.y); s += (a * a + b * b) + (c * c + d * d); }
            rstd[r] = rw / sqrtf(wave_sum(s) * (1.f / D) + NORM_EPS); s2[r] = 0.f; }
#pragma unroll
        for (int j = 0; j < 8; ++j) { const f32x4 g = gp[64 * j];
#pragma unroll
            for (int r = 0; r < 2; ++r) { const v2u w = yw[r][j]; const f32x4 x = xv[r][j]; f32x4 o;
                o.x = x.x + bflo(w.x) * rstd[r] * g.x; o.y = x.y + bfhi(w.x) * rstd[r] * g.y; o.z = x.z + bflo(w.y) * rstd[r] * g.z; o.w = x.w + bfhi(w.y) * rstd[r] * g.w;
                xv[r][j] = o; s2[r] += (o.x * o.x + o.y * o.y) + (o.z * o.z + o.w * o.w);
                if (r == 0 || two) ((GAS f32x4*)(xdst + (size_t)(r ? m1 : m0) * D) + lane)[64 * j] = o; } }
        if constexpr (HOUT) {
            float r2[2];
#pragma unroll
            for (int r = 0; r < 2; ++r) r2[r] = 1.0f / sqrtf(wave_sum(s2[r]) * (1.f / D) + NORM_EPS);
#pragma unroll
            for (int r = 0; r < 2; ++r) {
                if constexpr (AB) asm volatile("" : "+s"(gnext), "+s"(h), "+s"(ab) :: "memory");
                const GAS f32x4* gn = (const GAS f32x4*)gnext + lane;
                float dot[8];
#pragma unroll
                for (int c = 0; c < 8; ++c) dot[c] = 0.f;
#pragma unroll
                for (int j = 0; j < 8; ++j) { const f32x4 g = gn[64 * j]; f32x4 hv; hv.x = xv[r][j].x * r2[r] * g.x; hv.y = xv[r][j].y * r2[r] * g.y; hv.z = xv[r][j].z * r2[r] * g.z; hv.w = xv[r][j].w * r2[r] * g.w;
                    v2u o; o.x = pk2(hv.x, hv.y); o.y = pk2(hv.z, hv.w);
                    if (r == 0 || two) ((GAS v2u*)(h + (size_t)(r ? m1 : m0) * D) + lane)[64 * j] = o;
                    if constexpr (AB) {
                        asm volatile("" ::: "memory");
                        const LAS f32x4* wp = (const LAS f32x4*)(w8 + (size_t)(j * 256 + lane * 4) * 8);
#pragma unroll
                        for (int e = 0; e < 4; ++e) { const f32x4 wa = wp[2 * e], wb = wp[2 * e + 1]; const float hh = hv[e];
                            dot[0] += hh * wa.x; dot[1] += hh * wa.y; dot[2] += hh * wa.z; dot[3] += hh * wa.w; dot[4] += hh * wb.x; dot[5] += hh * wb.y; dot[6] += hh * wb.z; dot[7] += hh * wb.w; }
                    } }
                if constexpr (AB) {
#pragma unroll
                    for (int c = 0; c < 8; ++c) dot[c] = wave_sum(dot[c]);
                    if (lane == 0 && (r == 0 || two)) { GAS f32x4* ao = (GAS f32x4*)(ab + (size_t)(r ? m1 : m0) * 8); ao[0] = (f32x4){dot[0], dot[1], dot[2], dot[3]}; ao[1] = (f32x4){dot[4], dot[5], dot[6], dot[7]}; }
                }
            }
        }
    }
    if constexpr (AB) __syncthreads();
}

__device__ __forceinline__ void ab_rows_phase(Frame& F, const float* x, const float* g, const float* win_l, float* ab) {
    PHASE_TID();
    LAS float* w8 = (LAS float*)(F.lds + RING_OFF);
    __syncthreads();
    for (int i = tid; i < D * 8; i += NWAVES * 64) { const int k = i >> 3, c = i & 7; w8[i] = win_l[(size_t)k * INW + SRC_AB + c]; }
    __syncthreads();
    for (int m = F.gw; m < M; m += F.NGW) {
        asm volatile("" ::: "memory");
        const GAS f32x4* xr = (const GAS f32x4*)(x + (size_t)m * D) + lane; const GAS f32x4* gn = (const GAS f32x4*)g + lane;
        f32x4 v[8]; float s = 0.f;
#pragma unroll
        for (int j = 0; j < 8; ++j) { v[j] = xr[64 * j]; s += (v[j].x * v[j].x + v[j].y * v[j].y) + (v[j].z * v[j].z + v[j].w * v[j].w); }
        const float r2 = 1.0f / sqrtf(wave_sum(s) * (1.f / D) + NORM_EPS);
        float dot[8];
#pragma unroll
        for (int c = 0; c < 8; ++c) dot[c] = 0.f;
#pragma unroll
        for (int j = 0; j < 8; ++j) { const f32x4 gg = gn[64 * j]; const f32x4 hv = (v[j] * gg) * r2;
            const LAS f32x4* wp = (const LAS f32x4*)(w8 + (size_t)(j * 256 + lane * 4) * 8);
#pragma unroll
            for (int e = 0; e < 4; ++e) { const f32x4 wa = wp[2 * e], wb = wp[2 * e + 1]; const float hh = hv[e];
                dot[0] += hh * wa.x; dot[1] += hh * wa.y; dot[2] += hh * wa.z; dot[3] += hh * wa.w; dot[4] += hh * wb.x; dot[5] += hh * wb.y; dot[6] += hh * wb.z; dot[7] += hh * wb.w; } }
#pragma unroll
        for (int c = 0; c < 8; ++c) dot[c] = wave_sum(dot[c]);
        if (lane == 0) { GAS f32x4* ao = (GAS f32x4*)(ab + (size_t)m * 8); ao[0] = (f32x4){dot[0], dot[1], dot[2], dot[3]}; ao[1] = (f32x4){dot[4], dot[5], dot[6], dot[7]}; }
    }
    __syncthreads();
}
struct MixP {
    const float *sinks, *convw, *a_log, *dt_bias, *dn_norm_w, *s5_a_re, *s5_a_im, *s5_log_dt, *s5_b_re, *s5_b_im, *s5_c_re, *s5_c_im, *s5_d;
    const float *rope_cos, *rope_sin;
    const bf16* z; const float* ab; float* bg; float* kr; float *qn, *kn, *vc; float* oraw; float* ys; bf16* ysb; bf16* mixed;
};
__device__ __forceinline__ void prep_phase(Frame& F, const MixP& P) {
    PHASE_TID();
    for (int t = F.gw; t < M; t += F.NGW) {
        const int pos = t & (SEQ - 1);
        const bf16* zr = P.z + (size_t)t * ZW;
        const float c = P.rope_cos[pos * 64 + lane], s = P.rope_sin[pos * 64 + lane];
#pragma unroll
        for (int hh = 0; hh < 2; ++hh) { const float x1 = bf2f(zr[Z_AK + hh * 128 + lane]), x2 = bf2f(zr[Z_AK + hh * 128 + 64 + lane]);
            P.kr[(size_t)t * 256 + hh * 128 + lane] = x1 * c - x2 * s; P.kr[(size_t)t * 256 + hh * 128 + 64 + lane] = x2 * c + x1 * s; }
#pragma unroll 1
        for (int hc = 0; hc < 12; ++hc) {
            float v0 = 0.f, v1 = 0.f; const int ch = hc * 128 + lane;
#pragma unroll
            for (int k = 0; k < 4; ++k) { const int tp = pos - 3 + k; if (tp >= 0) { const bf16* zq = P.z + (size_t)(t - 3 + k) * ZW + Z_DQKV + ch; const float* cw = P.convw + k * 1536 + ch;
                v0 += cw[0] * bf2f(zq[0]); v1 += cw[64] * bf2f(zq[64]); } }
            v0 = v0 * sigmoid_f(v0); v1 = v1 * sigmoid_f(v1);
            if (hc < 8) { const float r = 1.0f / sqrtf(wave_sum(v0 * v0 + v1 * v1) + NORM_EPS); v0 *= r; v1 *= r; }
            float* dst = P.qn + (size_t)(hc >> 2) * ((size_t)M * 512) + (size_t)t * 512 + (hc & 3) * 128 + lane;
            dst[0] = v0; dst[64] = v1;
        }
        if (lane < 4) { const float br = P.ab[(size_t)t * 8 + lane], ar = P.ab[(size_t)t * 8 + 4 + lane] + P.dt_bias[lane];
            const float sp = fmaxf(ar, 0.f) + log1pf(__expf(-fabsf(ar)));
            P.bg[(size_t)t * 8 + lane] = sigmoid_f(br); P.bg[(size_t)t * 8 + 4 + lane] = -__expf(P.a_log[lane]) * sp; }
    }
}
__device__ __forceinline__ void slow_deltanet(Frame& F, const MixP& P, int bh) {
    PHASE_TID();
    const int b = bh >> 2, h = bh & 3, v = tid & 127, rg = tid >> 7;
    LAS float* qs = (LAS float*)(F.lds + RING_OFF); LAS float* ks = qs + 64 * 128; LAS float* vs = ks + 64 * 128; LAS float* bgs = vs + 64 * 128;
    LAS float* part = bgs + 128; LAS float* part2 = part + 512;
    float S[32];
#pragma unroll
    for (int i = 0; i < 32; ++i) S[i] = 0.f;
    for (int cch = 0; cch < SEQ / 64; ++cch) {
        const int t0 = b * SEQ + cch * 64;
        __syncthreads();
        for (int i = tid; i < 64 * 128; i += 512) { const int r = i >> 7, cc = i & 127; const size_t g = (size_t)(t0 + r) * 512 + h * 128 + cc; qs[i] = P.qn[g]; ks[i] = P.kn[g]; vs[i] = P.vc[g]; }
        if (tid < 64) { bgs[tid * 2] = P.bg[(size_t)(t0 + tid) * 8 + h]; bgs[tid * 2 + 1] = P.bg[(size_t)(t0 + tid) * 8 + 4 + h]; }
        __syncthreads();
        for (int i = 0; i < 64; ++i) {
            const LAS float* kp = ks + i * 128 + rg * 32; const LAS float* qp = qs + i * 128 + rg * 32;
            float r = 0.f;
#pragma unroll
            for (int kk = 0; kk < 32; ++kk) r += kp[kk] * S[kk];
            part[rg * 128 + v] = r;
            __syncthreads();
            const float rt = (part[v] + part[128 + v]) + (part[256 + v] + part[384 + v]);
            const float beta = bgs[2 * i], eg = __expf(bgs[2 * i + 1]);
            const float vn = beta * (vs[i * 128 + v] - eg * rt);
            float o = 0.f;
#pragma unroll
            for (int kk = 0; kk < 32; ++kk) { S[kk] = eg * S[kk] + kp[kk] * vn; o += qp[kk] * S[kk]; }
            part2[rg * 128 + v] = o;
            __syncthreads();
            if (rg == 0) P.oraw[(size_t)(t0 + i) * 512 + h * 128 + v] = ((part2[v] + part2[128 + v]) + (part2[256 + v] + part2[384 + v])) * 0.08838834764831845f;
        }
    }
}
__device__ __forceinline__ void slow_s5(Frame& F, const MixP& P, int task) {
    PHASE_TID();
    const int b = task >> 5, g = task & 31, p = lane;
    const double dt = (double)expf(P.s5_log_dt[g]);
    const double are = (double)P.s5_a_re[g * 64 + p], aim = (double)P.s5_a_im[g * 64 + p];
    double trev = aim * dt * 0.15915494309189535; trev -= __builtin_rint(trev);
    float sn, cs; sincos_rev(trev, sn, cs);
    const float er = __expf((float)(are * dt));
    const float ar = er * cs, ai = er * sn;
    const float lr = (float)are, li = (float)aim, den = lr * lr + li * li;
    const float nr = ar - 1.0f, ni = ai;
    const float cfr = (nr * lr + ni * li) / den, cfi = (ni * lr - nr * li) / den;
    float bbr[16], bbi[16], ccr[16], cci[16], dd[16];
#pragma unroll
    for (int hh = 0; hh < 16; ++hh) { const float br = P.s5_b_re[(g * 64 + p) * 16 + hh], bi = P.s5_b_im[(g * 64 + p) * 16 + hh];
        bbr[hh] = cfr * br - cfi * bi; bbi[hh] = cfr * bi + cfi * br;
        ccr[hh] = P.s5_c_re[(g * 16 + hh) * 64 + p]; cci[hh] = P.s5_c_im[(g * 16 + hh) * 64 + p]; dd[hh] = P.s5_d[g * 16 + hh]; }
    float xr = 0.f, xi = 0.f;
    for (int t = 0; t < SEQ; ++t) {
        const size_t tok = (size_t)b * SEQ + t;
        const v4u u0 = *(const GAS v4u*)(P.z + tok * ZW + Z_S5 + g * 16), u1 = *(const GAS v4u*)(P.z + tok * ZW + Z_S5 + g * 16 + 8);
        float u[16]; u[0] = bflo(u0.x); u[1] = bfhi(u0.x); u[2] = bflo(u0.y); u[3] = bfhi(u0.y); u[4] = bflo(u0.z); u[5] = bfhi(u0.z); u[6] = bflo(u0.w); u[7] = bfhi(u0.w);
        u[8] = bflo(u1.x); u[9] = bfhi(u1.x); u[10] = bflo(u1.y); u[11] = bfhi(u1.y); u[12] = bflo(u1.z); u[13] = bfhi(u1.z); u[14] = bflo(u1.w); u[15] = bfhi(u1.w);
        float br = 0.f, bi = 0.f;
#pragma unroll
        for (int hh = 0; hh < 16; ++hh) { br += bbr[hh] * u[hh]; bi += bbi[hh] * u[hh]; }
        const float nxr = ar * xr - ai * xi + br, nxi = ar * xi + ai * xr + bi; xr = nxr; xi = nxi;
        float yo = 0.f;
#pragma unroll
        for (int hh = 0; hh < 16; ++hh) { const float yy = wave_sum(ccr[hh] * xr - cci[hh] * xi) + dd[hh] * u[hh]; yo = (p == hh) ? yy : yo; }
        if (p < 16) { const float ge = gelu_tanh(yo); P.ys[tok * 512 + g * 16 + p] = ge; P.ysb[tok * 512 + g * 16 + p] = (bf16)f2bf(ge); }
    }
}
__device__ __forceinline__ void slow_attention(Frame& F, const MixP& P, int aw, int naw) {
    PHASE_TID();
    LAS float* qs = (LAS float*)(F.lds + RING_OFF + F.wave * 1024);
    for (int task = aw; task < M * 8; task += naw) {
        const int t = task >> 3, head = task & 7, pos = t & (SEQ - 1), kvh = head >> 2;
        const bf16* zr = P.z + (size_t)t * ZW;
        { const float x1 = bf2f(zr[Z_AQ + head * 128 + lane]), x2 = bf2f(zr[Z_AQ + head * 128 + 64 + lane]);
          const float c = P.rope_cos[pos * 64 + lane], s = P.rope_sin[pos * 64 + lane];
          LDS_WAIT(); asm volatile("" ::: "memory");
          qs[lane] = (x1 * c - x2 * s) * 0.08838834764831845f; qs[lane + 64] = (x2 * c + x1 * s) * 0.08838834764831845f;
          LDS_WAIT(); asm volatile("" ::: "memory"); }
        float sc[2];
#pragma unroll
        for (int kk = 0; kk < 2; ++kk) { const int off = lane + 64 * kk; float a = -INFINITY;
            if (pos - off >= 0) { const GAS f32x4* kp = (const GAS f32x4*)(P.kr + (size_t)(t - off) * 256 + kvh * 128); const LAS f32x4* qp = (const LAS f32x4*)qs; float d = 0.f;
#pragma unroll 8
                for (int i = 0; i < 32; ++i) { const f32x4 kv = kp[i], qv = qp[i]; d += (kv.x * qv.x + kv.y * qv.y) + (kv.z * qv.z + kv.w * qv.w); }
                a = d; }
            sc[kk] = a; }
        const float sink = P.sinks[head];
        const float mx = fmaxf(wave_max(fmaxf(sc[0], sc[1])), sink);
        const float p0 = __expf(sc[0] - mx), p1 = __expf(sc[1] - mx);
        const float denom = wave_sum(p0 + p1) + __expf(sink - mx);
        float o0 = 0.f, o1 = 0.f;
        const int nk = (pos + 1 < 128) ? pos + 1 : 128;
        for (int jj = 0; jj < nk; ++jj) { const float pj = (jj < 64) ? __shfl(p0, jj) : __shfl(p1, jj - 64);
            const unsigned w = *(const GAS unsigned*)(P.z + (size_t)(t - jj) * ZW + Z_AV + kvh * 128 + 2 * lane);
            o0 += pj * bflo(w); o1 += pj * bfhi(w); }
        const float inv = 1.0f / denom;
        *(GAS unsigned*)(P.mixed + (size_t)t * MIXW + head * 128 + 2 * lane) = pk2(o0 * inv, o1 * inv);
    }
}
__device__ __forceinline__ void dn_post_rows(Frame& F, const MixP& P) {
    PHASE_TID();
    for (int t = F.gw; t < M; t += F.NGW) {
#pragma unroll
        for (int h = 0; h < 4; ++h) { const float a = P.oraw[(size_t)t * 512 + h * 128 + lane], b2 = P.oraw[(size_t)t * 512 + h * 128 + 64 + lane];
            const float r = 1.0f / sqrtf(wave_sum(a * a + b2 * b2) * (1.f / 128.f) + NORM_EPS);
            const float z0 = bf2f(P.z[(size_t)t * ZW + Z_DZ + h * 128 + lane]), z1 = bf2f(P.z[(size_t)t * ZW + Z_DZ + h * 128 + 64 + lane]);
            P.mixed[(size_t)t * MIXW + 1024 + h * 128 + lane] = (bf16)f2bf(a * r * P.dn_norm_w[lane] * z0 * sigmoid_f(z0));
            P.mixed[(size_t)t * MIXW + 1024 + h * 128 + 64 + lane] = (bf16)f2bf(b2 * r * P.dn_norm_w[64 + lane] * z1 * sigmoid_f(z1)); }
    }
}
constexpr int AT_KS = 136, AT_VS = 264;
constexpr int AT_K_OFF = 0, AT_V_OFF = 256 * AT_KS * 2;
static_assert(AT_V_OFF + 128 * AT_VS * 2 <= MISC_OFF, "attention LDS");
constexpr int ATT_UNITS = 256;
__device__ __forceinline__ void rope8(const v4u a, const v4u b, const float* cp, const float* sp, float scale, v4u& o1, v4u& o2) {
    const f32x4 c0 = *(const GAS f32x4*)cp, c1 = *(const GAS f32x4*)(cp + 4), s0 = *(const GAS f32x4*)sp, s1 = *(const GAS f32x4*)(sp + 4);
    const float c[8] = {c0.x, c0.y, c0.z, c0.w, c1.x, c1.y, c1.z, c1.w}, s[8] = {s0.x, s0.y, s0.z, s0.w, s1.x, s1.y, s1.z, s1.w};
    const unsigned aw[4] = {a.x, a.y, a.z, a.w}, bw[4] = {b.x, b.y, b.z, b.w}; unsigned r1[4], r2[4];
#pragma unroll
    for (int i = 0; i < 4; ++i) { const float x1l = bflo(aw[i]), x1h = bfhi(aw[i]), x2l = bflo(bw[i]), x2h = bfhi(bw[i]);
        r1[i] = pk2((x1l * c[2 * i] - x2l * s[2 * i]) * scale, (x1h * c[2 * i + 1] - x2h * s[2 * i + 1]) * scale);
        r2[i] = pk2((x2l * c[2 * i] + x1l * s[2 * i]) * scale, (x2h * c[2 * i + 1] + x1h * s[2 * i + 1]) * scale); }
    o1 = (v4u){r1[0], r1[1], r1[2], r1[3]}; o2 = (v4u){r2[0], r2[1], r2[2], r2[3]};
}
__device__ __forceinline__ void attn_unit(Frame& F, const MixP& P, int unit) {
    PHASE_TID();
    const int half = unit & 1, kvh = (unit >> 1) & 1, blk = (unit >> 2) & 31, b = unit >> 7;
    LAS bf16* Kl = (LAS bf16*)(F.lds + AT_K_OFF); LAS bf16* Vt = (LAS bf16*)(F.lds + AT_V_OFF);
    const int tok0 = b * SEQ + (blk - 1) * 128;
    for (int it = tid; it < 2048; it += NWAVES * 64) {
        const int key = it >> 3, dg = it & 7; v4u o1 = (v4u){0u, 0u, 0u, 0u}, o2 = o1;
        if (blk > 0 || key >= 128) { const int pos = (blk - 1) * 128 + key; const bf16* zr = P.z + (size_t)(tok0 + key) * ZW + Z_AK + kvh * 128 + 8 * dg;
            rope8(*(const GAS v4u*)zr, *(const GAS v4u*)(zr + 64), P.rope_cos + pos * 64 + 8 * dg, P.rope_sin + pos * 64 + 8 * dg, 1.0f, o1, o2); }
        *(LAS v4u*)(Kl + key * AT_KS + 8 * dg) = o1; *(LAS v4u*)(Kl + key * AT_KS + 64 + 8 * dg) = o2;
    }
    for (int it = tid; it < 4096; it += NWAVES * 64) {
        const int key = it >> 4, dg = it & 15; v4u a = (v4u){0u, 0u, 0u, 0u};
        if (blk > 0 || key >= 128) a = *(const GAS v4u*)(P.z + (size_t)(tok0 + key) * ZW + Z_AV + kvh * 128 + 8 * dg);
        LAS bf16* vp = Vt + (8 * dg) * AT_VS + key;
        vp[0 * AT_VS] = (bf16)(a.x & 0xffffu); vp[1 * AT_VS] = (bf16)(a.x >> 16); vp[2 * AT_VS] = (bf16)(a.y & 0xffffu); vp[3 * AT_VS] = (bf16)(a.y >> 16);
        vp[4 * AT_VS] = (bf16)(a.z & 0xffffu); vp[5 * AT_VS] = (bf16)(a.z >> 16); vp[6 * AT_VS] = (bf16)(a.w & 0xffffu); vp[7 * AT_VS] = (bf16)(a.w >> 16);
    }
    __syncthreads();
    const int w = F.wave, n = lane & 15, q4 = lane >> 4, r0 = 16 * w, T0 = w & ~1;
    const int posq = blk * 128 + r0 + n; const size_t tq = (size_t)b * SEQ + posq;
#pragma unroll 1
    for (int hh = 0; hh < 2; ++hh) {
        asm volatile("" ::: "memory");
        const int head = kvh * 4 + half * 2 + hh;
        bf16x8 qf[4];
        { const bf16* zq = P.z + tq * ZW + Z_AQ + head * 128 + 8 * q4;
          const v4u x0 = *(const GAS v4u*)zq, x1 = *(const GAS v4u*)(zq + 32), x2 = *(const GAS v4u*)(zq + 64), x3 = *(const GAS v4u*)(zq + 96);
          v4u o0, o1, o2, o3;
          rope8(x0, x2, P.rope_cos + posq * 64 + 8 * q4, P.rope_sin + posq * 64 + 8 * q4, 0.08838834764831845f, o0, o2);
          rope8(x1, x3, P.rope_cos + posq * 64 + 32 + 8 * q4, P.rope_sin + posq * 64 + 32 + 8 * q4, 0.08838834764831845f, o1, o3);
          qf[0] = __builtin_bit_cast(bf16x8, o0); qf[1] = __builtin_bit_cast(bf16x8, o1); qf[2] = __builtin_bit_cast(bf16x8, o2); qf[3] = __builtin_bit_cast(bf16x8, o3); }
        f32x4 sacc[10];
#pragma unroll
        for (int kt = 0; kt < 10; ++kt) { sacc[kt] = (f32x4){0.f, 0.f, 0.f, 0.f};
#pragma unroll
            for (int ks = 0; ks < 4; ++ks) { const bf16x8 kf = *(const LAS bf16x8*)(Kl + (16 * (T0 + kt) + n) * AT_KS + 32 * ks + 8 * q4);
                sacc[kt] = __builtin_amdgcn_mfma_f32_16x16x32_bf16(kf, qf[ks], sacc[kt], 0, 0, 0); } }
        const float sink = P.sinks[head];
        float mx = -INFINITY;
#pragma unroll
        for (int kt = 0; kt < 10; ++kt)
#pragma unroll
            for (int r = 0; r < 4; ++r) { const int kw = 16 * (T0 + kt) + 4 * q4 + r, rel = 128 + r0 + n - kw; const bool vis = (rel >= 0) && (rel < 128) && (blk > 0 || kw >= 128);
                const float sv = vis ? sacc[kt][r] : -INFINITY; sacc[kt][r] = sv; mx = fmaxf(mx, sv); }
        mx = fmaxf(mx, __shfl_xor(mx, 16)); mx = fmaxf(mx, __shfl_xor(mx, 32)); mx = fmaxf(mx, sink);
        float sum = 0.f;
#pragma unroll
        for (int kt = 0; kt < 10; ++kt)
#pragma unroll
            for (int r = 0; r < 4; ++r) { const float p = __expf(sacc[kt][r] - mx); sacc[kt][r] = p; sum += p; }
        sum += __shfl_xor(sum, 16); sum += __shfl_xor(sum, 32); sum += __expf(sink - mx);
        f32x4 oacc[8];
#pragma unroll
        for (int dt = 0; dt < 8; ++dt) oacc[dt] = (f32x4){0.f, 0.f, 0.f, 0.f};
#pragma unroll
        for (int kp = 0; kp < 5; ++kp) {
            v4u pw; pw.x = pk2(sacc[2 * kp][0], sacc[2 * kp][1]); pw.y = pk2(sacc[2 * kp][2], sacc[2 * kp][3]); pw.z = pk2(sacc[2 * kp + 1][0], sacc[2 * kp + 1][1]); pw.w = pk2(sacc[2 * kp + 1][2], sacc[2 * kp + 1][3]);
            const bf16x8 pf = __builtin_bit_cast(bf16x8, pw);
#pragma unroll
            for (int dt = 0; dt < 8; ++dt) { const LAS bf16* vp = Vt + (16 * dt + n) * AT_VS + 16 * (T0 + 2 * kp) + 4 * q4;
                const v2u lo = *(const LAS v2u*)vp, hi = *(const LAS v2u*)(vp + 16);
                const bf16x8 vf = __builtin_bit_cast(bf16x8, (v4u){lo.x, lo.y, hi.x, hi.y});
                oacc[dt] = __builtin_amdgcn_mfma_f32_16x16x32_bf16(vf, pf, oacc[dt], 0, 0, 0); } }
        const float inv = 1.0f / sum;
        bf16* op = P.mixed + tq * MIXW + head * 128 + 4 * q4;
#pragma unroll
        for (int dt = 0; dt < 8; ++dt) { v2u o; o.x = pk2(oacc[dt][0] * inv, oacc[dt][1] * inv); o.y = pk2(oacc[dt][2] * inv, oacc[dt][3] * inv); *(GAS v2u*)(op + 16 * dt) = o; }
    }
    __syncthreads();
}
constexpr size_t S5T_K = 0, S5T_P = 8704, S5T_Q = S5T_P + 65536, S5T_A16 = S5T_Q + 65536, S5T_STRIDE = S5T_A16 + 512;
static_assert(S5T_STRIDE % 256 == 0, "s5 table stride");
__device__ __forceinline__ void s5_tables(Frame& F, const float* a_re, const float* a_im, const float* log_dt, const float* b_re, const float* b_im, const float* c_re, const float* c_im, unsigned char* tb, int g) {
    PHASE_TID();
    LAS float* apow = (LAS float*)(F.lds + RING_OFF);
    LAS float* bbar = apow + 17 * 128;
    LAS float* cc = bbar + 2048;
    __syncthreads();
    const float dtf = expf(log_dt[g]);
    for (int e = tid; e < 17 * 64; e += NWAVES * 64) { const int nn = e >> 6, p = e & 63; const double dt = (double)dtf;
        double trev = (double)a_im[g * 64 + p] * dt * (double)nn * 0.15915494309189535; trev -= __builtin_rint(trev);
        float sn, cs; sincos_rev(trev, sn, cs); const float er = expf((float)((double)a_re[g * 64 + p] * dt * (double)nn));
        apow[e * 2] = er * cs; apow[e * 2 + 1] = er * sn; }
    __syncthreads();
    for (int e = tid; e < 1024; e += NWAVES * 64) { const int p = e >> 4;
        const float lr = a_re[g * 64 + p], li = a_im[g * 64 + p], den = lr * lr + li * li, nr = apow[(64 + p) * 2] - 1.0f, ni = apow[(64 + p) * 2 + 1];
        const float cfr = (nr * lr + ni * li) / den, cfi = (ni * lr - nr * li) / den; const float br = b_re[g * 1024 + e], bi = b_im[g * 1024 + e];
        bbar[e * 2] = cfr * br - cfi * bi; bbar[e * 2 + 1] = cfr * bi + cfi * br;
        cc[e * 2] = c_re[g * 1024 + e]; cc[e * 2 + 1] = c_im[g * 1024 + e]; }
    __syncthreads();
    bf16* Ktab = (bf16*)(tb + S5T_K); bf16* Pt = (bf16*)(tb + S5T_P); bf16* Qt = (bf16*)(tb + S5T_Q); float* A16 = (float*)(tb + S5T_A16);
    for (int e = tid; e < 17 * 256; e += NWAVES * 64) { const int lag1 = e >> 8, ho = (e >> 4) & 15, hi = e & 15; float acc = 0.f;
        if (lag1 > 0) { const LAS float* ap = apow + (lag1 - 1) * 128;
            for (int p = 0; p < 64; ++p) { const float ar = ap[2 * p], ai = ap[2 * p + 1], br = bbar[(p * 16 + hi) * 2], bi = bbar[(p * 16 + hi) * 2 + 1], cr = cc[(ho * 64 + p) * 2], ci = cc[(ho * 64 + p) * 2 + 1];
                const float tr = ar * br - ai * bi, ti = ar * bi + ai * br; acc += cr * tr - ci * ti; } }
        Ktab[e] = (bf16)f2bf(acc); }
    for (int e = tid; e < 128 * 256; e += NWAVES * 64) { const int qp = e >> 8, k = e & 255, s = k >> 4, hi = k & 15, p = qp & 63;
        const float ar = apow[((15 - s) * 64 + p) * 2], ai = apow[((15 - s) * 64 + p) * 2 + 1], br = bbar[(p * 16 + hi) * 2], bi = bbar[(p * 16 + hi) * 2 + 1];
        Pt[e] = (bf16)f2bf((qp < 64) ? (ar * br - ai * bi) : (ar * bi + ai * br)); }
    for (int e = tid; e < 256 * 128; e += NWAVES * 64) { const int row = e >> 7, slot = e & 127, i = row >> 4, ho = row & 15, kp = slot >> 5, q4 = (slot >> 3) & 3, j = slot & 7;
        const int qp = (j < 4) ? (32 * kp + 4 * q4 + j) : (32 * kp + 16 + 4 * q4 + (j - 4)), p = qp & 63;
        const float ar = apow[((i + 1) * 64 + p) * 2], ai = apow[((i + 1) * 64 + p) * 2 + 1], cr = cc[(ho * 64 + p) * 2], ci = cc[(ho * 64 + p) * 2 + 1];
        Qt[e] = (bf16)f2bf((qp < 64) ? (cr * ar - ci * ai) : -(cr * ai + ci * ar)); }
    if (tid < 128) A16[tid] = apow[16 * 128 + tid];
    __syncthreads();
}
constexpr int S5_UNITS = 128;
template <bool PHB>
__device__ __forceinline__ void s5_unit(Frame& F, const MixP& P, const unsigned char* tabs_l, float* E, int unit) {
    PHASE_TID();
    const int span = unit >> 2, goct = unit & 3, b = span >> 4, u = span & 15, n = lane & 15, q4 = lane >> 4; const size_t tok0 = (size_t)b * SEQ + u * 256;
    const int g = goct * 8 + F.wave;
    const unsigned char* tb = tabs_l + (size_t)g * S5T_STRIDE;
    const bf16* Ktab = (const bf16*)(tb + S5T_K); const bf16* Pt = (const bf16*)(tb + S5T_P); const bf16* Qt = (const bf16*)(tb + S5T_Q); const float* A16 = (const float*)(tb + S5T_A16);
    float* Eb = E + ((size_t)(b * 16) * 32 + g) * 128 + 4 * q4;
    float ar[16], ai[16], yre[16], yim[16], Xr[16], Xi[16];
#define S5_LOAD_A16() _Pragma("unroll") for (int T = 0; T < 4; ++T) { const f32x4 v0 = *(const GAS f32x4*)(A16 + (16 * T + 4 * q4) * 2), v1 = *(const GAS f32x4*)(A16 + (16 * T + 4 * q4) * 2 + 4); \
        ar[4 * T] = v0.x; ai[4 * T] = v0.y; ar[4 * T + 1] = v0.z; ai[4 * T + 1] = v0.w; ar[4 * T + 2] = v1.x; ai[4 * T + 2] = v1.y; ar[4 * T + 3] = v1.z; ai[4 * T + 3] = v1.w; }
    bf16x8 ub[8];
#define S5_LOAD_UB() _Pragma("unroll") for (int ks = 0; ks < 8; ++ks) ub[ks] = *(const GAS bf16x8*)(P.z + (tok0 + 16 * n + 2 * ks + (q4 >> 1)) * ZW + Z_S5 + g * 16 + (q4 & 1) * 8)
    S5_LOAD_UB();
#pragma unroll
    for (int k = 0; k < 16; ++k) { Xr[k] = 0.f; Xi[k] = 0.f; }
    if constexpr (PHB) {
        S5_LOAD_A16();
        f32x4 en[8];
        if (u > 0) {
#pragma unroll
            for (int T = 0; T < 8; ++T) en[T] = *(const GAS f32x4*)(Eb + 16 * T);
        }
#pragma unroll
        for (int sq = 0; sq < 4; ++sq)
#pragma unroll
            for (int k = 0; k < 16; ++k) { const float a2 = ar[k] * ar[k] - ai[k] * ai[k]; ai[k] = (ar[k] + ar[k]) * ai[k]; ar[k] = a2; }
        for (int up = 0; up < u; ++up) {
            f32x4 ec[8];
#pragma unroll
            for (int T = 0; T < 8; ++T) ec[T] = en[T];
            if (up + 1 < u) {
#pragma unroll
                for (int T = 0; T < 8; ++T) en[T] = *(const GAS f32x4*)(Eb + (size_t)(up + 1) * 4096 + 16 * T);
            }
#pragma unroll
            for (int k = 0; k < 16; ++k) { const float xr = Xr[k], xi = Xi[k]; Xr[k] = ar[k] * xr - ai[k] * xi + ec[k >> 2][k & 3]; Xi[k] = ar[k] * xi + ai[k] * xr + ec[4 + (k >> 2)][k & 3]; }
        }
    }
    {
        f32x4 xl[8];
        const bf16* pt = Pt + n * 256 + 8 * q4;
        if constexpr (!PHB) {
            bf16x8 fq[4][8];
#pragma unroll
            for (int hb = 0; hb < 2; ++hb) {
                asm volatile("" ::: "memory");
#pragma unroll
                for (int T = 0; T < 4; ++T)
#pragma unroll
                    for (int ks = 0; ks < 8; ++ks) fq[T][ks] = *(const GAS bf16x8*)(pt + (4 * hb + T) * 4096 + 32 * ks);
#pragma unroll
                for (int T = 0; T < 4; ++T) { xl[4 * hb + T] = (f32x4){0.f, 0.f, 0.f, 0.f};
#pragma unroll
                    for (int ks = 0; ks < 8; ++ks) xl[4 * hb + T] = __builtin_amdgcn_mfma_f32_16x16x32_bf16(fq[T][ks], ub[ks], xl[4 * hb + T], 0, 0, 0); }
            }
        } else {
        bf16x8 fa[8], fb[8];
#pragma unroll
        for (int ks = 0; ks < 8; ++ks) fa[ks] = *(const GAS bf16x8*)(pt + 32 * ks);
#pragma unroll
        for (int T = 0; T < 8; T += 2) {
            asm volatile("" ::: "memory");
#pragma unroll
            for (int ks = 0; ks < 8; ++ks) fb[ks] = *(const GAS bf16x8*)(pt + (T + 1) * 4096 + 32 * ks);
            asm volatile("" ::: "memory");
            xl[T] = (f32x4){0.f, 0.f, 0.f, 0.f};
#pragma unroll
            for (int ks = 0; ks < 8; ++ks) xl[T] = __builtin_amdgcn_mfma_f32_16x16x32_bf16(fa[ks], ub[ks], xl[T], 0, 0, 0);
            if (T + 2 < 8) {
#pragma unroll
                for (int ks = 0; ks < 8; ++ks) fa[ks] = *(const GAS bf16x8*)(pt + (T + 2) * 4096 + 32 * ks);
            }
            asm volatile("" ::: "memory");
            xl[T + 1] = (f32x4){0.f, 0.f, 0.f, 0.f};
#pragma unroll
            for (int ks = 0; ks < 8; ++ks) xl[T + 1] = __builtin_amdgcn_mfma_f32_16x16x32_bf16(fb[ks], ub[ks], xl[T + 1], 0, 0, 0);
        }
        }
#pragma unroll
        for (int k = 0; k < 16; ++k) { yre[k] = xl[k >> 2][k & 3]; yim[k] = xl[4 + (k >> 2)][k & 3]; }
    }
    asm volatile("" ::: "memory");
    S5_LOAD_A16();
    if constexpr (PHB) { if (n == 0) {
#pragma unroll
        for (int k = 0; k < 16; ++k) { yre[k] += ar[k] * Xr[k] - ai[k] * Xi[k]; yim[k] += ar[k] * Xi[k] + ai[k] * Xr[k]; } } }
#pragma unroll
    for (int d = 1; d < 16; d <<= 1) {
#pragma unroll
        for (int k = 0; k < 16; ++k) {
            const float pr = __shfl_up(yre[k], d, 16), pi = __shfl_up(yim[k], d, 16);
            if (n >= d) { yre[k] += ar[k] * pr - ai[k] * pi; yim[k] += ar[k] * pi + ai[k] * pr; }
            const float a2 = ar[k] * ar[k] - ai[k] * ai[k]; ai[k] = (ar[k] + ar[k]) * ai[k]; ar[k] = a2; }
    }
    if constexpr (!PHB) {
        if (n == 15) {
#pragma unroll
            for (int T = 0; T < 4; ++T) { *(GAS f32x4*)(Eb + (size_t)u * 4096 + 16 * T) = (f32x4){yre[4 * T], yre[4 * T + 1], yre[4 * T + 2], yre[4 * T + 3]};
                *(GAS f32x4*)(Eb + (size_t)u * 4096 + 64 + 16 * T) = (f32x4){yim[4 * T], yim[4 * T + 1], yim[4 * T + 2], yim[4 * T + 3]}; }
        }
    } else {
#pragma unroll
        for (int k = 0; k < 16; ++k) { const float pr = __shfl_up(yre[k], 1, 16), pi = __shfl_up(yim[k], 1, 16); yre[k] = (n == 0) ? Xr[k] : pr; yim[k] = (n == 0) ? Xi[k] : pi; }
        bf16x8 xb[4];
#pragma unroll
        for (int kp = 0; kp < 2; ++kp) { v4u w; w.x = pk2(yre[8 * kp], yre[8 * kp + 1]); w.y = pk2(yre[8 * kp + 2], yre[8 * kp + 3]); w.z = pk2(yre[8 * kp + 4], yre[8 * kp + 5]); w.w = pk2(yre[8 * kp + 6], yre[8 * kp + 7]);
            xb[kp] = __builtin_bit_cast(bf16x8, w);
            v4u w2; w2.x = pk2(yim[8 * kp], yim[8 * kp + 1]); w2.y = pk2(yim[8 * kp + 2], yim[8 * kp + 3]); w2.z = pk2(yim[8 * kp + 4], yim[8 * kp + 5]); w2.w = pk2(yim[8 * kp + 6], yim[8 * kp + 7]);
            xb[2 + kp] = __builtin_bit_cast(bf16x8, w2); }
        const f32x4 dsk = *(const GAS f32x4*)(P.s5_d + g * 16 + 4 * q4);
        const bf16* qp0 = Qt + n * 128 + q4 * 8;
        const bf16* kp00 = Ktab + (1 - (q4 >> 1)) * 256 + n * 16 + (q4 & 1) * 8;
        const bf16* zu = P.z + (tok0 + 16 * n) * ZW + Z_S5 + g * 16 + 4 * q4;
        float* yo = P.ys + (tok0 + 16 * n) * 512 + g * 16 + 4 * q4; bf16* yob = P.ysb + (tok0 + 16 * n) * 512 + g * 16 + 4 * q4;
        bf16x8 qa[4], ka[8], qb[4], kb[8]; v2u ua, ubw;
#define S5_REQ(i_, qf, kf, uw) do { _Pragma("unroll") for (int kp = 0; kp < 4; ++kp) qf[kp] = *(const GAS bf16x8*)(qp0 + (i_) * 2048 + kp * 32); \
            _Pragma("unroll") for (int ks = 0; ks < 8; ++ks) if (2 * ks <= (i_)) kf[ks] = *(const GAS bf16x8*)(kp00 + (i_) * 256 - ks * 512); \
            uw = *(const GAS v2u*)(zu + (size_t)(i_) * ZW); } while (0)
#define S5_OUT(i_, qf, kf, uw) do { f32x4 acc = (f32x4){0.f, 0.f, 0.f, 0.f}; \
            _Pragma("unroll") for (int kp = 0; kp < 4; ++kp) acc = __builtin_amdgcn_mfma_f32_16x16x32_bf16(qf[kp], xb[kp], acc, 0, 0, 0); \
            _Pragma("unroll") for (int ks = 0; ks < 8; ++ks) if (2 * ks <= (i_)) acc = __builtin_amdgcn_mfma_f32_16x16x32_bf16(kf[ks], ub[ks], acc, 0, 0, 0); \
            f32x4 yv; yv.x = gelu_tanh(acc.x + dsk.x * bflo(uw.x)); yv.y = gelu_tanh(acc.y + dsk.y * bfhi(uw.x)); yv.z = gelu_tanh(acc.z + dsk.z * bflo(uw.y)); yv.w = gelu_tanh(acc.w + dsk.w * bfhi(uw.y)); \
            *(GAS f32x4*)(yo + (size_t)(i_) * 512) = yv; v2u ob; ob.x = pk2(yv.x, yv.y); ob.y = pk2(yv.z, yv.w); *(GAS v2u*)(yob + (size_t)(i_) * 512) = ob; } while (0)
        S5_REQ(0, qa, ka, ua);
#pragma unroll 1
        for (int i = 0; i < 16; i += 2) {
            asm volatile("" ::: "memory");
            S5_REQ(i + 1, qb, kb, ubw);
            asm volatile("" ::: "memory");
            S5_OUT(i, qa, ka, ua);
            if (i + 2 < 16) S5_REQ(i + 2, qa, ka, ua);
            asm volatile("" ::: "memory");
            S5_OUT(i + 1, qb, kb, ubw);
        }
#undef S5_REQ
#undef S5_OUT
    }
}
#undef S5_LOAD_A16
#undef S5_LOAD_UB
constexpr int DN_LS = 132, DN_MS = 68, DN_TS = 20;
constexpr int DN_Q_OFF = 0, DN_K_OFF = 64 * DN_LS * 4, DN_V_OFF = 2 * DN_K_OFF, DN_L_OFF = 3 * DN_K_OFF, DN_A_OFF = DN_L_OFF + 64 * DN_MS * 4, DN_T_OFF = DN_A_OFF + 64 * DN_MS * 4, DN_G_OFF = DN_T_OFF + 64 * DN_TS * 4;
static_assert(DN_G_OFF + 1024 <= MISC_OFF, "deltanet chunk LDS");
constexpr size_t DNC_W = 0, DNC_QD = 16384, DNC_AT = 32768, DNC_KD = 40960, DNC_U = 57344, DNC_GATE = 90112, DNC_EGL = 106496, DNC_STRIDE = 106752;
constexpr int DNC_OPS = 57344;
__device__ __forceinline__ void dn_chunk_unit(Frame& F, const MixP& P, unsigned char* dnc, int unit) {
    PHASE_TID();
    const int h = unit & 3, cn = (unit >> 2) & 63, b = unit >> 8;
    const int t0 = b * SEQ + cn * 64, pos0 = cn * 64;
    unsigned char* cb = dnc + (size_t)((b * 4 + h) * 64 + cn) * DNC_STRIDE;
    LAS float* qs = (LAS float*)(F.lds + DN_Q_OFF); LAS float* ks = (LAS float*)(F.lds + DN_K_OFF); LAS float* vs = (LAS float*)(F.lds + DN_V_OFF);
    LAS float* Lm = (LAS float*)(F.lds + DN_L_OFF); LAS float* At = (LAS float*)(F.lds + DN_A_OFF); LAS float* Td = (LAS float*)(F.lds + DN_T_OFF);
    LAS float* gcs = (LAS float*)(F.lds + DN_G_OFF); LAS float* betas = gcs + 64; LAS float* egs = gcs + 128; LAS float* gsm = gcs + 192;
    __syncthreads();
    if (tid < 384) { const int oct = tid & 7, pc = tid >> 3, part = pc >> 4, cg = pc & 15, ch = part * 512 + h * 128 + 8 * cg, tk0 = 8 * oct;
        v4u zr[11]; f32x4 wv[4][2];
#pragma unroll
        for (int j = 0; j < 11; ++j) { zr[j] = (v4u){0u, 0u, 0u, 0u}; if (pos0 + tk0 - 3 + j >= 0) zr[j] = *(const GAS v4u*)(P.z + (size_t)(t0 + tk0 - 3 + j) * ZW + Z_DQKV + ch); }
#pragma unroll
        for (int k = 0; k < 4; ++k) { wv[k][0] = *(const GAS f32x4*)(P.convw + k * 1536 + ch); wv[k][1] = *(const GAS f32x4*)(P.convw + k * 1536 + ch + 4); }
        LAS float* dst = (LAS float*)(F.lds + part * DN_K_OFF) + tk0 * DN_LS + 8 * cg;
#pragma unroll
        for (int tt = 0; tt < 8; ++tt) { float acc[8];
#pragma unroll
            for (int e = 0; e < 8; ++e) acc[e] = 0.f;
#pragma unroll
            for (int k = 0; k < 4; ++k) { const v4u zw = zr[tt + k]; const f32x4 w0 = wv[k][0], w1 = wv[k][1];
                acc[0] += w0.x * bflo(zw.x); acc[1] += w0.y * bfhi(zw.x); acc[2] += w0.z * bflo(zw.y); acc[3] += w0.w * bfhi(zw.y);
                acc[4] += w1.x * bflo(zw.z); acc[5] += w1.y * bfhi(zw.z); acc[6] += w1.z * bflo(zw.w); acc[7] += w1.w * bfhi(zw.w); }
#pragma unroll
            for (int e = 0; e < 8; ++e) acc[e] = acc[e] * sigmoid_f(acc[e]);
            *(LAS f32x4*)(dst + tt * DN_LS) = (f32x4){acc[0], acc[1], acc[2], acc[3]}; *(LAS f32x4*)(dst + tt * DN_LS + 4) = (f32x4){acc[4], acc[5], acc[6], acc[7]}; } }
    if (tid < 64) { const float br = P.ab[(size_t)(t0 + tid) * 8 + h], ar = P.ab[(size_t)(t0 + tid) * 8 + 4 + h] + P.dt_bias[h];
        const float sp = fmaxf(ar, 0.f) + log1pf(__expf(-fabsf(ar)));
        betas[tid] = sigmoid_f(br); gsm[tid] = -__expf(P.a_log[h]) * sp; }
    __syncthreads();
    { const int w = F.wave;
#pragma unroll 1
      for (int rr = 0; rr < 8; ++rr) { const int row = 8 * w + rr;
          { LAS float* p = qs + row * DN_LS; const float a = p[lane], c = p[lane + 64]; const float r = 0.08838834764831845f / sqrtf(wave_sum(a * a + c * c) + NORM_EPS); p[lane] = a * r; p[lane + 64] = c * r; }
          { LAS float* p = ks + row * DN_LS; const float a = p[lane], c = p[lane + 64]; const float r = 1.0f / sqrtf(wave_sum(a * a + c * c) + NORM_EPS); p[lane] = a * r; p[lane + 64] = c * r; } }
      if (w == 0) { float g = gsm[lane];
#pragma unroll
          for (int d = 1; d < 64; d <<= 1) { const float pv = __shfl_up(g, d, 64); if (lane >= d) g += pv; }
          gcs[lane] = g; egs[lane] = __expf(g); } }
    __syncthreads();
    const int m = lane & 15, q = lane >> 4;
#pragma unroll 1
    for (int job = F.wave; job < 20; job += NWAVES) { const int kind = job >= 10, idx = job - 10 * kind; const int ti = (idx >= 6) ? 3 : (idx >= 3) ? 2 : (idx >= 1) ? 1 : 0, tj = idx - ((ti * (ti + 1)) >> 1);
        const LAS float* ap = (kind ? qs : ks) + (16 * ti + m) * DN_LS + 4 * q; const LAS float* bp = ks + (16 * tj + m) * DN_LS + 4 * q;
        f32x4 acc = (f32x4){0.f, 0.f, 0.f, 0.f};
#pragma unroll
        for (int kg = 0; kg < 8; ++kg) { const f32x4 a4 = *(const LAS f32x4*)(ap + 16 * kg), b4 = *(const LAS f32x4*)(bp + 16 * kg);
#pragma unroll
            for (int s = 0; s < 4; ++s) acc = __builtin_amdgcn_mfma_f32_16x16x4f32(a4[s], b4[s], acc, 0, 0, 0); }
        const int j = 16 * tj + m; const float gj = gcs[j];
#pragma unroll
        for (int r = 0; r < 4; ++r) { const int i = 16 * ti + 4 * q + r; const float dec = __expf(gcs[i] - gj);
            if (kind) At[i * DN_MS + j] = (i >= j) ? acc[r] * dec : 0.f; else Lm[i * DN_MS + j] = (i > j) ? acc[r] * dec * betas[i] : 0.f; } }
    __syncthreads();
    if (F.wave == 0) { float Tr[16];
#pragma unroll
        for (int r = 0; r < 16; ++r) { float acc = (m == r) ? 1.f : 0.f;
#pragma unroll
            for (int j = 0; j < 16; ++j) if (j < r) acc -= Lm[(16 * q + r) * DN_MS + 16 * q + j] * Tr[j];
            Tr[r] = acc; Td[(16 * q + r) * DN_TS + m] = acc; } }
    __syncthreads();
#pragma unroll 1
    for (int half = 0; half < 2; ++half) {
        const int ct = F.wave + 8 * half; const LAS float* rsrc = (half ? ks : vs) + 16 * F.wave + m;
        f32x4 X[4];
#pragma unroll
        for (int i = 0; i < 4; ++i) { f32x4 acc;
#pragma unroll
            for (int r = 0; r < 4; ++r) { const int row = 16 * i + 4 * q + r; const float sc = half ? betas[row] * egs[row] : betas[row]; acc[r] = rsrc[row * DN_LS] * sc; }
            f32x4 s = (f32x4){0.f, 0.f, 0.f, 0.f};
#pragma unroll
            for (int j = 0; j < 4; ++j) if (j < i) { const f32x4 a4 = *(const LAS f32x4*)(Lm + (16 * i + m) * DN_MS + 16 * j + 4 * q);
#pragma unroll
                for (int s4 = 0; s4 < 4; ++s4) s = __builtin_amdgcn_mfma_f32_16x16x4f32(a4[s4], X[j][s4], s, 0, 0, 0); }
            acc -= s;
            const f32x4 t4 = *(const LAS f32x4*)(Td + (16 * i + m) * DN_TS + 4 * q); f32x4 xi = (f32x4){0.f, 0.f, 0.f, 0.f};
#pragma unroll
            for (int s4 = 0; s4 < 4; ++s4) xi = __builtin_amdgcn_mfma_f32_16x16x4f32(t4[s4], acc[s4], xi, 0, 0, 0);
            X[i] = xi; }
        if (half == 0) {
#pragma unroll
            for (int i = 0; i < 4; ++i) *(GAS f32x4*)(cb + DNC_U + (size_t)((ct * 4 + i) * 64 + lane) * 16) = X[i];
            __syncthreads();
        } else {
#pragma unroll
            for (int i = 0; i < 4; ++i)
#pragma unroll
                for (int r = 0; r < 4; ++r) vs[(16 * i + 4 * q + r) * DN_LS + 16 * F.wave + m] = X[i][r];
        }
    }
    __syncthreads();
    const float gl = gcs[63];
#pragma unroll
    for (int rep = 0; rep < 7; ++rep) { const int e = tid + rep * (NWAVES * 64); v4u o;
        if (rep < 4) { const int e2 = e & 1023, tile = e2 >> 6, fl = e2 & 63, fm = fl & 15, fq = fl >> 4, it = tile >> 2, kss = tile & 3, tok = 16 * it + fm;
            const LAS float* src = ((rep < 2) ? vs : qs) + tok * DN_LS + 32 * kss + 4 * fq; const float sc = (rep < 2) ? 1.0f : egs[tok];
            const f32x4 lo = *(const LAS f32x4*)src, hi = *(const LAS f32x4*)(src + 16);
            o.x = pk2(lo.x * sc, lo.y * sc); o.y = pk2(lo.z * sc, lo.w * sc); o.z = pk2(hi.x * sc, hi.y * sc); o.w = pk2(hi.z * sc, hi.w * sc);
        } else if (rep == 4) { const int e2 = e - 2048, tile = e2 >> 6, fl = e2 & 63, fm = fl & 15, fq = fl >> 4, it = tile >> 1, ks2 = tile & 1, i = 16 * it + fm, j0 = 32 * ks2 + 4 * fq;
            const f32x4 lo = *(const LAS f32x4*)(At + i * DN_MS + j0), hi = *(const LAS f32x4*)(At + i * DN_MS + j0 + 16);
            float v[8] = {lo.x, lo.y, lo.z, lo.w, hi.x, hi.y, hi.z, hi.w};
#pragma unroll
            for (int jj = 0; jj < 8; ++jj) { const int j = j0 + (jj & 3) + 16 * (jj >> 2); if (j > i) v[jj] = 0.f; }
            o.x = pk2(v[0], v[1]); o.y = pk2(v[2], v[3]); o.z = pk2(v[4], v[5]); o.w = pk2(v[6], v[7]);
        } else { const int e2 = e - 2560, tile = e2 >> 6, fl = e2 & 63, fm = fl & 15, fq = fl >> 4, dt = tile >> 1, ks2 = tile & 1, dk = 16 * dt + fm, j0 = 32 * ks2 + 4 * fq; float v[8];
#pragma unroll
            for (int jj = 0; jj < 8; ++jj) { const int j = j0 + (jj & 3) + 16 * (jj >> 2); v[jj] = ks[j * DN_LS + dk] * __expf(gl - gcs[j]); }
            o.x = pk2(v[0], v[1]); o.y = pk2(v[2], v[3]); o.z = pk2(v[4], v[5]); o.w = pk2(v[6], v[7]); }
        *(GAS v4u*)(cb + (size_t)e * 16) = o; }
    if (tid == 0) *(GAS float*)(cb + DNC_EGL) = __expf(gl);
}
constexpr int DNX_BUF0 = 0, DNX_BUF1 = DNC_OPS, DNX_RED = 2 * DNC_OPS;
static_assert(DNX_RED + 2 * 8 * 64 * 4 <= MISC_OFF, "deltanet chain LDS");
#ifndef DN_DMA
#define DN_DMA 0
#endif
template <int CTRL> __device__ __forceinline__ float dppf(float x) { return __builtin_bit_cast(float, __builtin_amdgcn_mov_dpp(__builtin_bit_cast(int, x), CTRL, 0xf, 0xf, true)); }
__device__ __forceinline__ float row16_sum(float x) { x += dppf<0xB1>(x); x += dppf<0x4E>(x); x += dppf<0x141>(x); x += dppf<0x128>(x); return x; }
typedef float f32x2_t __attribute__((ext_vector_type(2))); typedef __bf16 bf16x2_t __attribute__((ext_vector_type(2)));
__device__ __forceinline__ unsigned cvtpk(float lo, float hi) { const f32x2_t v = {lo, hi}; const bf16x2_t b = __builtin_convertvector(v, bf16x2_t); return __builtin_bit_cast(unsigned, b); }
__device__ __forceinline__ bf16x8 pack8(const f32x4 a, const f32x4 b) { v4u w; w.x = cvtpk(a[0], a[1]); w.y = cvtpk(a[2], a[3]); w.z = cvtpk(b[0], b[1]); w.w = cvtpk(b[2], b[3]); return __builtin_bit_cast(bf16x8, w); }
__device__ __forceinline__ void dn_chain(Frame& F, const MixP& P, const unsigned char* dnc, int unit) {
    PHASE_TID();
    const int bh = unit >> 1, half = unit & 1, b = bh >> 2, h = bh & 3, w = F.wave, n = lane & 15, q4 = lane >> 4;
    const unsigned char* cb0 = dnc + (size_t)(bh * 64) * DNC_STRIDE;
    __syncthreads();
    if (w >= 4) {
        const unsigned so = (unsigned)((tid - 256) * 16);
        v4u s0[14], s1[14], s2[14];
#define DN_REQ(dst, chunk_) do { const unsigned char* src_ = cb0 + (size_t)((chunk_) < 64 ? (chunk_) : 63) * DNC_STRIDE + so; \
        _Pragma("unroll") for (int r = 0; r < 14; ++r) dst[r] = *(const GAS v4u*)(src_ + r * 4096); } while (0)
#define DN_PUT(bufoff, srcv) do { _Pragma("unroll") for (int r = 0; r < 14; ++r) *(LAS v4u*)(F.lds + (bufoff) + so + r * 4096) = srcv[r]; } while (0)
#define DN_SBAR() do { asm volatile("s_waitcnt lgkmcnt(0)" ::: "memory"); __builtin_amdgcn_s_barrier(); asm volatile("" ::: "memory"); } while (0)
        DN_REQ(s0, 0); DN_REQ(s1, 1); DN_REQ(s2, 2);
        DN_PUT(DNX_BUF0, s0); DN_REQ(s0, 3);
        __syncthreads();
#pragma unroll 1
        for (int c = 0; c < 60; c += 6) {
            DN_PUT(DNX_BUF1, s1); DN_REQ(s1, c + 4); DN_SBAR();
            DN_PUT(DNX_BUF0, s2); DN_REQ(s2, c + 5); DN_SBAR();
            DN_PUT(DNX_BUF1, s0); DN_REQ(s0, c + 6); DN_SBAR();
            DN_PUT(DNX_BUF0, s1); DN_REQ(s1, c + 7); DN_SBAR();
            DN_PUT(DNX_BUF1, s2); DN_REQ(s2, c + 8); DN_SBAR();
            DN_PUT(DNX_BUF0, s0); DN_REQ(s0, c + 9); DN_SBAR();
        }
        DN_PUT(DNX_BUF1, s1); DN_SBAR();
        DN_PUT(DNX_BUF0, s2); DN_SBAR();
        DN_PUT(DNX_BUF1, s0); DN_SBAR();
        DN_SBAR();
#undef DN_REQ
#undef DN_PUT
#undef DN_SBAR
    } else {
        const int sl = half * 4 + w;
        float* ob = P.oraw + ((size_t)b * SEQ + 4 * q4) * 512 + h * 128 + 16 * sl + n;
        const unsigned uoff = (unsigned)(DNC_U + ((sl * 4) * 64 + lane) * 16);
        f32x4 S[8]; bf16x8 Sb[4];
#pragma unroll
        for (int T = 0; T < 8; ++T) S[T] = (f32x4){0.f, 0.f, 0.f, 0.f};
#pragma unroll
        for (int k = 0; k < 4; ++k) Sb[k] = __builtin_bit_cast(bf16x8, (v4u){0u, 0u, 0u, 0u});
        f32x4 U0[4], U1[4]; float eg0, eg1;
#pragma unroll
        for (int it = 0; it < 4; ++it) { U0[it] = *(const GAS f32x4*)(cb0 + uoff + it * 1024); U1[it] = *(const GAS f32x4*)(cb0 + DNC_STRIDE + uoff + it * 1024); }
        eg0 = *(const GAS float*)(cb0 + DNC_EGL); eg1 = *(const GAS float*)(cb0 + DNC_STRIDE + DNC_EGL);
        __syncthreads();
#define DN_STEP(c_, BUFOFF, U_, eg_) do { \
        const LAS unsigned char* buf = F.lds + (BUFOFF); \
        bf16x8 fa[16], fb[16]; f32x4 ws[4], o[4]; \
        _Pragma("unroll") for (int t = 0; t < 16; ++t) fa[t] = *(const LAS bf16x8*)(buf + DNC_W + (t * 64 + lane) * 16); \
        _Pragma("unroll") for (int t = 0; t < 16; ++t) fb[t] = *(const LAS bf16x8*)(buf + DNC_QD + (t * 64 + lane) * 16); \
        asm volatile("" ::: "memory"); \
        _Pragma("unroll") for (int it = 0; it < 4; ++it) { ws[it] = (f32x4){0.f, 0.f, 0.f, 0.f}; o[it] = (f32x4){0.f, 0.f, 0.f, 0.f}; } \
        _Pragma("unroll") for (int ks = 0; ks < 4; ++ks) _Pragma("unroll") for (int it = 0; it < 4; ++it) ws[it] = __builtin_amdgcn_mfma_f32_16x16x32_bf16(fa[it * 4 + ks], Sb[ks], ws[it], 0, 0, 0); \
        _Pragma("unroll") for (int t = 0; t < 16; ++t) fa[t] = *(const LAS bf16x8*)(buf + DNC_KD + (t * 64 + lane) * 16); \
        asm volatile("" ::: "memory"); \
        _Pragma("unroll") for (int ks = 0; ks < 4; ++ks) _Pragma("unroll") for (int it = 0; it < 4; ++it) o[it] = __builtin_amdgcn_mfma_f32_16x16x32_bf16(fb[it * 4 + ks], Sb[ks], o[it], 0, 0, 0); \
        bf16x8 vb[2]; vb[0] = pack8(U_[0] - ws[0], U_[1] - ws[1]); vb[1] = pack8(U_[2] - ws[2], U_[3] - ws[3]); \
        _Pragma("unroll") for (int t = 0; t < 8; ++t) if (32 * (t & 1) <= 16 * (t >> 1) + 15) fb[t] = *(const LAS bf16x8*)(buf + DNC_AT + (t * 64 + lane) * 16); \
        asm volatile("" ::: "memory"); \
        _Pragma("unroll") for (int T = 0; T < 8; ++T) S[T] = S[T] * eg_; \
        _Pragma("unroll") for (int k2 = 0; k2 < 2; ++k2) _Pragma("unroll") for (int T = 0; T < 8; ++T) S[T] = __builtin_amdgcn_mfma_f32_16x16x32_bf16(fa[T * 2 + k2], vb[k2], S[T], 0, 0, 0); \
        _Pragma("unroll") for (int k2 = 0; k2 < 2; ++k2) _Pragma("unroll") for (int it = 0; it < 4; ++it) if (32 * k2 <= 16 * it + 15) o[it] = __builtin_amdgcn_mfma_f32_16x16x32_bf16(fb[it * 2 + k2], vb[k2], o[it], 0, 0, 0); \
        _Pragma("unroll") for (int k = 0; k < 4; ++k) Sb[k] = pack8(S[2 * k], S[2 * k + 1]); \
        { float* op = ob + (size_t)(c_) * (64 * 512); \
          _Pragma("unroll") for (int it = 0; it < 4; ++it) _Pragma("unroll") for (int r = 0; r < 4; ++r) op[(16 * it + r) * 512] = o[it][r]; } \
        { const unsigned char* src = cb0 + (size_t)((c_) + 2 < 64 ? (c_) + 2 : 63) * DNC_STRIDE; \
          _Pragma("unroll") for (int it = 0; it < 4; ++it) U_[it] = *(const GAS f32x4*)(src + uoff + it * 1024); \
          eg_ = *(const GAS float*)(src + DNC_EGL); } \
        asm volatile("s_waitcnt lgkmcnt(0)" ::: "memory"); __builtin_amdgcn_s_barrier(); asm volatile("" ::: "memory"); } while (0)
#pragma unroll 1
        for (int c = 0; c < 64; c += 2) {
            DN_STEP(c, DNX_BUF0, U0, eg0);
            DN_STEP(c + 1, DNX_BUF1, U1, eg1);
        }
#undef DN_STEP
    }
    asm volatile("s_waitcnt vmcnt(0)" ::: "memory");
    __syncthreads();
}
__device__ __forceinline__ void dn_chain_e(Frame& F, const MixP& P, const unsigned char* dnc, int unit) {
    PHASE_TID();
    const int bh = unit >> 1, half = unit & 1, b = bh >> 2, h = bh & 3, w = F.wave, n = lane & 15, q4 = lane >> 4;
    const unsigned char* cb0 = dnc + (size_t)(bh * 64) * DNC_STRIDE;
    __syncthreads();
    if (w >= 4) {
        const unsigned so = (unsigned)((tid - 256) * 16);
        v4u s0[14], s1[14], s2[14];
#define DN_REQ(dst, chunk_) do { const unsigned char* src_ = cb0 + (size_t)((chunk_) < 64 ? (chunk_) : 63) * DNC_STRIDE + so; \
        _Pragma("unroll") for (int r = 0; r < 14; ++r) dst[r] = *(const GAS v4u*)(src_ + r * 4096); } while (0)
#define DN_PUT(bufoff, srcv) do { _Pragma("unroll") for (int r = 0; r < 14; ++r) *(LAS v4u*)(F.lds + (bufoff) + so + r * 4096) = srcv[r]; } while (0)
#define DN_SBAR() do { asm volatile("s_waitcnt lgkmcnt(0)" ::: "memory"); __builtin_amdgcn_s_barrier(); asm volatile("" ::: "memory"); } while (0)
        DN_REQ(s0, 0); DN_REQ(s1, 1); DN_REQ(s2, 2);
        DN_PUT(DNX_BUF0, s0); DN_REQ(s0, 3);
        __syncthreads();
#pragma unroll 1
        for (int c = 0; c < 60; c += 6) {
            DN_PUT(DNX_BUF1, s1); DN_REQ(s1, c + 4); DN_SBAR();
            DN_PUT(DNX_BUF0, s2); DN_REQ(s2, c + 5); DN_SBAR();
            DN_PUT(DNX_BUF1, s0); DN_REQ(s0, c + 6); DN_SBAR();
            DN_PUT(DNX_BUF0, s1); DN_REQ(s1, c + 7); DN_SBAR();
            DN_PUT(DNX_BUF1, s2); DN_REQ(s2, c + 8); DN_SBAR();
            DN_PUT(DNX_BUF0, s0); DN_REQ(s0, c + 9); DN_SBAR();
        }
        DN_PUT(DNX_BUF1, s1); DN_SBAR();
        DN_PUT(DNX_BUF0, s2); DN_SBAR();
        DN_PUT(DNX_BUF1, s0); DN_SBAR();
        DN_SBAR();
#undef DN_REQ
#undef DN_PUT
#undef DN_SBAR
    } else {
        const int sl = half * 4 + w;
        float* ob = P.oraw + ((size_t)b * SEQ + 4 * q4) * 512 + h * 128 + 16 * sl + n;
        const unsigned uoff = (unsigned)(DNC_U + ((sl * 4) * 64 + lane) * 16);
        f32x4 S[8]; bf16x8 Sb[4];
#pragma unroll
        for (int T = 0; T < 8; ++T) S[T] = (f32x4){0.f, 0.f, 0.f, 0.f};
#pragma unroll
        for (int k = 0; k < 4; ++k) Sb[k] = __builtin_bit_cast(bf16x8, (v4u){0u, 0u, 0u, 0u});
        f32x4 U0[4], U1[4]; float eg0, eg1;
#pragma unroll
        for (int it = 0; it < 4; ++it) { U0[it] = *(const GAS f32x4*)(cb0 + uoff + it * 1024); U1[it] = *(const GAS f32x4*)(cb0 + DNC_STRIDE + uoff + it * 1024); }
        eg0 = *(const GAS float*)(cb0 + DNC_EGL); eg1 = *(const GAS float*)(cb0 + DNC_STRIDE + DNC_EGL);
        __syncthreads();
#define DN_STEP(c_, BUFOFF, U_, eg_) do { \
        const LAS unsigned char* buf = F.lds + (BUFOFF); \
        bf16x8 fa[16], fb[16]; f32x4 ws[4], o[4]; \
        _Pragma("unroll") for (int t = 0; t < 16; ++t) fa[t] = *(const LAS bf16x8*)(buf + DNC_W + (t * 64 + lane) * 16); \
        _Pragma("unroll") for (int t = 0; t < 16; ++t) fb[t] = *(const LAS bf16x8*)(buf + DNC_QD + (t * 64 + lane) * 16); \
        asm volatile("" ::: "memory"); \
        _Pragma("unroll") for (int it = 0; it < 4; ++it) { ws[it] = (f32x4){0.f, 0.f, 0.f, 0.f}; o[it] = (f32x4){0.f, 0.f, 0.f, 0.f}; } \
        _Pragma("unroll") for (int ks = 0; ks < 4; ++ks) _Pragma("unroll") for (int it = 0; it < 4; ++it) ws[it] = __builtin_amdgcn_mfma_f32_16x16x32_bf16(fa[it * 4 + ks], Sb[ks], ws[it], 0, 0, 0); \
        _Pragma("unroll") for (int t = 0; t < 16; ++t) fa[t] = *(const LAS bf16x8*)(buf + DNC_KD + (t * 64 + lane) * 16); \
        asm volatile("" ::: "memory"); \
        _Pragma("unroll") for (int ks = 0; ks < 4; ++ks) _Pragma("unroll") for (int it = 0; it < 4; ++it) o[it] = __builtin_amdgcn_mfma_f32_16x16x32_bf16(fb[it * 4 + ks], Sb[ks], o[it], 0, 0, 0); \
        bf16x8 vb[2]; vb[0] = pack8(U_[0] - ws[0], U_[1] - ws[1]); vb[1] = pack8(U_[2] - ws[2], U_[3] - ws[3]); \
        _Pragma("unroll") for (int t = 0; t < 8; ++t) if (32 * (t & 1) <= 16 * (t >> 1) + 15) fb[t] = *(const LAS bf16x8*)(buf + DNC_AT + (t * 64 + lane) * 16); \
        asm volatile("" ::: "memory"); \
        _Pragma("unroll") for (int T = 0; T < 8; ++T) S[T] = S[T] * eg_; \
        { const unsigned char* src = cb0 + (size_t)((c_) + 2 < 64 ? (c_) + 2 : 63) * DNC_STRIDE;        \
          _Pragma("unroll") for (int it = 0; it < 4; ++it) U_[it] = *(const GAS f32x4*)(src + uoff + it * 1024); \
          eg_ = *(const GAS float*)(src + DNC_EGL); } \
        asm volatile("" ::: "memory"); \
        _Pragma("unroll") for (int k2 = 0; k2 < 2; ++k2) _Pragma("unroll") for (int T = 0; T < 8; ++T) S[T] = __builtin_amdgcn_mfma_f32_16x16x32_bf16(fa[T * 2 + k2], vb[k2], S[T], 0, 0, 0); \
        _Pragma("unroll") for (int k2 = 0; k2 < 2; ++k2) _Pragma("unroll") for (int it = 0; it < 4; ++it) if (32 * k2 <= 16 * it + 15) o[it] = __builtin_amdgcn_mfma_f32_16x16x32_bf16(fb[it * 2 + k2], vb[k2], o[it], 0, 0, 0); \
        _Pragma("unroll") for (int k = 0; k < 4; ++k) Sb[k] = pack8(S[2 * k], S[2 * k + 1]); \
        { float* op = ob + (size_t)(c_) * (64 * 512); \
          _Pragma("unroll") for (int it = 0; it < 4; ++it) _Pragma("unroll") for (int r = 0; r < 4; ++r) op[(16 * it + r) * 512] = o[it][r]; } \
        asm volatile("s_waitcnt lgkmcnt(0)" ::: "memory"); __builtin_amdgcn_s_barrier(); asm volatile("" ::: "memory"); } while (0)
#pragma unroll 1
        for (int c = 0; c < 64; c += 2) {
            DN_STEP(c, DNX_BUF0, U0, eg0);
            DN_STEP(c + 1, DNX_BUF1, U1, eg1);
        }
#undef DN_STEP
    }
    asm volatile("s_waitcnt vmcnt(0)" ::: "memory");
    __syncthreads();
}
__device__ __forceinline__ void dn_chain_p(Frame& F, const MixP& P, const unsigned char* dnc, int unit) {
    PHASE_TID();
    const int bh = unit >> 1, half = unit & 1, b = bh >> 2, h = bh & 3, w = F.wave, n = lane & 15, q4 = lane >> 4;
    const unsigned char* cb0 = dnc + (size_t)(bh * 64) * DNC_STRIDE;
    __syncthreads();
    if (w >= 4) {
        const unsigned so = (unsigned)((tid - 256) * 16);
        v4u s0[14], s1[14], s2[14]; unsigned s0p, s1p, s2p;
        const unsigned po = (unsigned)(DNC_U + half * 16384 + ((tid - 256) & 127) * 128);
#define DN_REQ(dst, chunk_) do { const unsigned char* src_ = cb0 + (size_t)((chunk_) < 64 ? (chunk_) : 63) * DNC_STRIDE + so; \
        _Pragma("unroll") for (int r = 0; r < 14; ++r) dst[r] = *(const GAS v4u*)(src_ + r * 4096); \
        dst##p = *(const GAS unsigned*)(cb0 + (size_t)((chunk_) + 1 < 64 ? (chunk_) + 1 : 63) * DNC_STRIDE + po); } while (0)
#define DN_PUT(bufoff, srcv) do { _Pragma("unroll") for (int r = 0; r < 14; ++r) *(LAS v4u*)(F.lds + (bufoff) + so + r * 4096) = srcv[r]; *(LAS unsigned*)(F.lds + DNX_RED + (tid - 256) * 4) = srcv##p; } while (0)
#define DN_SBAR() do { asm volatile("s_waitcnt lgkmcnt(0)" ::: "memory"); __builtin_amdgcn_s_barrier(); asm volatile("" ::: "memory"); } while (0)
        DN_REQ(s0, 0); DN_REQ(s1, 1); DN_REQ(s2, 2);
        DN_PUT(DNX_BUF0, s0); DN_REQ(s0, 3);
        __syncthreads();
#pragma unroll 1
        for (int c = 0; c < 60; c += 6) {
            DN_PUT(DNX_BUF1, s1); DN_REQ(s1, c + 4); DN_SBAR();
            DN_PUT(DNX_BUF0, s2); DN_REQ(s2, c + 5); DN_SBAR();
            DN_PUT(DNX_BUF1, s0); DN_REQ(s0, c + 6); DN_SBAR();
            DN_PUT(DNX_BUF0, s1); DN_REQ(s1, c + 7); DN_SBAR();
            DN_PUT(DNX_BUF1, s2); DN_REQ(s2, c + 8); DN_SBAR();
            DN_PUT(DNX_BUF0, s0); DN_REQ(s0, c + 9); DN_SBAR();
        }
        DN_PUT(DNX_BUF1, s1); DN_SBAR();
        DN_PUT(DNX_BUF0, s2); DN_SBAR();
        DN_PUT(DNX_BUF1, s0); DN_SBAR();
        DN_SBAR();
#undef DN_REQ
#undef DN_PUT
#undef DN_SBAR
    } else {
        const int sl = half * 4 + w;
        float* ob = P.oraw + ((size_t)b * SEQ + 4 * q4) * 512 + h * 128 + 16 * sl + n;
        const unsigned uoff = (unsigned)(DNC_U + ((sl * 4) * 64 + lane) * 16);
        f32x4 S[8]; bf16x8 Sb[4];
#pragma unroll
        for (int T = 0; T < 8; ++T) S[T] = (f32x4){0.f, 0.f, 0.f, 0.f};
#pragma unroll
        for (int k = 0; k < 4; ++k) Sb[k] = __builtin_bit_cast(bf16x8, (v4u){0u, 0u, 0u, 0u});
        f32x4 U0[4], U1[4]; float eg0, eg1;
#pragma unroll
        for (int it = 0; it < 4; ++it) { U0[it] = *(const GAS f32x4*)(cb0 + uoff + it * 1024); U1[it] = *(const GAS f32x4*)(cb0 + DNC_STRIDE + uoff + it * 1024); }
        eg0 = 0.f; eg1 = 0.f;
        LAS float* egl = (LAS float*)(F.lds + DNX_RED + 1024);
        if (w == 0) egl[lane] = *(const GAS float*)(cb0 + (size_t)lane * DNC_STRIDE + DNC_EGL);
        asm volatile("s_waitcnt vmcnt(0) lgkmcnt(0)" ::: "memory");
        __syncthreads();
#define DN_STEP(c_, BUFOFF, U_, eg_) do { \
        const LAS unsigned char* buf = F.lds + (BUFOFF); \
        bf16x8 fa[16], fb[16]; f32x4 ws[4], o[4]; \
        _Pragma("unroll") for (int t = 0; t < 16; ++t) fa[t] = *(const LAS bf16x8*)(buf + DNC_W + (t * 64 + lane) * 16); \
        _Pragma("unroll") for (int t = 0; t < 16; ++t) fb[t] = *(const LAS bf16x8*)(buf + DNC_QD + (t * 64 + lane) * 16); \
        asm volatile("" ::: "memory"); \
        _Pragma("unroll") for (int it = 0; it < 4; ++it) { ws[it] = (f32x4){0.f, 0.f, 0.f, 0.f}; o[it] = (f32x4){0.f, 0.f, 0.f, 0.f}; } \
        _Pragma("unroll") for (int ks = 0; ks < 4; ++ks) _Pragma("unroll") for (int it = 0; it < 4; ++it) ws[it] = __builtin_amdgcn_mfma_f32_16x16x32_bf16(fa[it * 4 + ks], Sb[ks], ws[it], 0, 0, 0); \
        _Pragma("unroll") for (int t = 0; t < 16; ++t) fa[t] = *(const LAS bf16x8*)(buf + DNC_KD + (t * 64 + lane) * 16); \
        asm volatile("" ::: "memory"); \
        _Pragma("unroll") for (int ks = 0; ks < 4; ++ks) _Pragma("unroll") for (int it = 0; it < 4; ++it) o[it] = __builtin_amdgcn_mfma_f32_16x16x32_bf16(fb[it * 4 + ks], Sb[ks], o[it], 0, 0, 0); \
        bf16x8 vb[2]; vb[0] = pack8(U_[0] - ws[0], U_[1] - ws[1]); vb[1] = pack8(U_[2] - ws[2], U_[3] - ws[3]); \
        _Pragma("unroll") for (int t = 0; t < 8; ++t) if (32 * (t & 1) <= 16 * (t >> 1) + 15) fb[t] = *(const LAS bf16x8*)(buf + DNC_AT + (t * 64 + lane) * 16); \
        asm volatile("" ::: "memory"); \
        eg_ = egl[c_]; \
        _Pragma("unroll") for (int T = 0; T < 8; ++T) S[T] = S[T] * eg_; \
        _Pragma("unroll") for (int k2 = 0; k2 < 2; ++k2) _Pragma("unroll") for (int T = 0; T < 8; ++T) S[T] = __builtin_amdgcn_mfma_f32_16x16x32_bf16(fa[T * 2 + k2], vb[k2], S[T], 0, 0, 0); \
        _Pragma("unroll") for (int k2 = 0; k2 < 2; ++k2) _Pragma("unroll") for (int it = 0; it < 4; ++it) if (32 * k2 <= 16 * it + 15) o[it] = __builtin_amdgcn_mfma_f32_16x16x32_bf16(fb[it * 2 + k2], vb[k2], o[it], 0, 0, 0); \
        _Pragma("unroll") for (int k = 0; k < 4; ++k) Sb[k] = pack8(S[2 * k], S[2 * k + 1]); \
        { float* op = ob + (size_t)(c_) * (64 * 512); \
          _Pragma("unroll") for (int it = 0; it < 4; ++it) _Pragma("unroll") for (int r = 0; r < 4; ++r) op[(16 * it + r) * 512] = o[it][r]; } \
        { const unsigned char* src = cb0 + (size_t)((c_) + 2 < 64 ? (c_) + 2 : 63) * DNC_STRIDE; \
          _Pragma("unroll") for (int it = 0; it < 4; ++it) U_[it] = *(const GAS f32x4*)(src + uoff + it * 1024); \
          } \
        asm volatile("s_waitcnt lgkmcnt(0)" ::: "memory"); __builtin_amdgcn_s_barrier(); asm volatile("" ::: "memory"); } while (0)
#pragma unroll 1
        for (int c = 0; c < 64; c += 2) {
            DN_STEP(c, DNX_BUF0, U0, eg0);
            DN_STEP(c + 1, DNX_BUF1, U1, eg1);
        }
#undef DN_STEP
    }
    asm volatile("s_waitcnt vmcnt(0)" ::: "memory");
    __syncthreads();
}
#ifndef DN_PFD
#define DN_PFD 2
#endif
__device__ __forceinline__ void dn_chain_q(Frame& F, const MixP& P, const unsigned char* dnc, int unit) {
    PHASE_TID();
    const int bh = unit >> 1, half = unit & 1, b = bh >> 2, h = bh & 3, w = F.wave, n = lane & 15, q4 = lane >> 4;
    const unsigned char* cb0 = dnc + (size_t)(bh * 64) * DNC_STRIDE;
    __syncthreads();
    if (w >= 4) {
        const unsigned so = (unsigned)((tid - 256) * 16);
        v4u s0[14], s1[14], s2[14]; unsigned s0p, s1p, s2p, s0q, s1q, s2q, s0r, s1r, s2r;
        const unsigned po = (unsigned)(DNC_U + half * 16384 + ((tid - 256) & 127) * 128);
#define DN_REQ(dst, chunk_) do { const unsigned char* src_ = cb0 + (size_t)((chunk_) < 64 ? (chunk_) : 63) * DNC_STRIDE + so; \
        _Pragma("unroll") for (int r = 0; r < 14; ++r) dst[r] = *(const GAS v4u*)(src_ + r * 4096); \
        { const unsigned char* pf_ = cb0 + (size_t)((chunk_) + DN_PFD < 64 ? (chunk_) + DN_PFD : 63) * DNC_STRIDE;        \
          dst##p = *(const GAS unsigned*)(pf_ + po); dst##q = *(const GAS unsigned*)(pf_ + (tid - 256) * 128); dst##r = *(const GAS unsigned*)(pf_ + ((tid - 256) < 192 ? (tid - 256) + 256 : (tid - 256)) * 128); } } while (0)
#define DN_PUT(bufoff, srcv) do { _Pragma("unroll") for (int r = 0; r < 14; ++r) *(LAS v4u*)(F.lds + (bufoff) + so + r * 4096) = srcv[r]; *(LAS unsigned*)(F.lds + DNX_RED + (tid - 256) * 4) = srcv##p ^ srcv##q ^ srcv##r; } while (0)
#define DN_SBAR() do { asm volatile("s_waitcnt lgkmcnt(0)" ::: "memory"); __builtin_amdgcn_s_barrier(); asm volatile("" ::: "memory"); } while (0)
        DN_REQ(s0, 0); DN_REQ(s1, 1); DN_REQ(s2, 2);
        DN_PUT(DNX_BUF0, s0); DN_REQ(s0, 3);
        __syncthreads();
#pragma unroll 1
        for (int c = 0; c < 60; c += 6) {
            DN_PUT(DNX_BUF1, s1); DN_REQ(s1, c + 4); DN_SBAR();
            DN_PUT(DNX_BUF0, s2); DN_REQ(s2, c + 5); DN_SBAR();
            DN_PUT(DNX_BUF1, s0); DN_REQ(s0, c + 6); DN_SBAR();
            DN_PUT(DNX_BUF0, s1); DN_REQ(s1, c + 7); DN_SBAR();
            DN_PUT(DNX_BUF1, s2); DN_REQ(s2, c + 8); DN_SBAR();
            DN_PUT(DNX_BUF0, s0); DN_REQ(s0, c + 9); DN_SBAR();
        }
        DN_PUT(DNX_BUF1, s1); DN_SBAR();
        DN_PUT(DNX_BUF0, s2); DN_SBAR();
        DN_PUT(DNX_BUF1, s0); DN_SBAR();
        DN_SBAR();
#undef DN_REQ
#undef DN_PUT
#undef DN_SBAR
    } else {
        const int sl = half * 4 + w;
        float* ob = P.oraw + ((size_t)b * SEQ + 4 * q4) * 512 + h * 128 + 16 * sl + n;
        const unsigned uoff = (unsigned)(DNC_U + ((sl * 4) * 64 + lane) * 16);
        f32x4 S[8]; bf16x8 Sb[4];
#pragma unroll
        for (int T = 0; T < 8; ++T) S[T] = (f32x4){0.f, 0.f, 0.f, 0.f};
#pragma unroll
        for (int k = 0; k < 4; ++k) Sb[k] = __builtin_bit_cast(bf16x8, (v4u){0u, 0u, 0u, 0u});
        f32x4 U0[4], U1[4]; float eg0, eg1;
#pragma unroll
        for (int it = 0; it < 4; ++it) { U0[it] = *(const GAS f32x4*)(cb0 + uoff + it * 1024); U1[it] = *(const GAS f32x4*)(cb0 + DNC_STRIDE + uoff + it * 1024); }
        eg0 = 0.f; eg1 = 0.f;
        LAS float* egl = (LAS float*)(F.lds + DNX_RED + 1024);
        if (w == 0) egl[lane] = *(const GAS float*)(cb0 + (size_t)lane * DNC_STRIDE + DNC_EGL);
        asm volatile("s_waitcnt vmcnt(0) lgkmcnt(0)" ::: "memory");
        __syncthreads();
#define DN_STEP(c_, BUFOFF, U_, eg_) do { \
        const LAS unsigned char* buf = F.lds + (BUFOFF); \
        bf16x8 fa[16], fb[16]; f32x4 ws[4], o[4]; \
        _Pragma("unroll") for (int t = 0; t < 16; ++t) fa[t] = *(const LAS bf16x8*)(buf + DNC_W + (t * 64 + lane) * 16); \
        _Pragma("unroll") for (int t = 0; t < 16; ++t) fb[t] = *(const LAS bf16x8*)(buf + DNC_QD + (t * 64 + lane) * 16); \
        asm volatile("" ::: "memory"); \
        _Pragma("unroll") for (int it = 0; it < 4; ++it) { ws[it] = (f32x4){0.f, 0.f, 0.f, 0.f}; o[it] = (f32x4){0.f, 0.f, 0.f, 0.f}; } \
        _Pragma("unroll") for (int ks = 0; ks < 4; ++ks) _Pragma("unroll") for (int it = 0; it < 4; ++it) ws[it] = __builtin_amdgcn_mfma_f32_16x16x32_bf16(fa[it * 4 + ks], Sb[ks], ws[it], 0, 0, 0); \
        _Pragma("unroll") for (int t = 0; t < 16; ++t) fa[t] = *(const LAS bf16x8*)(buf + DNC_KD + (t * 64 + lane) * 16); \
        asm volatile("" ::: "memory"); \
        _Pragma("unroll") for (int ks = 0; ks < 4; ++ks) _Pragma("unroll") for (int it = 0; it < 4; ++it) o[it] = __builtin_amdgcn_mfma_f32_16x16x32_bf16(fb[it * 4 + ks], Sb[ks], o[it], 0, 0, 0); \
        bf16x8 vb[2]; vb[0] = pack8(U_[0] - ws[0], U_[1] - ws[1]); vb[1] = pack8(U_[2] - ws[2], U_[3] - ws[3]); \
        _Pragma("unroll") for (int t = 0; t < 8; ++t) if (32 * (t & 1) <= 16 * (t >> 1) + 15) fb[t] = *(const LAS bf16x8*)(buf + DNC_AT + (t * 64 + lane) * 16); \
        asm volatile("" ::: "memory"); \
        eg_ = egl[c_]; \
        _Pragma("unroll") for (int T = 0; T < 8; ++T) S[T] = S[T] * eg_; \
        _Pragma("unroll") for (int k2 = 0; k2 < 2; ++k2) _Pragma("unroll") for (int T = 0; T < 8; ++T) S[T] = __builtin_amdgcn_mfma_f32_16x16x32_bf16(fa[T * 2 + k2], vb[k2], S[T], 0, 0, 0); \
        _Pragma("unroll") for (int k2 = 0; k2 < 2; ++k2) _Pragma("unroll") for (int it = 0; it < 4; ++it) if (32 * k2 <= 16 * it + 15) o[it] = __builtin_amdgcn_mfma_f32_16x16x32_bf16(fb[it * 2 + k2], vb[k2], o[it], 0, 0, 0); \
        _Pragma("unroll") for (int k = 0; k < 4; ++k) Sb[k] = pack8(S[2 * k], S[2 * k + 1]); \
        { float* op = ob + (size_t)(c_) * (64 * 512); \
          _Pragma("unroll") for (int it = 0; it < 4; ++it) _Pragma("unroll") for (int r = 0; r < 4; ++r) op[(16 * it + r) * 512] = o[it][r]; } \
        { const unsigned char* src = cb0 + (size_t)((c_) + 2 < 64 ? (c_) + 2 : 63) * DNC_STRIDE; \
          _Pragma("unroll") for (int it = 0; it < 4; ++it) U_[it] = *(const GAS f32x4*)(src + uoff + it * 1024); \
          } \
        asm volatile("s_waitcnt lgkmcnt(0)" ::: "memory"); __builtin_amdgcn_s_barrier(); asm volatile("" ::: "memory"); } while (0)
#pragma unroll 1
        for (int c = 0; c < 64; c += 2) {
            DN_STEP(c, DNX_BUF0, U0, eg0);
            DN_STEP(c + 1, DNX_BUF1, U1, eg1);
        }
#undef DN_STEP
    }
    asm volatile("s_waitcnt vmcnt(0)" ::: "memory");
    __syncthreads();
}
constexpr int DNU_BUF0 = 0, DNU_BUF1 = DNC_OPS + 16384, DNU_EG = 2 * (DNC_OPS + 16384);
static_assert(DNU_EG + 256 <= MISC_OFF, "deltanet chain LDS (U staged)");
__device__ __forceinline__ void dn_chain_u(Frame& F, const MixP& P, const unsigned char* dnc, int unit) {
    PHASE_TID();
    const int bh = unit >> 1, half = unit & 1, b = bh >> 2, h = bh & 3, w = F.wave, n = lane & 15, q4 = lane >> 4;
    const unsigned char* cb0 = dnc + (size_t)(bh * 64) * DNC_STRIDE;
    __syncthreads();
    if (w >= 4) {
        const unsigned so = (unsigned)((tid - 256) * 16);
        v4u s0[18], s1[18], s2[18];
        const __amdgpu_buffer_rsrc_t rs = __builtin_amdgcn_make_buffer_rsrc((void*)cb0, (short)0, 0x7ffffff0, 0x00020000);
        const unsigned uo = (unsigned)(DNC_U + half * 16384 - 14 * 4096);
#define DN_REQ(dst, chunk_) do { const unsigned cbase_ = (unsigned)((chunk_) < 64 ? (chunk_) : 63) * (unsigned)DNC_STRIDE;         \
        _Pragma("unroll") for (int r = 0; r < 14; ++r) dst[r] = __builtin_bit_cast(v4u, __builtin_amdgcn_raw_buffer_load_b128(rs, so, cbase_ + r * 4096, 0)); \
        _Pragma("unroll") for (int r = 14; r < 18; ++r) dst[r] = __builtin_bit_cast(v4u, __builtin_amdgcn_raw_buffer_load_b128(rs, so, cbase_ + uo + r * 4096, 0)); } while (0)
#define DN_PUT(bufoff, srcv) do { _Pragma("unroll") for (int r = 0; r < 18; ++r) *(LAS v4u*)(F.lds + (bufoff) + so + r * 4096) = srcv[r]; } while (0)
#define DN_SBAR() do { asm volatile("s_waitcnt lgkmcnt(0)" ::: "memory"); __builtin_amdgcn_s_barrier(); asm volatile("" ::: "memory"); } while (0)
        DN_REQ(s0, 0); DN_REQ(s1, 1); DN_REQ(s2, 2);
        DN_PUT(DNU_BUF0, s0); DN_REQ(s0, 3);
        __syncthreads();
#pragma unroll 1
        for (int c = 0; c < 60; c += 6) {
            DN_PUT(DNU_BUF1, s1); DN_REQ(s1, c + 4); DN_SBAR();
            DN_PUT(DNU_BUF0, s2); DN_REQ(s2, c + 5); DN_SBAR();
            DN_PUT(DNU_BUF1, s0); DN_REQ(s0, c + 6); DN_SBAR();
            DN_PUT(DNU_BUF0, s1); DN_REQ(s1, c + 7); DN_SBAR();
            DN_PUT(DNU_BUF1, s2); DN_REQ(s2, c + 8); DN_SBAR();
            DN_PUT(DNU_BUF0, s0); DN_REQ(s0, c + 9); DN_SBAR();
        }
        DN_PUT(DNU_BUF1, s1); DN_SBAR();
        DN_PUT(DNU_BUF0, s2); DN_SBAR();
        DN_PUT(DNU_BUF1, s0); DN_SBAR();
        DN_SBAR();
#undef DN_REQ
#undef DN_PUT
#undef DN_SBAR
    } else {
        const int sl = half * 4 + w;
        float* ob = P.oraw + ((size_t)b * SEQ + 4 * q4) * 512 + h * 128 + 16 * sl + n;
        f32x4 S[8]; bf16x8 Sb[4];
#pragma unroll
        for (int T = 0; T < 8; ++T) S[T] = (f32x4){0.f, 0.f, 0.f, 0.f};
#pragma unroll
        for (int k = 0; k < 4; ++k) Sb[k] = __builtin_bit_cast(bf16x8, (v4u){0u, 0u, 0u, 0u});
        LAS float* egl = (LAS float*)(F.lds + DNU_EG);
        if (w == 0) egl[lane] = *(const GAS float*)(cb0 + (size_t)lane * DNC_STRIDE + DNC_EGL);
        asm volatile("s_waitcnt vmcnt(0) lgkmcnt(0)" ::: "memory");
        __syncthreads();
#define DN_STEP(c_, BUFOFF) do { \
        const LAS unsigned char* buf = F.lds + (BUFOFF); \
        bf16x8 fa[16], fb[16]; f32x4 ws[4], o[4]; \
        _Pragma("unroll") for (int t = 0; t < 16; ++t) fa[t] = *(const LAS bf16x8*)(buf + DNC_W + (t * 64 + lane) * 16); \
        _Pragma("unroll") for (int t = 0; t < 16; ++t) fb[t] = *(const LAS bf16x8*)(buf + DNC_QD + (t * 64 + lane) * 16); \
        _Pragma("unroll") for (int it = 0; it < 4; ++it) ws[it] = *(const LAS f32x4*)(buf + DNC_OPS + ((w * 4 + it) * 64 + lane) * 16);        \
        const float eg_ = egl[c_]; \
        asm volatile("" ::: "memory"); \
        _Pragma("unroll") for (int it = 0; it < 4; ++it) { ws[it] = -ws[it]; o[it] = (f32x4){0.f, 0.f, 0.f, 0.f}; } \
        _Pragma("unroll") for (int ks = 0; ks < 4; ++ks) _Pragma("unroll") for (int it = 0; it < 4; ++it) ws[it] = __builtin_amdgcn_mfma_f32_16x16x32_bf16(fa[it * 4 + ks], Sb[ks], ws[it], 0, 0, 0); \
        _Pragma("unroll") for (int t = 0; t < 16; ++t) fa[t] = *(const LAS bf16x8*)(buf + DNC_KD + (t * 64 + lane) * 16); \
        asm volatile("" ::: "memory"); \
        _Pragma("unroll") for (int ks = 0; ks < 4; ++ks) _Pragma("unroll") for (int it = 0; it < 4; ++it) o[it] = __builtin_amdgcn_mfma_f32_16x16x32_bf16(fb[it * 4 + ks], Sb[ks], o[it], 0, 0, 0); \
        bf16x8 vb[2]; vb[0] = pack8(-ws[0], -ws[1]); vb[1] = pack8(-ws[2], -ws[3]); \
        _Pragma("unroll") for (int t = 0; t < 8; ++t) if (32 * (t & 1) <= 16 * (t >> 1) + 15) fb[t] = *(const LAS bf16x8*)(buf + DNC_AT + (t * 64 + lane) * 16); \
        asm volatile("" ::: "memory"); \
        _Pragma("unroll") for (int T = 0; T < 8; ++T) S[T] = S[T] * eg_; \
        _Pragma("unroll") for (int k2 = 0; k2 < 2; ++k2) _Pragma("unroll") for (int T = 0; T < 8; ++T) S[T] = __builtin_amdgcn_mfma_f32_16x16x32_bf16(fa[T * 2 + k2], vb[k2], S[T], 0, 0, 0); \
        _Pragma("unroll") for (int k2 = 0; k2 < 2; ++k2) _Pragma("unroll") for (int it = 0; it < 4; ++it) if (32 * k2 <= 16 * it + 15) o[it] = __builtin_amdgcn_mfma_f32_16x16x32_bf16(fb[it * 2 + k2], vb[k2], o[it], 0, 0, 0); \
        _Pragma("unroll") for (int k = 0; k < 4; ++k) Sb[k] = pack8(S[2 * k], S[2 * k + 1]); \
        { float* op = ob + (size_t)(c_) * (64 * 512); \
          _Pragma("unroll") for (int it = 0; it < 4; ++it) _Pragma("unroll") for (int r = 0; r < 4; ++r) op[(16 * it + r) * 512] = o[it][r]; } \
        asm volatile("s_waitcnt lgkmcnt(0)" ::: "memory"); __builtin_amdgcn_s_barrier(); asm volatile("" ::: "memory"); } while (0)
#pragma unroll 1
        for (int c = 0; c < 64; c += 2) {
            DN_STEP(c, DNU_BUF0);
            DN_STEP(c + 1, DNU_BUF1);
        }
#undef DN_STEP
    }
    asm volatile("s_waitcnt vmcnt(0)" ::: "memory");
    __syncthreads();
}
__device__ __forceinline__ void glu_unit(Frame& F, const bf16* ysb, const bf16* wt, const float* bias, bf16* mixed, int u) {
    PHASE_TID();
    const int rp = u >> 1, ch = u & 1, l15 = lane & 15, q = lane >> 4;
    const bf16* yrow = ysb + (size_t)(rp * 64 + l15) * 512 + 8 * q;
    const bf16* wrow = wt + (size_t)(ch * 256 + F.wave * 32 + l15) * 512 + 8 * q;
    f32x4 acc[2][4];
#pragma unroll
    for (int mt = 0; mt < 2; ++mt)
#pragma unroll
        for (int nt = 0; nt < 4; ++nt) acc[mt][nt] = (f32x4){0.f, 0.f, 0.f, 0.f};
    bf16x8 fa[2][2][4], fb[2][4][4];
#define GLU_LOAD(bu, kb) do { _Pragma("unroll") for (int ks = 0; ks < 4; ++ks) { \
        _Pragma("unroll") for (int mt = 0; mt < 2; ++mt) fa[bu][mt][ks] = *(const GAS bf16x8*)(wrow + mt * 16 * 512 + ((kb) * 4 + ks) * 32); \
        _Pragma("unroll") for (int nt = 0; nt < 4; ++nt) fb[bu][nt][ks] = *(const GAS bf16x8*)(yrow + nt * 16 * 512 + ((kb) * 4 + ks) * 32); } } while (0)
#define GLU_MMA(bu) do { _Pragma("unroll") for (int ks = 0; ks < 4; ++ks) _Pragma("unroll") for (int mt = 0; mt < 2; ++mt) _Pragma("unroll") for (int nt = 0; nt < 4; ++nt) \
        acc[mt][nt] = __builtin_amdgcn_mfma_f32_16x16x32_bf16(fa[bu][mt][ks], fb[bu][nt][ks], acc[mt][nt], 0, 0, 0); } while (0)
    GLU_LOAD(0, 0);
    GLU_LOAD(1, 1); asm volatile("" ::: "memory"); GLU_MMA(0);
    GLU_LOAD(0, 2); asm volatile("" ::: "memory"); GLU_MMA(1);
    GLU_LOAD(1, 3); asm volatile("" ::: "memory"); GLU_MMA(0);
    v2u yv[2][4]; f32x4 bb[2];
#pragma unroll
    for (int mt = 0; mt < 2; ++mt) { bb[mt] = *(const GAS f32x4*)(bias + ch * 256 + F.wave * 32 + mt * 16 + 4 * q);
#pragma unroll
        for (int nt = 0; nt < 4; ++nt) yv[mt][nt] = *(const GAS v2u*)(ysb + (size_t)(rp * 64 + nt * 16 + l15) * 512 + ch * 256 + F.wave * 32 + mt * 16 + 4 * q); }
    asm volatile("" ::: "memory");
    GLU_MMA(1);
#undef GLU_LOAD
#undef GLU_MMA
#pragma unroll
    for (int mt = 0; mt < 2; ++mt)
#pragma unroll
        for (int nt = 0; nt < 4; ++nt) { const v2u y = yv[mt][nt]; const f32x4 a = acc[mt][nt];
            const float o0 = bflo(y.x) * sigmoid_f(a[0] + bb[mt][0]), o1 = bfhi(y.x) * sigmoid_f(a[1] + bb[mt][1]), o2 = bflo(y.y) * sigmoid_f(a[2] + bb[mt][2]), o3 = bfhi(y.y) * sigmoid_f(a[3] + bb[mt][3]);
            v2u o; o.x = pk2(o0, o1); o.y = pk2(o2, o3);
            *(GAS v2u*)(mixed + (size_t)(rp * 64 + nt * 16 + l15) * MIXW + 1536 + ch * 256 + F.wave * 32 + mt * 16 + 4 * q) = o; }
}
__device__ __forceinline__ void dn_post_rows4(Frame& F, const MixP& P) {
    PHASE_TID();
    for (int t0 = F.gw; t0 < M; t0 += 4 * F.NGW) {
        float a[4][4], b2[4][4], z0[4][4], z1[4][4];
#pragma unroll
        for (int i = 0; i < 4; ++i) { const int t = (t0 + i * F.NGW < M) ? t0 + i * F.NGW : t0;
#pragma unroll
            for (int h = 0; h < 4; ++h) { a[i][h] = P.oraw[(size_t)t * 512 + h * 128 + lane]; b2[i][h] = P.oraw[(size_t)t * 512 + h * 128 + 64 + lane];
                z0[i][h] = bf2f(P.z[(size_t)t * ZW + Z_DZ + h * 128 + lane]); z1[i][h] = bf2f(P.z[(size_t)t * ZW + Z_DZ + h * 128 + 64 + lane]); } }
        const float w0 = P.dn_norm_w[lane], w1 = P.dn_norm_w[64 + lane];
#pragma unroll
        for (int i = 0; i < 4; ++i) { const int t = t0 + i * F.NGW; if (t < M) {
#pragma unroll
            for (int h = 0; h < 4; ++h) { const float r = 1.0f / sqrtf(wave_sum(a[i][h] * a[i][h] + b2[i][h] * b2[i][h]) * (1.f / 128.f) + NORM_EPS);
                P.mixed[(size_t)t * MIXW + 1024 + h * 128 + lane] = (bf16)f2bf(a[i][h] * r * w0 * z0[i][h] * sigmoid_f(z0[i][h]));
                P.mixed[(size_t)t * MIXW + 1024 + h * 128 + 64 + lane] = (bf16)f2bf(b2[i][h] * r * w1 * z1[i][h] * sigmoid_f(z1[i][h])); } } }
    }
}
constexpr int NPH = 12;
constexpr int NSTEPS = 1 + DEPTH * NPH;
struct Args { const float* in[30]; float* out; unsigned char* ws; int s_lo, s_hi; };
enum { I_X = 0, I_FF1_PRE, I_FF1_G, I_FF1_U, I_FF1_D, I_FF1_POST, I_MIX_PRE, I_WIN, I_SINKS, I_CONVW, I_ALOG, I_DTB, I_DNNW, I_S5ARE, I_S5AIM, I_S5LDT, I_S5BRE, I_S5BIM, I_S5CRE, I_S5CIM, I_S5D,
       I_GLUW, I_GLUB, I_WOUT, I_MIX_POST, I_FF2_PRE, I_FF2_G, I_FF2_U, I_FF2_D, I_FF2_POST };
typedef const __attribute__((address_space(4))) Args* CArgsP;
__device__ __forceinline__ CArgsP kargs() { CArgsP p = (CArgsP)__builtin_amdgcn_kernarg_segment_ptr(); asm volatile("" : "+s"(p)); return p; }
__device__ __forceinline__ MixP make_mixp(CArgsP A, unsigned char* ws, int l) {
    MixP P;
    P.sinks = A->in[I_SINKS] + l * 8; P.convw = A->in[I_CONVW] + l * 4 * 1536; P.a_log = A->in[I_ALOG] + l * 4; P.dt_bias = A->in[I_DTB] + l * 4; P.dn_norm_w = A->in[I_DNNW] + l * 128;
    P.s5_a_re = A->in[I_S5ARE] + l * 2048; P.s5_a_im = A->in[I_S5AIM] + l * 2048; P.s5_log_dt = A->in[I_S5LDT] + l * 32;
    P.s5_b_re = A->in[I_S5BRE] + l * 32768; P.s5_b_im = A->in[I_S5BIM] + l * 32768; P.s5_c_re = A->in[I_S5CRE] + l * 32768; P.s5_c_im = A->in[I_S5CIM] + l * 32768; P.s5_d = A->in[I_S5D] + l * 512;
    P.rope_cos = (float*)(ws + WS_ROPE); P.rope_sin = P.rope_cos + SEQ * 64; P.z = (bf16*)(ws + WS_Z); P.ab = (float*)(ws + WS_AB); P.bg = (float*)(ws + WS_BG); P.kr = (float*)(ws + WS_KR);
    P.qn = (float*)(ws + WS_QN); P.kn = (float*)(ws + WS_KN); P.vc = (float*)(ws + WS_VC); P.oraw = (float*)(ws + WS_ORAW); P.ys = (float*)(ws + WS_YS); P.ysb = (bf16*)(ws + WS_YSB); P.mixed = (bf16*)(ws + WS_MIXED);
    return P;
}
constexpr int CV_G1 = 0, CV_U1 = 5632, CV_D1 = 11264, CV_WA = 16896, CV_WB = 20480, CV_GL = 20992, CV_WO = 21120, CV_G2 = 23168, CV_U2 = 28800, CV_D2 = 34432, CV_END = 40064;
#ifndef CONV_ALL5
#define CONV_ALL5 0
#endif
constexpr int CV_TOTAL = DEPTH * CV_END, CV_PRO = CONV_ALL5 ? CV_G2 : CV_WA;
#ifndef GU_ALIGN
#define GU_ALIGN true
#endif
#ifndef GU_SP2
#define GU_SP2 true
#endif
__device__ __forceinline__ void convert_items_fs(Frame& F, CArgsP A, unsigned char* ws, int gbeg, int gend, int first, int nw) {
    PHASE_TID();
    LAS float* scr = (LAS float*)(F.lds + RING_OFF + F.wave * 16384);
    if (gend > CV_TOTAL) gend = CV_TOTAL;
    for (int gi = gbeg + first; gi < gend; gi += nw) {
        const int tl = gi / CV_END, it = gi - tl * CV_END; const LayerW w = layer_w(ws, tl);
        if (it < CV_U1)      transpose_item(A->in[I_FF1_G] + (size_t)tl * D * FF, D, FF, 0, FF, (bf16*)w.wgu1, 0, 1, scr, it - CV_G1, lane);
        else if (it < CV_D1) transpose_item(A->in[I_FF1_U] + (size_t)tl * D * FF, D, FF, 0, FF, (bf16*)w.wgu1, 128, 1, scr, it - CV_U1, lane);
        else if (it < CV_WA) transpose_item(A->in[I_FF1_D] + (size_t)tl * FF * D, FF, D, 0, D, (bf16*)w.wd1, 0, 0, scr, it - CV_D1, lane);
        else if (it < CV_WB) transpose_item(A->in[I_WIN] + (size_t)tl * D * INW, D, INW, 0, SRC_AB, (bf16*)w.win, 0, 0, scr, it - CV_WA, lane);
        else if (it < CV_GL) transpose_item(A->in[I_WIN] + (size_t)tl * D * INW, D, INW, SRC_S5, 512, (bf16*)w.win, Z_S5, 0, scr, it - CV_WB, lane);
        else if (it < CV_WO) transpose_item(A->in[I_GLUW] + (size_t)tl * 512 * 512, 512, 512, 0, 512, (bf16*)w.wglu, 0, 0, scr, it - CV_GL, lane);
        else if (it < CV_G2) transpose_item(A->in[I_WOUT] + (size_t)tl * MIXW * D, MIXW, D, 0, D, (bf16*)w.wout, 0, 0, scr, it - CV_WO, lane);
        else if (it < CV_U2) transpose_item(A->in[I_FF2_G] + (size_t)tl * D * FF, D, FF, 0, FF, (bf16*)w.wgu2, 0, 1, scr, it - CV_G2, lane);
        else if (it < CV_D2) transpose_item(A->in[I_FF2_U] + (size_t)tl * D * FF, D, FF, 0, FF, (bf16*)w.wgu2, 128, 1, scr, it - CV_U2, lane);
        else                 transpose_item(A->in[I_FF2_D] + (size_t)tl * FF * D, FF, D, 0, D, (bf16*)w.wd2, 0, 0, scr, it - CV_D2, lane);
    }
}
__device__ __forceinline__ void convert_items(Frame& F, CArgsP A, unsigned char* ws, int gbeg, int gend, int w0, int nw) { convert_items_fs(F, A, ws, gbeg, gend, F.gw - w0, nw); }
#ifndef CVS_A_N
#define CVS_A_N 8000
#endif
#ifndef CVS_C_N
#define CVS_C_N 8000
#endif
constexpr int CVS_A = CONV_ALL5 ? 0 : CVS_A_N, CVS_C = CONV_ALL5 ? 0 : CVS_C_N, CVS_B = CV_END - CVS_A - CVS_C;
static_assert(CVS_A + CVS_B + CVS_C == CV_END && CV_PRO + CVS_A >= CV_G2 - 0 + 0 - 1728 - 0 && CV_PRO + CVS_A >= CV_WO + 2048, "slot A covers w_in, glu_w, w_out of its layer");
static_assert(CV_PRO + CVS_A + CVS_B >= CV_END, "slot B covers the rest of its layer (FFN2 weights)");
#ifndef STAGGER_SLEEP
#define STAGGER_SLEEP 19
#endif
__device__ __forceinline__ void xcd_stagger() {
    const unsigned x = xb_xcc_id() & 7u;
    for (unsigned i = 0; i < x; ++i) __builtin_amdgcn_s_sleep(STAGGER_SLEEP);
}
#ifndef NO_FILLER
#define NO_FILLER 0
#endif
#ifndef FILLER_FIRST
#define FILLER_FIRST 0
#endif
#ifndef CONV_SPLIT
#define CONV_SPLIT 0
#endif
#ifndef WAIT_PROBE
#define WAIT_PROBE 0
#endif
#ifndef WAIT_MODE
#define WAIT_MODE 0
#endif
#ifndef WAIT_REGION
#define WAIT_REGION 0
#endif
#ifndef WAIT_SEL
#define WAIT_SEL 0
#endif
#ifndef WAIT_AMP
#define WAIT_AMP 1
#endif
#ifndef WAIT_PROBE_MAX
#define WAIT_PROBE_MAX 0
#endif
#ifndef WAIT_PROBE_MIN
#define WAIT_PROBE_MIN 0
#endif
#ifndef GLU_DIRECT
#define GLU_DIRECT 0
#endif
#ifndef CONV_NCW
#define CONV_NCW 0
#endif
#ifndef DN_USTAGE
#define DN_USTAGE 0
#endif
#if DN_USTAGE == 4
#define DN_CHAIN_FN dn_chain_q
#elif DN_USTAGE == 3
#define DN_CHAIN_FN dn_chain_e
#elif DN_USTAGE == 2
#define DN_CHAIN_FN dn_chain_p
#elif DN_USTAGE
#define DN_CHAIN_FN dn_chain_u
#else
#define DN_CHAIN_FN dn_chain
#endif
#ifndef STEP5_SPLIT
#define STEP5_SPLIT 0
#endif
#ifndef S5_IN5
#define S5_IN5 0
#endif
#ifndef S5_IN5_SPLIT
#define S5_IN5_SPLIT 18000
#endif
#ifndef NORM2ROW
#define NORM2ROW 0
#endif
#if NORM2ROW && Y_BF16
#define NORM_FN norm_phase2
#else
#define NORM_FN norm_phase
#endif
#ifndef PRO_SPLIT
#define PRO_SPLIT 0
#endif
#ifndef GLU_IN5
#define GLU_IN5 0
#endif
struct OneUnit { int pm, pn; __device__ bool next(int i, pg8::Unit& u) const { if (i) return false; u.pm = pm; u.pn = pn; return true; }
    __device__ __forceinline__ void a_ready(const pg8::Unit&) const {} __device__ __forceinline__ void done(const pg8::Unit&) const {} };
#ifndef GU_SPLIT
#define GU_SPLIT 0
#endif
struct RangeOrder : pg8::StaticOrder { int base, limit;
    __device__ bool next(int i, pg8::Unit& u) const { const long L = (long)i * G + c + base; if (L >= limit) return false;
        int wgid = (int)L; { const int q = nwg / pg8::NXCD, r = nwg % pg8::NXCD, xcd = wgid % pg8::NXCD, off = wgid / pg8::NXCD; wgid = (xcd < r ? xcd * (q + 1) : r * (q + 1) + (xcd - r) * q) + off; }
        const int nig = pg8::WGM * nN, gid = wgid / nig, fm = gid * pg8::WGM, gsz = (nM - fm) < pg8::WGM ? (nM - fm) : pg8::WGM;
        u.pm = fm + ((wgid % nig) % gsz); u.pn = (wgid % nig) / gsz; return true; } };
#define PHASE_BEGIN() Frame F; F.lds = (LAS unsigned char*)lds; { int bx_ = blockIdx.x, gx_ = gridDim.x, tw_ = threadIdx.x; asm volatile("" : "+s"(bx_), "+s"(gx_), "+v"(tw_)); \
        F.bid = bx_; F.G = gx_; F.wave = __builtin_amdgcn_readfirstlane(tw_ >> 6); F.gw = bx_ * NWAVES + F.wave; F.NGW = gx_ * NWAVES; } \
    const CArgsP A = kargs(); unsigned char* const ws = A->ws; (void)ws; \
    bf16* const Hb = (bf16*)(ws + WS_H); bf16* const ACT = (bf16*)(ws + WS_ACT); float* const Yb = (float*)(ws + WS_Y); bf16* const Zb = (bf16*)(ws + WS_Z); bf16* const MIXED = (bf16*)(ws + WS_MIXED); \
    float* const xout = A->out; (void)Hb; (void)ACT; (void)Yb; (void)Zb; (void)MIXED; (void)xout

__global__ void __launch_bounds__(NWAVES * 64, 2) mk_fwd(Args args) {
    extern __shared__ __attribute__((aligned(16))) unsigned char lds[];
    if (threadIdx.x < 128) ((LAS unsigned*)((LAS unsigned char*)lds + MISC_OFF))[threadIdx.x] = 0u;
    __syncthreads();
    XcdBarrier bar; bar.bar = (unsigned*)(kargs()->ws + WS_CTL) + CW_BAR; bar.x = 0; bar.st = nullptr; bar.expect = 0u;
    if (!MK_MULTI) bar = xcd_barrier_post((unsigned*)(kargs()->ws + WS_CTL) + CW_BAR, (volatile LAS unsigned*)((LAS unsigned char*)lds + MISC_OFF) + 8);
#if S5_IN5
    if (blockIdx.x >= 16) (void)xcd_barrier_post((unsigned*)(kargs()->ws + WS_CTL) + 8192, (volatile LAS unsigned*)((LAS unsigned char*)lds + MISC_OFF) + 12);
#endif
    const int lo = kargs()->s_lo, hi = kargs()->s_hi;
#define IN(s) (lo <= (s) && (s) < hi)
#if WAIT_PROBE
    unsigned long long wacc = 0, tprev_ = __builtin_amdgcn_s_memrealtime();
    __builtin_amdgcn_s_waitcnt(0xC07F);
#define SEAM(s) do { if (IN(s) && IN((s) + 1)) { const unsigned long long t0_ = __builtin_amdgcn_s_memrealtime(); __builtin_amdgcn_s_waitcnt(0xC07F); xcd_barrier(bar); const unsigned long long t1_ = __builtin_amdgcn_s_memrealtime(); __builtin_amdgcn_s_waitcnt(0xC07F); \
        const int kind_ = (s) == 0 ? 12 : ((s) - 1) % NPH; if ((WAIT_PROBE >> kind_) & 1) wacc += WAIT_MODE ? t1_ - tprev_ : t1_ - t0_; tprev_ = t1_; } } while (0)
#else
#define SEAM(s) do { if (!MK_MULTI) { if (IN(s) && IN((s) + 1)) xcd_barrier(bar); } } while (0)
#endif

    if (IN(0)) for (int rp_ = 0; rp_ < 1 + ((PROBE_DBL_MASK >> 12) & 1); ++rp_) {
        PHASE_BEGIN();
#if PRO_SPLIT
        const bool tabwg = F.bid >= F.G - 32;
        if (!tabwg) convert_items_fs(F, A, ws, 0, CV_PRO, F.gw, (F.G - 32) * NWAVES);
        else { const int tg = F.bid - (F.G - 32);
            s5_tables(F, A->in[I_S5ARE], A->in[I_S5AIM], A->in[I_S5LDT], A->in[I_S5BRE], A->in[I_S5BIM], A->in[I_S5CRE], A->in[I_S5CIM], ws + WS_S5T + (size_t)tg * S5T_STRIDE, tg); }
#else
        convert_items(F, A, ws, 0, NO_FILLER ? CV_TOTAL : CV_PRO, 0, F.NGW);
        for (int c = F.bid; c < DEPTH * 32; c += F.G) { const int tl = c >> 5, tg = c & 31;
            s5_tables(F, A->in[I_S5ARE] + tl * 2048, A->in[I_S5AIM] + tl * 2048, A->in[I_S5LDT] + tl * 32, A->in[I_S5BRE] + tl * 32768, A->in[I_S5BIM] + tl * 32768, A->in[I_S5CRE] + tl * 32768, A->in[I_S5CIM] + tl * 32768,
                      ws + WS_S5T + (size_t)c * S5T_STRIDE, tg); }
#endif
        { PHASE_TID(); float* rope_cos = (float*)(ws + WS_ROPE); float* rope_sin = rope_cos + SEQ * 64;
          for (int i = F.bid * (NWAVES * 64) + tid; i < SEQ * 64; i += F.G * NWAVES * 64) {
            const int pos = i >> 6, d = i & 63;
            const float invf = exp2f(-(float)d * (13.287712379549449f / 64.0f));
            const float ang = (float)pos * invf;
            double t = (double)ang * 0.15915494309189535; t -= __builtin_rint(t);
            float s, c; sincos_rev(t, s, c); rope_cos[i] = c; rope_sin[i] = s;
          } }
#if PRO_SPLIT
        if (!tabwg) { PHASE_TID(); const int st = (F.G - 32) * NWAVES;
            for (int m0 = F.gw; m0 < M; m0 += 2 * st) { const bool two = m0 + st < M; const int m1 = two ? m0 + st : m0;
                const float* xin = A->in[I_X]; const float* gain = A->in[I_FF1_PRE]; f32x4 v[2][8]; float rstd[2];
#pragma unroll
                for (int r = 0; r < 2; ++r) { const GAS f32x4* xr = (const GAS f32x4*)(xin + (size_t)(r ? m1 : m0) * D) + lane;
#pragma unroll
                    for (int j = 0; j < 8; ++j) v[r][j] = xr[64 * j]; }
#pragma unroll
                for (int r = 0; r < 2; ++r) { float s = 0.f;
#pragma unroll
                    for (int j = 0; j < 8; ++j) s += (v[r][j].x * v[r][j].x + v[r][j].y * v[r][j].y) + (v[r][j].z * v[r][j].z + v[r][j].w * v[r][j].w);
                    rstd[r] = 1.0f / sqrtf(wave_sum(s) * (1.f / D) + NORM_EPS); }
                const GAS f32x4* gr = (const GAS f32x4*)gain + lane;
#pragma unroll
                for (int j = 0; j < 8; ++j) { const f32x4 g = gr[64 * j];
#pragma unroll
                    for (int r = 0; r < 2; ++r) { v2u o; o.x = pk2(v[r][j].x * rstd[r] * g.x, v[r][j].y * rstd[r] * g.y); o.y = pk2(v[r][j].z * rstd[r] * g.z, v[r][j].w * rstd[r] * g.w);
                        if (r == 0 || two) ((GAS v2u*)(Hb + (size_t)(r ? m1 : m0) * D) + lane)[64 * j] = o; } } } }
#else
        { PHASE_TID(); for (int m = F.gw; m < M; m += F.NGW) rms_row_to_bf16(lane, A->in[I_X] + (size_t)m * D, A->in[I_FF1_PRE], Hb + (size_t)m * D); }
#endif
    }
    SEAM(0);

#pragma unroll 1
    for (int l = 0; l < DEPTH; ++l) {
        const int sb = 1 + l * NPH;
        if (IN(sb + 0)) for (int rp_ = 0; rp_ < 1 + ((PROBE_DBL_MASK >> 0) & 1); ++rp_) { PHASE_BEGIN(); const LayerW w = layer_w(ws, l); pg8::Gemm g{Hb, w.wgu1, M, 2 * FF, D}; pg8::EpiSwiGLU E{ACT, FF};
#if GU_SPLIT
            { RangeOrder S; S.init(M, 2 * FF, F.G, F.bid); S.base = 0; S.limit = 704; pg8::gemm_phase<pg8::EpiSwiGLU, RangeOrder, GU_ALIGN, GU_SP2>(F.lds + RING_OFF, g, S, E); }
            xcd_barrier(bar);
            { RangeOrder S; S.init(M, 2 * FF, F.G, F.bid); S.base = 704; S.limit = 1408; pg8::gemm_phase<pg8::EpiSwiGLU, RangeOrder, GU_ALIGN, GU_SP2>(F.lds + RING_OFF, g, S, E); }
#else
#if FILLER_FIRST
            if (!NO_FILLER && F.bid >= 128) { convert_items(F, A, ws, l * CV_END + CV_PRO, l * CV_END + CV_PRO + CVS_A, 128 * NWAVES, (F.G - 128) * NWAVES); __syncthreads(); }
#endif
            pg8::StaticOrder S; S.init(M, 2 * FF, F.G, F.bid);
            pg8::gemm_phase<pg8::EpiSwiGLU, pg8::StaticOrder, GU_ALIGN, GU_SP2>(F.lds + RING_OFF, g, S, E);
#endif
            if (!FILLER_FIRST && !NO_FILLER && F.bid >= 128) convert_items(F, A, ws, l * CV_END + CV_PRO, l * CV_END + CV_PRO + CVS_A, 128 * NWAVES, (F.G - 128) * NWAVES); }
        SEAM(sb + 0);
        if (IN(sb + 1)) for (int rp_ = 0; rp_ < 1 + ((PROBE_DBL_MASK >> 1) & 1); ++rp_) { PHASE_BEGIN(); const LayerW w = layer_w(ws, l); pg8::Gemm g{ACT, w.wd1, M, D, FF}; pg8::StaticOrder S; S.init(M, D, F.G, F.bid);
#if FUSED_NORM
            pg8::EpiRmsRes E{l == 0 ? A->in[I_X] : xout, xout, Hb, A->in[I_FF1_POST] + l * D, A->in[I_MIX_PRE] + l * D, 0.5f, (unsigned long long*)(ws + WS_XS), (unsigned*)(ws + WS_CTL) + CW_CNT, 64u * (unsigned)(3 * l + 1), (unsigned*)(ws + WS_CTL) + CW_TMO};
            pg8::gemm_phase<pg8::EpiRmsRes, pg8::StaticOrder, false, true>(F.lds + RING_OFF, g, S, E); }
#else
#if Y_BF16
            pg8::EpiBf16P E{(bf16*)Yb, D};
            pg8::gemm_phase<pg8::EpiBf16P, pg8::StaticOrder, true, true>(F.lds + RING_OFF, g, S, E); }
#else
            pg8::EpiF32 E{Yb, D};
            pg8::gemm_phase<pg8::EpiF32, pg8::StaticOrder, true, true>(F.lds + RING_OFF, g, S, E); }
#endif
#endif
        SEAM(sb + 1);
#if !FUSED_NORM
        if (IN(sb + 2)) { PHASE_BEGIN(); norm_phase<true, true>(F, Yb, l == 0 ? A->in[I_X] : xout, xout, A->in[I_FF1_POST] + l * D, 0.5f, A->in[I_MIX_PRE] + l * D, Hb, A->in[I_WIN] + (size_t)l * D * INW, (float*)(ws + WS_AB));
            if ((PROBE_DBL_MASK >> 18) & 1) norm_phase<true, true>(F, Yb, xout, (float*)ACT, A->in[I_FF1_POST] + l * D, 0.5f, A->in[I_MIX_PRE] + l * D, Zb, A->in[I_WIN] + (size_t)l * D * INW, (float*)(ws + WS_BG)); }
        SEAM(sb + 2);
#endif
        if (IN(sb + 3)) for (int rp_ = 0; rp_ < 1 + ((PROBE_DBL_MASK >> 3) & 1); ++rp_) { PHASE_BEGIN(); const LayerW w = layer_w(ws, l); pg8::Gemm g{Hb, w.win, M, ZW, D}; pg8::StaticOrder S; S.init(M, ZW, F.G, F.bid); pg8::EpiBf16P E{Zb, ZW};
            pg8::gemm_phase<pg8::EpiBf16P, pg8::StaticOrder, true, true>(F.lds + RING_OFF, g, S, E);
#if FUSED_NORM
            ab_rows_phase(F, xout, A->in[I_MIX_PRE] + l * D, A->in[I_WIN] + (size_t)l * D * INW, (float*)(ws + WS_AB));
#endif
            }
        SEAM(sb + 3);
        if (IN(sb + 4)) for (int rp_ = 0; rp_ < 1 + ((PROBE_DBL_MASK >> 4) & 1); ++rp_) { PHASE_BEGIN(); const MixP P = make_mixp(A, ws, l);
#if FAST_S5 && !S5_IN5
            if (F.bid < S5_UNITS) for (int r2_ = 0; r2_ < 1 + ((PROBE_DBL_MASK >> 17) & 1); ++r2_) s5_unit<false>(F, P, ws + WS_S5T + (size_t)l * 32 * S5T_STRIDE, (float*)(ws + WS_S5E), F.bid);
#endif
#if FAST_DN
            for (int r2_ = 0; r2_ < 1 + ((PROBE_DBL_MASK >> 16) & 1); ++r2_) for (int u = F.bid; u < 512; u += F.G) dn_chunk_unit(F, P, ws + WS_DNC, u);
#else
            prep_phase(F, P);
#endif
            }
        SEAM(sb + 4);
        if (IN(sb + 5)) for (int rp_ = 0; rp_ < 1 + ((PROBE_DBL_MASK >> 5) & 1); ++rp_) {
            PHASE_BEGIN(); const MixP P = make_mixp(A, ws, l); const int bid = F.bid;
#if FAST_DN
#if WAIT_PROBE && WAIT_REGION == 3
            if (bid < 16) { const unsigned long long ra_ = __builtin_amdgcn_s_memrealtime(); __builtin_amdgcn_s_waitcnt(0xC07F); DN_CHAIN_FN(F, P, ws + WS_DNC, bid);
                const unsigned long long rb_ = __builtin_amdgcn_s_memrealtime(); __builtin_amdgcn_s_waitcnt(0xC07F); wacc += rb_ - ra_; }
#elif WAIT_PROBE && WAIT_REGION == 4
            if (bid < 16) { const unsigned long long ra_ = __builtin_amdgcn_s_memtime(); __builtin_amdgcn_s_waitcnt(0xC07F); DN_CHAIN_FN(F, P, ws + WS_DNC, bid);
                const unsigned long long rb_ = __builtin_amdgcn_s_memtime(); __builtin_amdgcn_s_waitcnt(0xC07F); wacc += (rb_ - ra_) >> 3; }
#else
            if (bid < 16) { for (int r2_ = 0; r2_ < 1 + ((PROBE_DBL_MASK >> 13) & 1); ++r2_) DN_CHAIN_FN(F, P, ws + WS_DNC, bid); }
#endif
#if STEP5_SPLIT
            xcd_barrier(bar);
            if (bid < 16) { }
#endif
#else
            if (bid < 8) slow_deltanet(F, P, bid);
#endif
#if FAST_S5 && S5_IN5
            else { const int rel = bid - 16; const unsigned char* tabs = ws + WS_S5T + (size_t)l * 32 * S5T_STRIDE;
                if (rel >= S5_UNITS) s5_unit<false>(F, P, tabs, (float*)(ws + WS_S5E), rel - S5_UNITS);
                else if (rel < 16) s5_unit<false>(F, P, tabs, (float*)(ws + WS_S5E), 112 + rel);
                else { attn_unit(F, P, 2 * (rel - 16)); attn_unit(F, P, 2 * (rel - 16) + 1); }
                { XcdBarrier barP; barP.bar = (unsigned*)(ws + WS_CTL) + 8192; barP.x = xb_xcc_id(); barP.st = (volatile LAS unsigned*)(F.lds + MISC_OFF) + 12; barP.expect = (unsigned)F.G - 16u;
                  xcd_barrier(barP); }
                if (rel < S5_UNITS) { s5_unit<true>(F, P, tabs, (float*)(ws + WS_S5E), rel); if (rel < 16) { attn_unit(F, P, 224 + 2 * rel); attn_unit(F, P, 224 + 2 * rel + 1); } }
#if PRO_SPLIT
                if (l + 1 < DEPTH && bid >= F.G - 32) { const int tl = l + 1, tg = bid - (F.G - 32);
                    s5_tables(F, A->in[I_S5ARE] + tl * 2048, A->in[I_S5AIM] + tl * 2048, A->in[I_S5LDT] + tl * 32, A->in[I_S5BRE] + tl * 32768, A->in[I_S5BIM] + tl * 32768, A->in[I_S5CRE] + tl * 32768, A->in[I_S5CIM] + tl * 32768,
                              ws + WS_S5T + (size_t)(tl * 32 + tg) * S5T_STRIDE, tg); }
#endif
                if (!NO_FILLER) { const int g0 = l * CV_END + CV_PRO + CVS_A;
#pragma unroll 1
                    for (int ps = (rel >= S5_UNITS ? 0 : 1); ps < 2; ++ps)
                        convert_items(F, A, ws, ps == 0 ? g0 : g0 + S5_IN5_SPLIT, ps == 0 ? g0 + S5_IN5_SPLIT : g0 + CVS_B, (ps == 0 ? 144 : 16) * NWAVES, (F.G - (ps == 0 ? 144 : 16)) * NWAVES); } }
#elif FAST_S5
            else { for (int u = bid - 16; u < S5_UNITS + ATT_UNITS; u += F.G - 16) { if (u < S5_UNITS) { for (int r2_ = 0; r2_ < 1 + ((PROBE_DBL_MASK >> 14) & 1); ++r2_) s5_unit<true>(F, P, ws + WS_S5T + (size_t)l * 32 * S5T_STRIDE, (float*)(ws + WS_S5E), u);
#if GLU_IN5
                    asm volatile("s_waitcnt vmcnt(0)" ::: "memory"); __syncthreads();
                    if (threadIdx.x == 0) { __builtin_amdgcn_fence(__ATOMIC_RELEASE, "agent"); asm volatile("s_waitcnt vmcnt(0)" ::: "memory"); (void)xb_add((unsigned*)(ws + WS_CTL) + 12288 + l * 64, 1u); }
#endif
                    }
                else { for (int r2_ = 0; r2_ < 1 + ((PROBE_DBL_MASK >> 15) & 1); ++r2_) attn_unit(F, P, u - S5_UNITS); } }
#if PRO_SPLIT
                if (l + 1 < DEPTH && bid >= F.G - 32) { const int tl = l + 1, tg = bid - (F.G - 32);
                    s5_tables(F, A->in[I_S5ARE] + tl * 2048, A->in[I_S5AIM] + tl * 2048, A->in[I_S5LDT] + tl * 32, A->in[I_S5BRE] + tl * 32768, A->in[I_S5BIM] + tl * 32768, A->in[I_S5CRE] + tl * 32768, A->in[I_S5CIM] + tl * 32768,
                              ws + WS_S5T + (size_t)(tl * 32 + tg) * S5T_STRIDE, tg); }
#endif
#if CONV_SPLIT > 0
                if (!NO_FILLER) {
                    const int g0 = l * CV_END + CV_PRO + CVS_A;
#pragma unroll 1
                    for (int ps = ((bid >= 144 && bid < 224) ? 0 : 1); ps < 2; ++ps)
                        convert_items(F, A, ws, ps == 0 ? g0 : g0 + CONV_SPLIT, ps == 0 ? g0 + CONV_SPLIT : g0 + CVS_B, (ps == 0 ? 144 : 16) * NWAVES, (ps == 0 ? 80 : F.G - 16) * NWAVES); }
#if GLU_IN5
                if (bid >= 144 && bid < 208) {
                    __syncthreads();
                    if (threadIdx.x == 0) { unsigned* cnt_ = (unsigned*)(ws + WS_CTL) + 12288 + l * 64; unsigned* bar_ = (unsigned*)(ws + WS_CTL) + CW_BAR;
                        XB_SPIN(xb_ld(cnt_) < (unsigned)S5_UNITS, bar_);
                        __builtin_amdgcn_fence(__ATOMIC_ACQUIRE, "agent"); asm volatile("s_waitcnt vmcnt(0)" ::: "memory"); }
                    __syncthreads();
                    const LayerW w = layer_w(ws, l); pg8::Gemm g{P.ysb, w.wglu, M, 512, 512}; OneUnit S; S.pm = (bid - 144) >> 1; S.pn = (bid - 144) & 1;
                    pg8::EpiGlu E{(const pg8::bf16_t*)P.ysb, 512, A->in[I_GLUB] + l * 512, (pg8::bf16_t*)MIXED, MIXW, 1536};
                    pg8::gemm_phase<pg8::EpiGlu, OneUnit, true, true>(F.lds + RING_OFF, g, S, E); }
#endif
                }
#elif CONV_NCW > 0
                if (!NO_FILLER) convert_items_fs(F, A, ws, l * CV_END + CV_PRO + CVS_A, l * CV_END + CV_PRO + CVS_A + CVS_B, F.wave < CONV_NCW ? (bid - 16) * CONV_NCW + F.wave : (1 << 29), (F.G - 16) * CONV_NCW); }
#else
                if (!NO_FILLER) convert_items(F, A, ws, l * CV_END + CV_PRO + CVS_A, l * CV_END + CV_PRO + CVS_A + CVS_B, 16 * NWAVES, (F.G - 16) * NWAVES);
#if GLU_IN5
                if (bid >= 144 && bid < 208) {
                    __syncthreads();
                    if (threadIdx.x == 0) { unsigned* cnt_ = (unsigned*)(ws + WS_CTL) + 12288 + l * 64; unsigned* bar_ = (unsigned*)(ws + WS_CTL) + CW_BAR;
                        XB_SPIN(xb_ld(cnt_) < (unsigned)S5_UNITS, bar_);
                        __builtin_amdgcn_fence(__ATOMIC_ACQUIRE, "agent"); asm volatile("s_waitcnt vmcnt(0)" ::: "memory"); }
                    __syncthreads();
                    const LayerW w = layer_w(ws, l); pg8::Gemm g{P.ysb, w.wglu, M, 512, 512}; OneUnit S; S.pm = (bid - 144) >> 1; S.pn = (bid - 144) & 1;
                    pg8::EpiGlu E{(const pg8::bf16_t*)P.ysb, 512, A->in[I_GLUB] + l * 512, (pg8::bf16_t*)MIXED, MIXW, 1536};
                    pg8::gemm_phase<pg8::EpiGlu, OneUnit, true, true>(F.lds + RING_OFF, g, S, E); }
#endif
                }
#endif
#else
            else if (bid < 16) slow_s5(F, P, (bid - 8) * NWAVES + F.wave);
            else { for (int u = bid - 16; u < ATT_UNITS; u += F.G - 16) attn_unit(F, P, u); }
#endif
        }
        SEAM(sb + 5);
#if GLU_IN5
        if (IN(sb + 6)) { PHASE_BEGIN(); const MixP P = make_mixp(A, ws, l); dn_post_rows4(F, P); }
#elif GLU_DIRECT
        if (IN(sb + 6)) for (int rp_ = 0; rp_ < 1 + ((PROBE_DBL_MASK >> 6) & 1); ++rp_) { PHASE_BEGIN(); const LayerW w = layer_w(ws, l); const MixP P = make_mixp(A, ws, l);
#if WAIT_PROBE && WAIT_REGION
            unsigned long long ra_ = __builtin_amdgcn_s_memrealtime(); __builtin_amdgcn_s_waitcnt(0xC07F);
#endif
            for (int u = F.bid; u < 256; u += F.G) glu_unit(F, P.ysb, (const bf16*)w.wglu, A->in[I_GLUB] + l * 512, MIXED, u);
#if WAIT_PROBE && WAIT_REGION
            { asm volatile("s_waitcnt vmcnt(0)" ::: "memory"); const unsigned long long rb_ = __builtin_amdgcn_s_memrealtime(); __builtin_amdgcn_s_waitcnt(0xC07F); if (WAIT_REGION == 1) wacc += rb_ - ra_; ra_ = rb_; }
#endif
            dn_post_rows4(F, P);
#if WAIT_PROBE && WAIT_REGION
            { asm volatile("s_waitcnt vmcnt(0)" ::: "memory"); const unsigned long long rb_ = __builtin_amdgcn_s_memrealtime(); __builtin_amdgcn_s_waitcnt(0xC07F); if (WAIT_REGION == 2) wacc += rb_ - ra_; }
#endif
            }
#else
        if (IN(sb + 6)) for (int rp_ = 0; rp_ < 1 + ((PROBE_DBL_MASK >> 6) & 1); ++rp_) { PHASE_BEGIN(); const LayerW w = layer_w(ws, l); const MixP P = make_mixp(A, ws, l); pg8::Gemm g{P.ysb, w.wglu, M, 512, 512}; pg8::StaticOrder S; S.init(M, 512, F.G, F.bid);
            #if GLU_BF16Y
            pg8::EpiGlu E{(const pg8::bf16_t*)P.ysb, 512, A->in[I_GLUB] + l * 512, (pg8::bf16_t*)MIXED, MIXW, 1536};
#else
            pg8::EpiGlu E{P.ys, 512, A->in[I_GLUB] + l * 512, MIXED, MIXW, 1536};
#endif
            pg8::gemm_phase<pg8::EpiGlu, pg8::StaticOrder, true, true>(F.lds + RING_OFF, g, S, E);
            dn_post_rows(F, P);
            }
#endif
        SEAM(sb + 6);
        if (IN(sb + 7)) for (int rp_ = 0; rp_ < 1 + ((PROBE_DBL_MASK >> 7) & 1); ++rp_) { PHASE_BEGIN(); const LayerW w = layer_w(ws, l); pg8::Gemm g{MIXED, w.wout, M, D, MIXW}; pg8::StaticOrder S; S.init(M, D, F.G, F.bid);
#if FUSED_NORM
            pg8::EpiRmsRes E{xout, xout, Hb, A->in[I_MIX_POST] + l * D, A->in[I_FF2_PRE] + l * D, 1.0f, (unsigned long long*)(ws + WS_XS), (unsigned*)(ws + WS_CTL) + CW_CNT, 64u * (unsigned)(3 * l + 2), (unsigned*)(ws + WS_CTL) + CW_TMO};
            pg8::gemm_phase<pg8::EpiRmsRes, pg8::StaticOrder, false, true>(F.lds + RING_OFF, g, S, E); }
#else
#if Y_BF16
            pg8::EpiBf16P E{(bf16*)Yb, D};
            pg8::gemm_phase<pg8::EpiBf16P, pg8::StaticOrder, true, true>(F.lds + RING_OFF, g, S, E); }
#else
            pg8::EpiF32 E{Yb, D};
            pg8::gemm_phase<pg8::EpiF32, pg8::StaticOrder, true, true>(F.lds + RING_OFF, g, S, E); }
#endif
#endif
        SEAM(sb + 7);
#if !FUSED_NORM
        if (IN(sb + 8)) { PHASE_BEGIN(); NORM_FN<true, false>(F, Yb, xout, xout, A->in[I_MIX_POST] + l * D, 1.0f, A->in[I_FF2_PRE] + l * D, Hb, nullptr, nullptr);
            if ((PROBE_DBL_MASK >> 18) & 1) NORM_FN<true, false>(F, Yb, xout, (float*)ACT, A->in[I_MIX_POST] + l * D, 1.0f, A->in[I_FF2_PRE] + l * D, Zb, nullptr, nullptr); }
        SEAM(sb + 8);
#endif
        if (IN(sb + 9)) for (int rp_ = 0; rp_ < 1 + ((PROBE_DBL_MASK >> 9) & 1); ++rp_) { PHASE_BEGIN(); const LayerW w = layer_w(ws, l); pg8::Gemm g{Hb, w.wgu2, M, 2 * FF, D}; pg8::EpiSwiGLU E{ACT, FF};
#if GU_SPLIT
            { RangeOrder S; S.init(M, 2 * FF, F.G, F.bid); S.base = 0; S.limit = 704; pg8::gemm_phase<pg8::EpiSwiGLU, RangeOrder, GU_ALIGN, GU_SP2>(F.lds + RING_OFF, g, S, E); }
            xcd_barrier(bar);
            { RangeOrder S; S.init(M, 2 * FF, F.G, F.bid); S.base = 704; S.limit = 1408; pg8::gemm_phase<pg8::EpiSwiGLU, RangeOrder, GU_ALIGN, GU_SP2>(F.lds + RING_OFF, g, S, E); }
#else
#if FILLER_FIRST
            if (!NO_FILLER && F.bid >= 128) { convert_items(F, A, ws, l * CV_END + CV_PRO + CVS_A + CVS_B, l * CV_END + CV_PRO + CVS_A + CVS_B + CVS_C, 128 * NWAVES, (F.G - 128) * NWAVES); __syncthreads(); }
#endif
            pg8::StaticOrder S; S.init(M, 2 * FF, F.G, F.bid);
            pg8::gemm_phase<pg8::EpiSwiGLU, pg8::StaticOrder, GU_ALIGN, GU_SP2>(F.lds + RING_OFF, g, S, E);
#endif
            if (!FILLER_FIRST && !NO_FILLER && F.bid >= 128) convert_items(F, A, ws, l * CV_END + CV_PRO + CVS_A + CVS_B, l * CV_END + CV_PRO + CVS_A + CVS_B + CVS_C, 128 * NWAVES, (F.G - 128) * NWAVES); }
        SEAM(sb + 9);
        if (IN(sb + 10)) for (int rp_ = 0; rp_ < 1 + ((PROBE_DBL_MASK >> 10) & 1); ++rp_) { PHASE_BEGIN(); const LayerW w = layer_w(ws, l); pg8::Gemm g{ACT, w.wd2, M, D, FF}; pg8::StaticOrder S; S.init(M, D, F.G, F.bid);
#if FUSED_NORM
            pg8::EpiRmsRes E{xout, xout, (l + 1 < DEPTH) ? Hb : (bf16*)nullptr, A->in[I_FF2_POST] + l * D, A->in[I_FF1_PRE] + (l + 1 < DEPTH ? l + 1 : l) * D, 0.5f, (unsigned long long*)(ws + WS_XS), (unsigned*)(ws + WS_CTL) + CW_CNT, 64u * (unsigned)(3 * l + 3), (unsigned*)(ws + WS_CTL) + CW_TMO};
            pg8::gemm_phase<pg8::EpiRmsRes, pg8::StaticOrder, false, true>(F.lds + RING_OFF, g, S, E); }
#else
#if Y_BF16
            pg8::EpiBf16P E{(bf16*)Yb, D};
            pg8::gemm_phase<pg8::EpiBf16P, pg8::StaticOrder, true, true>(F.lds + RING_OFF, g, S, E); }
#else
            pg8::EpiF32 E{Yb, D};
            pg8::gemm_phase<pg8::EpiF32, pg8::StaticOrder, true, true>(F.lds + RING_OFF, g, S, E); }
#endif
#endif
        SEAM(sb + 10);
#if !FUSED_NORM
        if (IN(sb + 11)) { PHASE_BEGIN();
            if (l + 1 < DEPTH) NORM_FN<true, false>(F, Yb, xout, xout, A->in[I_FF2_POST] + l * D, 0.5f, A->in[I_FF1_PRE] + (l + 1) * D, Hb, nullptr, nullptr);
            else NORM_FN<false, false>(F, Yb, xout, xout, A->in[I_FF2_POST] + l * D, 0.5f, nullptr, nullptr, nullptr, nullptr);
            if ((PROBE_DBL_MASK >> 18) & 1) NORM_FN<true, false>(F, Yb, xout, (float*)ACT, A->in[I_FF2_POST] + l * D, 0.5f, A->in[I_FF1_PRE] + l * D, Zb, nullptr, nullptr);
        }
        SEAM(sb + 11);
#endif
    }
#if WAIT_PROBE
    {
        unsigned* const pw = (unsigned*)(kargs()->ws + WS_CTL) + 64;
#if WAIT_PROBE_MAX
        if (threadIdx.x == 0) atomicMax(pw, (unsigned)wacc);
#elif WAIT_PROBE_MIN
        if (threadIdx.x == 0) atomicMax(pw, 0x7fffffffu - (unsigned)wacc);
#else
        { const int b_ = blockIdx.x; const bool sel_ = WAIT_SEL == 0 || (WAIT_SEL == 1 && b_ < 16) || (WAIT_SEL == 2 && b_ >= 16 && b_ < 144) || (WAIT_SEL == 3 && b_ >= 144);
          if (threadIdx.x == 0 && sel_) atomicAdd(pw, (unsigned)wacc); }
#endif
        xcd_barrier(bar);
        unsigned sum = __hip_atomic_load(pw, __ATOMIC_RELAXED, __HIP_MEMORY_SCOPE_AGENT);
#if WAIT_PROBE_MAX
        const unsigned long long dly = (unsigned long long)sum * WAIT_AMP;
#elif WAIT_PROBE_MIN
        const unsigned long long dly = (unsigned long long)(0x7fffffffu - sum) * WAIT_AMP;
#else
        const unsigned long long dly = (unsigned long long)(sum / (WAIT_SEL == 0 ? gridDim.x : WAIT_SEL == 1 ? 16u : WAIT_SEL == 2 ? 128u : 112u)) * WAIT_AMP;
#endif
        const unsigned long long t0 = __builtin_amdgcn_s_memrealtime(); __builtin_amdgcn_s_waitcnt(0xC07F);
        while (true) { const unsigned long long t1 = __builtin_amdgcn_s_memrealtime(); __builtin_amdgcn_s_waitcnt(0xC07F); if (t1 - t0 >= dly) break; __builtin_amdgcn_s_sleep(8); }
    }
#endif
#undef IN
#undef SEAM
}

extern "C" void kernel_launch(void* const* d_in, const int* in_sizes, int n_in, void* d_out, int out_size, void* d_ws, size_t ws_size, hipStream_t stream) {
    static int grid = 0;
    if (grid == 0) {
        if (n_in != 30 || in_sizes[0] != M * D || out_size != M * D || ws_size < WS_END) { fprintf(stderr, "kernel_launch: unexpected shapes (n_in %d, in0 %d, out %d, ws %zu need %zu)\n", n_in, n_in > 0 ? in_sizes[0] : -1, out_size, ws_size, (size_t)WS_END); grid = -1; return; }
        int dev = 0, cus = 0, per_cu = 0;
        if (hipGetDevice(&dev) != hipSuccess || hipDeviceGetAttribute(&cus, hipDeviceAttributeMultiprocessorCount, dev) != hipSuccess) { grid = -1; return; }
        if (hipFuncSetAttribute((const void*)mk_fwd, hipFuncAttributeMaxDynamicSharedMemorySize, LDS_BYTES) != hipSuccess) { fprintf(stderr, "kernel_launch: hipFuncSetAttribute failed\n"); grid = -1; return; }
        if (hipOccupancyMaxActiveBlocksPerMultiprocessor(&per_cu, (const void*)mk_fwd, NWAVES * 64, LDS_BYTES) != hipSuccess || per_cu < 1) fprintf(stderr, "kernel_launch: occupancy query says %d\n", per_cu);
        (void)hipGetLastError();
        grid = cus;
    }
    if (grid < 0) return;
    if (hipMemsetAsync((char*)d_ws + WS_CTL, 0, CTL_ZERO_BYTES, stream) != hipSuccess) return;
    Args a{};
    for (int i = 0; i < 30; ++i) a.in[i] = (const float*)d_in[i];
    a.out = (float*)d_out; a.ws = (unsigned char*)d_ws;
#if MK_MULTI
    for (int s = 0; s < NSTEPS; ++s) { a.s_lo = s; a.s_hi = s + 1; hipLaunchKernelGGL(mk_fwd, dim3(grid), dim3(NWAVES * 64), LDS_BYTES, stream, a); }
#else
    a.s_lo = 0; a.s_hi = NSTEPS;
    hipLaunchKernelGGL(mk_fwd, dim3(grid), dim3(NWAVES * 64), LDS_BYTES, stream, a);
#endif
}
```
